# Optimizing an MI355X kernel written in HIP

```python
import jax, jax.numpy as jnp
from jax import lax
import numpy as np

D_MODEL = 2048
BATCH = 1
SEQ = 8192
DEPTH = 4

CTX_LEN = 256
GRID_W = 64
EPS = 1e-6

POOL_WINDOWS = (2, 4, 8, 16)
POOL_WIDTH = D_MODEL // 2
POOL_GROUP = POOL_WIDTH // len(POOL_WINDOWS)
CONV_WIDTH = D_MODEL // 2
CONV_HEADS = 8
CONV_K = 3
EVEN_IN = POOL_WIDTH + 3 * CONV_WIDTH

MLA_HEADS = 16
QK_NOPE = 128
QK_ROPE = 64
V_DIM = 128
Q_LORA = 512
KV_LORA = 512
ROPE_THETA = 10000.0
Q_BLOCK = 128

D_FF = ((8 * D_MODEL // 3 + 255) // 256) * 256

N_EVEN = (DEPTH + 1) // 2
N_ODD = DEPTH // 2

kernel_name = "hybrid_pool_conv_mla_dit_prefix"


def rmsnorm(x, g):
    xf = x.astype(jnp.float32)
    y = xf * lax.rsqrt(jnp.mean(xf * xf, axis=-1, keepdims=True) + EPS)
    return (y * g.astype(jnp.float32)).astype(x.dtype)


def modulate(h, shift, scale):
    return h * (1 + scale) + shift


def ada_mod(cond, w, b):
    return jnp.split(jax.nn.silu(cond) @ w + b, 6, axis=-1)


def swiglu(h, w_gate, w_up, w_down):
    return (jax.nn.silu(h @ w_gate) * (h @ w_up)) @ w_down


def centred_pool_minus_self(u):
    n = u.shape[1]
    uf = u.astype(jnp.float32)
    cs = jnp.concatenate([jnp.zeros_like(uf[:, :1]), jnp.cumsum(uf, axis=1)], axis=1)
    t = jnp.arange(n)
    outs = []
    for g, w in enumerate(POOL_WINDOWS):
        lo = jnp.clip(t - w // 2, 0, n)
        hi = jnp.clip(t + (w - w // 2), 0, n)
        csg = cs[..., g * POOL_GROUP:(g + 1) * POOL_GROUP]
        s = jnp.take(csg, hi, axis=1) - jnp.take(csg, lo, axis=1)
        cnt = (hi - lo).astype(jnp.float32)[None, :, None]
        outs.append(s / cnt)
    pooled = jnp.concatenate(outs, axis=-1)
    return (pooled - uf).astype(u.dtype)


def pool_conv_mixer(h, w_in, pool_w, pool_scale, conv_w, w_out):
    bsz, n, _ = h.shape
    z = h @ w_in
    u_pool, gate_b, gate_c, v = jnp.split(
        z, [POOL_WIDTH, POOL_WIDTH + CONV_WIDTH, POOL_WIDTH + 2 * CONV_WIDTH], axis=-1)
    p = centred_pool_minus_self(u_pool).reshape(bsz, n, len(POOL_WINDOWS), POOL_GROUP)
    y_a = jnp.einsum('bngc,gcd->bngd', p, pool_w).reshape(bsz, n, POOL_WIDTH) * pool_scale
    u = gate_c * v
    pad = CONV_K // 2
    up = jnp.pad(u, ((0, 0), (pad, pad), (0, 0)))
    conv = sum(up[:, k:k + n] * conv_w[k] for k in range(CONV_K))
    y_b = gate_b * conv
    return jnp.concatenate([y_a, y_b], axis=-1) @ w_out


def axial_tables(n, dtype):
    rows = n // GRID_W
    row = jnp.repeat(jnp.arange(rows), GRID_W).astype(jnp.float32)
    col = jnp.tile(jnp.arange(GRID_W), rows).astype(jnp.float32)
    nf = QK_ROPE // 4
    inv = jnp.power(jnp.float32(ROPE_THETA), -jnp.arange(nf, dtype=jnp.float32) / nf)
    ar = row[:, None] * inv
    ac = col[:, None] * inv
    return (jnp.cos(ar).astype(dtype), jnp.sin(ar).astype(dtype),
            jnp.cos(ac).astype(dtype), jnp.sin(ac).astype(dtype))


def rope_half(t, cos, sin):
    half = t.shape[-1] // 2
    t1, t2 = t[..., :half], t[..., half:]
    return jnp.concatenate([t1 * cos - t2 * sin, t2 * cos + t1 * sin], axis=-1)


def axial_rope(t, cos_r, sin_r, cos_c, sin_c):
    h = QK_ROPE // 2
    return jnp.concatenate([rope_half(t[..., :h], cos_r, sin_r),
                            rope_half(t[..., h:], cos_c, sin_c)], axis=-1)


def mla_query(h, w_dq, q_norm_g, w_uq):
    bsz, n, _ = h.shape
    q = (rmsnorm(h @ w_dq, q_norm_g) @ w_uq).reshape(bsz, n, MLA_HEADS, QK_NOPE + QK_ROPE)
    return q[..., :QK_NOPE], q[..., QK_NOPE:]


def mla_keyvalue(h, w_dkv, kv_norm_g, w_ukv):
    bsz, n, _ = h.shape
    kv_a = h @ w_dkv
    c_kv = rmsnorm(kv_a[..., :KV_LORA], kv_norm_g)
    k_rope = kv_a[..., KV_LORA:]
    kv = (c_kv @ w_ukv).reshape(bsz, n, MLA_HEADS, QK_NOPE + V_DIM)
    return kv[..., :QK_NOPE], k_rope, kv[..., QK_NOPE:]


def mla_attend(q_nope, q_rope, k_nope, k_rope, v):
    scale = (QK_NOPE + QK_ROPE) ** -0.5
    s = (jnp.einsum('bqhd,bkhd->bhqk', q_nope, k_nope)
         + jnp.einsum('bqhr,bkr->bhqk', q_rope, k_rope))
    p = jax.nn.softmax(s.astype(jnp.float32) * scale, axis=-1).astype(v.dtype)
    return jnp.einsum('bhqk,bkhd->bqhd', p, v)


def blocked_attend(q_nope, q_rope, k_nope, k_rope, v):
    bsz, n, nh, _ = q_nope.shape
    nb = n // Q_BLOCK

    def to_blocks(t):
        return jnp.moveaxis(t.reshape(bsz, nb, Q_BLOCK, *t.shape[2:]), 1, 0)

    out = lax.map(lambda qs: mla_attend(qs[0], qs[1], k_nope, k_rope, v),
                  (to_blocks(q_nope), to_blocks(q_rope)))
    return jnp.moveaxis(out, 0, 1).reshape(bsz, n, nh, V_DIM)


def mla_mixer(h, hc, need_ctx_out, w_dq, q_norm_g, w_uq, w_dkv, kv_norm_g, w_ukv, w_o):
    bsz, n, _ = h.shape
    cr, sr, cc, sc = axial_tables(n, h.dtype)
    qn, qr = mla_query(h, w_dq, q_norm_g, w_uq)
    qr = axial_rope(qr, cr[:, None], sr[:, None], cc[:, None], sc[:, None])
    kn, kr, v = mla_keyvalue(h, w_dkv, kv_norm_g, w_ukv)
    kr = axial_rope(kr, cr, sr, cc, sc)
    kn_c, kr_c, v_c = mla_keyvalue(hc, w_dkv, kv_norm_g, w_ukv)
    kn_all = jnp.concatenate([kn, kn_c], axis=1)
    kr_all = jnp.concatenate([kr, kr_c], axis=1)
    v_all = jnp.concatenate([v, v_c], axis=1)
    y = blocked_attend(qn, qr, kn_all, kr_all, v_all).reshape(bsz, n, MLA_HEADS * V_DIM) @ w_o
    yc = None
    if need_ctx_out:
        qn_c, qr_c = mla_query(hc, w_dq, q_norm_g, w_uq)
        lc = hc.shape[1]
        yc = mla_attend(qn_c, qr_c, kn_c, kr_c, v_c).reshape(bsz, lc, MLA_HEADS * V_DIM) @ w_o
    return y, yc


def setup_inputs(seed: int = 0) -> dict:
    key = jax.random.key(seed)
    ks = iter(jax.random.split(key, 32))

    def nrm(shape, fan_in, mult=1.0):
        return jax.random.normal(next(ks), shape, jnp.float32) * (mult * fan_in ** -0.5)

    def gain(shape):
        return 1.0 + 0.02 * jax.random.normal(next(ks), shape, jnp.float32)

    x = jax.random.normal(next(ks), (BATCH, SEQ, D_MODEL), jnp.float32)
    c = jax.random.normal(next(ks), (BATCH, D_MODEL), jnp.float32)
    ctx = jax.random.normal(next(ks), (BATCH, CTX_LEN, D_MODEL), jnp.float32)
    c_ctx = jax.random.normal(next(ks), (D_MODEL,), jnp.float32)
    return {
        'x': x, 'c': c, 'ctx': ctx, 'c_ctx': c_ctx,
        'ada_w': nrm((DEPTH, D_MODEL, 6 * D_MODEL), D_MODEL, 0.5),
        'ada_b': 0.02 * jax.random.normal(next(ks), (DEPTH, 6 * D_MODEL), jnp.float32),
        'norm1_g': gain((DEPTH, D_MODEL)),
        'norm2_g': gain((DEPTH, D_MODEL)),
        'even_w_in': nrm((N_EVEN, D_MODEL, EVEN_IN), D_MODEL),
        'pool_w': nrm((N_EVEN, len(POOL_WINDOWS), POOL_GROUP, POOL_GROUP), POOL_GROUP),
        'pool_scale': gain((N_EVEN, POOL_WIDTH)),
        'conv_w': nrm((N_EVEN, CONV_K, CONV_WIDTH), CONV_K),
        'even_w_out': nrm((N_EVEN, POOL_WIDTH + CONV_WIDTH, D_MODEL), POOL_WIDTH + CONV_WIDTH),
        'mla_w_dq': nrm((N_ODD, D_MODEL, Q_LORA), D_MODEL),
        'mla_q_norm_g': gain((N_ODD, Q_LORA)),
        'mla_w_uq': nrm((N_ODD, Q_LORA, MLA_HEADS * (QK_NOPE + QK_ROPE)), Q_LORA),
        'mla_w_dkv': nrm((N_ODD, D_MODEL, KV_LORA + QK_ROPE), D_MODEL),
        'mla_kv_norm_g': gain((N_ODD, KV_LORA)),
        'mla_w_ukv': nrm((N_ODD, KV_LORA, MLA_HEADS * (QK_NOPE + V_DIM)), KV_LORA),
        'mla_w_o': nrm((N_ODD, MLA_HEADS * V_DIM, D_MODEL), MLA_HEADS * V_DIM),
        'ffn_w_gate': nrm((DEPTH, D_MODEL, D_FF), D_MODEL),
        'ffn_w_up': nrm((DEPTH, D_MODEL, D_FF), D_MODEL),
        'ffn_w_down': nrm((DEPTH, D_FF, D_MODEL), D_FF),
        'final_norm_g': gain((D_MODEL,)),
    }


def reference(x, c, ctx, c_ctx, ada_w, ada_b, norm1_g, norm2_g, even_w_in, pool_w, pool_scale,
              conv_w, even_w_out, mla_w_dq, mla_q_norm_g, mla_w_uq, mla_w_dkv, mla_kv_norm_g,
              mla_w_ukv, mla_w_o, ffn_w_gate, ffn_w_up, ffn_w_down, final_norm_g):
    x_lat, x_ctx = x, ctx
    for layer in range(DEPTH):
        last = layer == DEPTH - 1
        odd = layer % 2 == 1
        i = layer // 2
        sh1, sc1, g1, sh2, sc2, g2 = [p[:, None, :] for p in ada_mod(c, ada_w[layer], ada_b[layer])]
        h = modulate(rmsnorm(x_lat, norm1_g[layer]), sh1, sc1)
        hc = None
        if odd or not last:
            csh1, csc1, cg1, csh2, csc2, cg2 = ada_mod(c_ctx, ada_w[layer], ada_b[layer])
            hc = modulate(rmsnorm(x_ctx, norm1_g[layer]), csh1, csc1)
        if odd:
            y, yc = mla_mixer(h, hc, not last, mla_w_dq[i], mla_q_norm_g[i], mla_w_uq[i],
                              mla_w_dkv[i], mla_kv_norm_g[i], mla_w_ukv[i], mla_w_o[i])
        else:
            y = pool_conv_mixer(h, even_w_in[i], pool_w[i], pool_scale[i], conv_w[i], even_w_out[i])
            yc = None
            if not last:
                yc = pool_conv_mixer(hc, even_w_in[i], pool_w[i], pool_scale[i], conv_w[i], even_w_out[i])
        x_lat = x_lat + g1 * y
        h2 = modulate(rmsnorm(x_lat, norm2_g[layer]), sh2, sc2)
        x_lat = x_lat + g2 * swiglu(h2, ffn_w_gate[layer], ffn_w_up[layer], ffn_w_down[layer])
        if not last:
            x_ctx = x_ctx + cg1 * yc
            h2c = modulate(rmsnorm(x_ctx, norm2_g[layer]), csh2, csc2)
            x_ctx = x_ctx + cg2 * swiglu(h2c, ffn_w_gate[layer], ffn_w_up[layer], ffn_w_down[layer])
    return rmsnorm(x_lat, final_norm_g)
```

```cpp
#include <hip/hip_runtime.h>
#include <cstdio>
#include <cstdint>

#ifndef MK_ONE_LAUNCH
#define MK_ONE_LAUNCH 1
#endif
#ifndef MK_SIMPLE_ATTN
#define MK_SIMPLE_ATTN 0
#endif
#ifndef MK_SIMPLE_GEMM
#define MK_SIMPLE_GEMM 0
#endif

#define LAS __attribute__((address_space(3)))
#define GAS __attribute__((address_space(1)))
typedef unsigned short bf16_t;
typedef short bf16x8 __attribute__((ext_vector_type(8)));
typedef float f32x4 __attribute__((ext_vector_type(4)));
typedef float f32x2 __attribute__((ext_vector_type(2)));
typedef float f32x16 __attribute__((ext_vector_type(16)));
typedef unsigned u32x4 __attribute__((ext_vector_type(4)));
typedef unsigned u32x2 __attribute__((ext_vector_type(2)));

constexpr int DM = 2048, SEQ = 8192, CTXL = 256, R = SEQ + CTXL, NPANEL = R / 256, DEPTH = 4;
constexpr int EVEN_IN = 4096, FF = 5632, QLORA = 512, KVLORA = 512, NHEAD = 16, QKN = 128, QKR = 64, VD = 128, QHD = QKN + QKR;
constexpr int NQ = NHEAD * QHD  , NKV = NHEAD * (QKN + VD)  , NDQKV = 1280  ;
constexpr float EPS = 1e-6f;
constexpr float QSCALE = 0.07216878364870322f * 1.4426950408889634f;

__device__ __forceinline__ unsigned cvt_pk_bf16(float lo, float hi) { unsigned r; asm volatile("v_cvt_pk_bf16_f32 %0, %1, %2" : "=v"(r) : "v"(lo), "v"(hi)); return r; }
__device__ __forceinline__ float bf_lo(unsigned w) { return __uint_as_float(w << 16); }
__device__ __forceinline__ float bf_hi(unsigned w) { return __uint_as_float(w & 0xffff0000u); }
template <int K> __device__ __forceinline__ float xor_add(float v) {
    if constexpr (K < 32) return v + __builtin_bit_cast(float, __builtin_amdgcn_ds_swizzle(__builtin_bit_cast(int, v), (K << 10) | 0x1F));
    else { auto rr = __builtin_amdgcn_permlane32_swap(__float_as_uint(v), __float_as_uint(v), false, false); return __uint_as_float(rr[0]) + __uint_as_float(rr[1]); }
}
__device__ __forceinline__ float wave_sum(float v) { v = xor_add<1>(v); v = xor_add<2>(v); v = xor_add<4>(v); v = xor_add<8>(v); v = xor_add<16>(v); return xor_add<32>(v); }

__device__ __forceinline__ int otid() { int t = threadIdx.x; asm volatile("" : "+v"(t)); return t; }
__device__ __forceinline__ int obid() { int b = blockIdx.x; asm volatile("" : "+s"(b)); return b; }
template <class T> __device__ __forceinline__ T karg_ld(int off) { const __attribute__((address_space(4))) char* k = (const __attribute__((address_space(4))) char*)__builtin_amdgcn_kernarg_segment_ptr(); asm volatile("" : "+s"(k)); return *(const __attribute__((address_space(4))) T*)(k + off); }
#define KARG(type, off) karg_ld<type>(off)
#define INP(k) KARG(const float*, 8 * (k))
namespace pg8 {
constexpr int BM = 256, BK = 64, HALF = 128, HTB = HALF * BK * 2, STAGE_BYTES = 8 * HTB, NXCD = 8, WGM = 8;
__host__ __device__ __forceinline__ int lds_byte(int r, int c) { const int st = (r >> 4) * 2 + (c >> 5), rr = r & 15, cc = c & 31, ob = rr * 64 + cc * 2; return st * 1024 + (ob ^ (((ob >> 9) & 1) << 5)); }
__host__ __device__ __forceinline__ void stage_rc(int b, int& Rr, int& C) { const int st = b / 1024, sb = b % 1024, swz = sb ^ (((sb >> 9) & 1) << 5); Rr = (st >> 1) * 16 + swz / 64; C = (st & 1) * 32 + (swz % 64) / 2; }
__host__ __device__ __forceinline__ int perm32(int rho) { const int n = rho >> 4, i = rho & 15; return 8 * (i >> 2) + 4 * n + (i & 3); }

struct Unit { int pm, pn, ka, kb, nt, aux; };
struct Gemm { const bf16_t* A; const bf16_t* Bt; int lda, ldb, nt; };

struct StaticOrder {
    int nM, nN, nwg, G, c, nt;
    __device__ void init(int nM_, int nN_, int G_, int c_, int nt_) { nM = nM_; nN = nN_; nwg = nM * nN; G = G_; c = c_; nt = nt_; }
    __device__ __forceinline__ bool next(int i, Unit& u) const {
        const long L = (long)i * G + c; if (L >= nwg) return false;
        int wgid = (int)L; { const int q = nwg / NXCD, r = nwg % NXCD, xcd = wgid % NXCD, off = wgid / NXCD; wgid = (xcd < r ? xcd * (q + 1) : r * (q + 1) + (xcd - r) * q) + off; }
        const int nig = WGM * nN, gid = wgid / nig, fm = gid * WGM, gsz = (nM - fm) < WGM ? (nM - fm) : WGM;
        u.pm = fm + ((wgid % nig) % gsz); u.pn = (wgid % nig) / gsz; u.ka = 0; u.kb = 0; u.nt = nt; u.aux = 0; return true;
    }
};
struct FoldOrder {
    int c;
    __device__ bool next(int i, Unit& u) const { if (i > 0 || c >= 32) return false; u.pm = c & 3; u.pn = c >> 2; u.ka = 0; u.kb = 256 * (c & 3); u.nt = 4; u.aux = 0; return true; }
};

struct LatCtxOrder {
    StaticOrder so; int ntn, nsl, kchunk;
    __device__ __forceinline__ bool next(int i, Unit& u) const {
        Unit a; a.pm = 0; a.pn = 0; a.ka = 0; a.kb = 0; a.nt = so.nt; a.aux = 0;
        const bool ok1 = so.next(i, a);
        const int nL = so.c < so.nwg ? (so.nwg - so.c + so.G - 1) / so.G : 0, s = so.c + (i - nL) * so.G;
        const bool ok2 = !ok1 && s >= 0 && s < nsl;
        const int sl = s / ntn, ko = sl * kchunk;
        u.pm = ok1 ? a.pm : 32; u.pn = ok1 ? a.pn : s - sl * ntn; u.aux = ok1 ? 0 : sl; u.ka = ok1 ? 0 : ko; u.kb = ok1 ? 0 : ko; u.nt = ok1 ? so.nt : kchunk / 64;
        return ok1 || ok2;
    }
};
__device__ __forceinline__ void pg8_glds(const char* sbase, unsigned voff, unsigned lds_dst) {
    asm volatile("s_mov_b32 m0, %2\n\ts_nop 0\n\tglobal_load_lds_dwordx4 %1, %0" :: "s"(sbase), "v"(voff), "s"(lds_dst) : "memory", "m0"); }
template <class Epi, class Sched>
__device__ __forceinline__ void gemm_simple(const Gemm g, const Sched& S, const Epi& E) {
    const int tid = otid(), wid = __builtin_amdgcn_readfirstlane(tid >> 6), lane = tid & 63, wr = wid >> 2, wc = wid & 3, fr = lane & 15, fq = lane >> 4;
    Unit u;
    for (int i = 0; S.next(i, u); ++i) {
        f32x4 acc[2][2][4][2];
#pragma unroll
        for (int a = 0; a < 2; ++a)
#pragma unroll
            for (int b = 0; b < 2; ++b)
#pragma unroll
                for (int m = 0; m < 4; ++m)
#pragma unroll
                    for (int n = 0; n < 2; ++n) acc[a][b][m][n] = (f32x4){0.f, 0.f, 0.f, 0.f};
        const bf16_t* A = g.A + (size_t)u.pm * 256 * g.lda + u.ka + (size_t)(64 * wr + fr) * g.lda + fq * 8;
        int rb[2];
#pragma unroll
        for (int n = 0; n < 2; ++n) { const int rho = 16 * n + fr; rb[n] = Epi::PERM ? perm32(rho) : rho; }
        const bf16_t* B = g.Bt + (size_t)u.pn * 256 * g.ldb + u.kb + (size_t)(32 * wc) * g.ldb + fq * 8;
        bf16x8 a[2][4], b[2][2], an[2][4], bn[2][2];
        const int kend = u.nt * 64;
#define GS_LOAD(DA, DB, KK) do { _Pragma("unroll") for (int ai = 0; ai < 2; ++ai) _Pragma("unroll") for (int m = 0; m < 4; ++m) DA[ai][m] = *(const bf16x8*)(A + (size_t)(128 * ai + 16 * m) * g.lda + (KK)); \
            _Pragma("unroll") for (int bj = 0; bj < 2; ++bj) _Pragma("unroll") for (int n = 0; n < 2; ++n) DB[bj][n] = *(const bf16x8*)(B + (size_t)(128 * bj + rb[n]) * g.ldb + (KK)); } while (0)
        GS_LOAD(a, b, 0);
#pragma unroll 1
        for (int kk = 0; kk < kend; kk += 32) {
            const int kn = (kk + 32 < kend) ? kk + 32 : kk;
            GS_LOAD(an, bn, kn);
#pragma unroll
            for (int ai = 0; ai < 2; ++ai)
#pragma unroll
                for (int bj = 0; bj < 2; ++bj)
#pragma unroll
                    for (int m = 0; m < 4; ++m)
#pragma unroll
                        for (int n = 0; n < 2; ++n) acc[ai][bj][m][n] = __builtin_amdgcn_mfma_f32_16x16x32_bf16(b[bj][n], a[ai][m], acc[ai][bj][m][n], 0, 0, 0);
#pragma unroll
            for (int ai = 0; ai < 2; ++ai)
#pragma unroll
                for (int m = 0; m < 4; ++m) a[ai][m] = an[ai][m];
#pragma unroll
            for (int bj = 0; bj < 2; ++bj)
#pragma unroll
                for (int n = 0; n < 2; ++n) b[bj][n] = bn[bj][n];
        }
#undef GS_LOAD
        E(acc, u, wr, wc, fr, fq);
    }
}

template <class Epi, class Sched, bool ALIGN_EPI = true, bool SP2 = true>
__device__ __forceinline__ void gemm_phase(LAS unsigned char* lds, const Gemm g, const Sched& S, const Epi& E) {
    const int tid = otid(), wid = __builtin_amdgcn_readfirstlane(tid >> 6), lane = tid & 63, wr = wid >> 2, wc = wid & 3, fr = lane & 15, fq = lane >> 4;
    unsigned voffA[2], voffB[2];
#pragma unroll
    for (int i = 0; i < 2; ++i) { int Rr, C; stage_rc(tid * 16 + i * 8192, Rr, C); const int Rb = Epi::PERM ? ((Rr & ~31) + perm32(Rr & 31)) : Rr;
        voffA[i] = (unsigned)(Rr * g.lda + C) * 2u; voffB[i] = (unsigned)(Rb * g.ldb + C) * 2u; }
    const size_t kstep = (size_t)(BK * 2);
    const size_t hstepA = (size_t)HALF * g.lda * 2, hstepB = (size_t)HALF * g.ldb * 2;
    const size_t tstepA = 2 * hstepA, tstepB = 2 * hstepB;
    const unsigned ldsw = (unsigned)wid * 1024u, lds0 = (unsigned)(uintptr_t)lds;
    const int aoff = lds_byte(wr * 64 + fr, fq * 8), boff = lds_byte(wc * 32 + fr, fq * 8);
#define PG8_SA(b, h) (((b) * 2 + (h)) * HTB)
#define PG8_SB(b, h) ((4 + (b) * 2 + (h)) * HTB)
#define PG8_STAGE(bufoff, gbase, voff) do { _Pragma("unroll") for (int _i = 0; _i < 2; ++_i) \
        pg8_glds((const char*)(gbase), (voff)[_i], (unsigned)__builtin_amdgcn_readfirstlane((int)(lds0 + (unsigned)(bufoff) + ldsw + (unsigned)(_i * 8192)))); } while (0)
#define PG8_LDA(dst, b, h) do { _Pragma("unroll") for (int m = 0; m < 4; ++m) _Pragma("unroll") for (int k = 0; k < 2; ++k) dst[m][k] = *(const LAS bf16x8*)(lds + PG8_SA(b, h) + aoff + m * 2048 + k * 1024); } while (0)
#define PG8_LDB(dst, b, h) do { _Pragma("unroll") for (int n = 0; n < 2; ++n) _Pragma("unroll") for (int k = 0; k < 2; ++k) dst[n][k] = *(const LAS bf16x8*)(lds + PG8_SB(b, h) + boff + n * 2048 + k * 1024); } while (0)
#define PG8_MMA(ai, bj, At, Bt) do { __builtin_amdgcn_s_setprio(1); _Pragma("unroll") for (int m = 0; m < 4; ++m) _Pragma("unroll") for (int n = 0; n < 2; ++n) _Pragma("unroll") for (int k = 0; k < 2; ++k) \
        acc[ai][bj][m][n] = __builtin_amdgcn_mfma_f32_16x16x32_bf16(Bt[n][k], At[m][k], acc[ai][bj][m][n], 0, 0, 0); __builtin_amdgcn_s_setprio(0); } while (0)
#define PG8_WAIT_V(n) asm volatile("s_waitcnt vmcnt(" #n ")" ::: "memory")
#define PG8_WAIT_L(n) asm volatile("s_waitcnt lgkmcnt(" #n ")" ::: "memory")
#define PG8_WAIT_L0() __builtin_amdgcn_s_waitcnt(0xC07F)
#define PG8_BAR __builtin_amdgcn_s_barrier()
#define PG8_SCHED __builtin_amdgcn_sched_barrier(0)
    Unit cur, nxt; int ui = 0;
    if (!S.next(0, cur)) return;
    f32x4 acc[2][2][4][2];
#pragma unroll
    for (int a = 0; a < 2; ++a)
#pragma unroll
        for (int b = 0; b < 2; ++b)
#pragma unroll
            for (int m = 0; m < 4; ++m)
#pragma unroll
                for (int n = 0; n < 2; ++n) acc[a][b][m][n] = (f32x4){0.f, 0.f, 0.f, 0.f};
    bf16x8 At[4][2], B0[2][2], B1[2][2];
    const char* cA = (const char*)g.A + (size_t)cur.pm * tstepA + (size_t)cur.ka * 2; const char* cB = (const char*)g.Bt + (size_t)cur.pn * tstepB + (size_t)cur.kb * 2;
    if constexpr (SP2) {
        PG8_STAGE(PG8_SB(0, 0), cB, voffB); PG8_STAGE(PG8_SB(0, 1), cB + hstepB, voffB); PG8_STAGE(PG8_SA(0, 0), cA, voffA); PG8_STAGE(PG8_SA(0, 1), cA + hstepA, voffA);
        if (wr == 1) PG8_BAR;
        PG8_WAIT_V(2); PG8_BAR;
        PG8_STAGE(PG8_SB(1, 0), cB + kstep, voffB); PG8_STAGE(PG8_SA(1, 0), cA + kstep, voffA); PG8_STAGE(PG8_SB(1, 1), cB + hstepB + kstep, voffB);
        PG8_WAIT_V(6); PG8_BAR;
    } else {
        PG8_STAGE(PG8_SB(0, 0), cB, voffB); PG8_STAGE(PG8_SA(0, 0), cA, voffA); PG8_STAGE(PG8_SB(0, 1), cB + hstepB, voffB); PG8_STAGE(PG8_SA(0, 1), cA + hstepA, voffA);
        if (wr == 1) PG8_BAR;
        PG8_WAIT_V(4); PG8_BAR;
        PG8_STAGE(PG8_SB(1, 0), cB + kstep, voffB); PG8_STAGE(PG8_SA(1, 0), cA + kstep, voffA); PG8_STAGE(PG8_SB(1, 1), cB + hstepB + kstep, voffB);
        PG8_WAIT_V(6); PG8_BAR;
    }
    for (;;) {
        const bool has_next = S.next(ui + 1, nxt);
        const char* nA = has_next ? (const char*)g.A + (size_t)nxt.pm * tstepA + (size_t)nxt.ka * 2 : cA; const char* nB = has_next ? (const char*)g.Bt + (size_t)nxt.pn * tstepB + (size_t)nxt.kb * 2 : cB;
        const int nt = cur.nt;
        for (int t = 0; t < nt; t += 2) {
            const bool last = (t == nt - 2);
            const char* a1 = cA + (size_t)(t + 1) * kstep;
            const char* a2 = last ? nA : cA + (size_t)(t + 2) * kstep; const char* b2 = last ? nB : cB + (size_t)(t + 2) * kstep;
            const char* a3 = a2 + kstep; const char* b3 = b2 + kstep;
            if constexpr (SP2) {
            PG8_LDB(B0, 0, 0); PG8_LDB(B1, 0, 1); PG8_SCHED; PG8_LDA(At, 0, 0); PG8_STAGE(PG8_SA(1, 1), a1 + hstepA, voffA);
            PG8_WAIT_V(8); PG8_WAIT_L0(); PG8_BAR; PG8_MMA(0, 0, At, B0); PG8_MMA(0, 1, At, B1); PG8_BAR; PG8_SCHED;
            PG8_LDA(At, 0, 1); PG8_STAGE(PG8_SB(0, 0), b2, voffB); PG8_STAGE(PG8_SB(0, 1), b2 + hstepB, voffB); PG8_STAGE(PG8_SA(0, 0), a2, voffA);
            PG8_WAIT_V(8); PG8_WAIT_L0(); PG8_BAR; PG8_MMA(1, 0, At, B0); PG8_MMA(1, 1, At, B1); PG8_BAR; PG8_SCHED;
            PG8_LDB(B0, 1, 0); PG8_LDB(B1, 1, 1); PG8_SCHED; PG8_LDA(At, 1, 0); PG8_STAGE(PG8_SA(0, 1), a2 + hstepA, voffA);
            PG8_WAIT_V(8); PG8_WAIT_L0(); PG8_BAR; PG8_MMA(0, 0, At, B0); PG8_MMA(0, 1, At, B1); PG8_BAR; PG8_SCHED;
            PG8_LDA(At, 1, 1); PG8_STAGE(PG8_SB(1, 0), b3, voffB); PG8_STAGE(PG8_SB(1, 1), b3 + hstepB, voffB); PG8_STAGE(PG8_SA(1, 0), a3, voffA);
            PG8_WAIT_V(8); PG8_WAIT_L0(); PG8_BAR; PG8_MMA(1, 0, At, B0); PG8_MMA(1, 1, At, B1); PG8_BAR; PG8_SCHED;
            } else {
            PG8_LDB(B0, 0, 0); PG8_SCHED; PG8_LDA(At, 0, 0); PG8_STAGE(PG8_SA(1, 1), a1 + hstepA, voffA);
            PG8_WAIT_L(8); PG8_BAR; PG8_WAIT_L(0); PG8_MMA(0, 0, At, B0); PG8_BAR; PG8_SCHED;
            PG8_LDB(B1, 0, 1); PG8_STAGE(PG8_SB(0, 0), b2, voffB);
            PG8_BAR; PG8_WAIT_L(0); PG8_MMA(0, 1, At, B1); PG8_BAR;
            PG8_LDA(At, 0, 1); PG8_STAGE(PG8_SA(0, 0), a2, voffA);
            PG8_BAR; PG8_WAIT_L(0); PG8_MMA(1, 0, At, B0); PG8_BAR; PG8_SCHED;
            PG8_STAGE(PG8_SB(0, 1), b2 + hstepB, voffB);
            PG8_WAIT_V(6); PG8_BAR; PG8_MMA(1, 1, At, B1); PG8_BAR;
            PG8_LDB(B0, 1, 0); PG8_SCHED; PG8_LDA(At, 1, 0); PG8_STAGE(PG8_SA(0, 1), a2 + hstepA, voffA);
            PG8_WAIT_L(8); PG8_BAR; PG8_WAIT_L(0); PG8_MMA(0, 0, At, B0); PG8_BAR; PG8_SCHED;
            PG8_LDB(B1, 1, 1); PG8_STAGE(PG8_SB(1, 0), b3, voffB);
            PG8_BAR; PG8_WAIT_L(0); PG8_MMA(0, 1, At, B1); PG8_BAR;
            PG8_LDA(At, 1, 1); PG8_STAGE(PG8_SA(1, 0), a3, voffA);
            PG8_BAR; PG8_WAIT_L(0); PG8_MMA(1, 0, At, B0); PG8_BAR; PG8_SCHED;
            PG8_STAGE(PG8_SB(1, 1), b3 + hstepB, voffB);
            PG8_WAIT_V(6); PG8_BAR; PG8_MMA(1, 1, At, B1); PG8_BAR;
            }
        }
        if constexpr (ALIGN_EPI) { if (wr == 0) PG8_BAR; }
        E(acc, cur, wr, wc, fr, fq);
        if (!has_next) break;
#pragma unroll
        for (int a = 0; a < 2; ++a)
#pragma unroll
            for (int b = 0; b < 2; ++b)
#pragma unroll
                for (int m = 0; m < 4; ++m)
#pragma unroll
                    for (int n = 0; n < 2; ++n) acc[a][b][m][n] = (f32x4){0.f, 0.f, 0.f, 0.f};
        cur = nxt; cA = nA; cB = nB; ++ui;
        if constexpr (ALIGN_EPI) { if (wr == 1) PG8_BAR; }
    }
    PG8_WAIT_V(0);
    if constexpr (!ALIGN_EPI) { if (wr == 0) PG8_BAR; }
    PG8_BAR;
#undef PG8_SA
#undef PG8_SB
#undef PG8_STAGE
#undef PG8_LDA
#undef PG8_LDB
#undef PG8_MMA
#undef PG8_WAIT_V
#undef PG8_WAIT_L
#undef PG8_WAIT_L0
#undef PG8_BAR
#undef PG8_SCHED
}
}

typedef f32x4 Acc[2][2][4][2];
__device__ __forceinline__ u32x4 pack8(f32x4 v0, f32x4 v1) { u32x4 w; w.x = cvt_pk_bf16(v0[0], v0[1]); w.y = cvt_pk_bf16(v0[2], v0[3]); w.z = cvt_pk_bf16(v1[0], v1[1]); w.w = cvt_pk_bf16(v1[2], v1[3]); return w; }

struct EpiBf16 {
    static constexpr bool PERM = true;
    bf16_t* O; int ldc; const float* rs;
    __device__ __forceinline__ void operator()(const Acc& acc, const pg8::Unit& u, int wr, int wc, int fr, int fq) const {
        const int row0 = u.pm * 256 + wr * 64 + fr, col0 = u.pn * 256 + wc * 32 + 8 * fq;
        float sv[2][4];
#pragma unroll
        for (int ai = 0; ai < 2; ++ai)
#pragma unroll
            for (int m = 0; m < 4; ++m) sv[ai][m] = rs ? rs[row0 + ai * 128 + m * 16] : 1.f;
#pragma unroll
        for (int ai = 0; ai < 2; ++ai)
#pragma unroll
            for (int m = 0; m < 4; ++m) { const int row = row0 + ai * 128 + m * 16; const float s = sv[ai][m]; bf16_t* rowp = O + (size_t)row * ldc + col0;
#pragma unroll
                for (int bj = 0; bj < 2; ++bj) *(u32x4*)(rowp + bj * 128) = pack8(acc[ai][bj][m][0] * s, acc[ai][bj][m][1] * s); }
    }
};
typedef _Float16 h2_t __attribute__((ext_vector_type(2)));
__device__ __forceinline__ unsigned xpk(float lo, float hi) { const f32x2 v = {lo, hi}; const h2_t h = __builtin_convertvector(v, h2_t); return __builtin_bit_cast(unsigned, h); }
__device__ __forceinline__ f32x2 xun(unsigned w) { return __builtin_convertvector(__builtin_bit_cast(h2_t, w), f32x2); }
__device__ __forceinline__ u32x4 xpack8(f32x4 a, f32x4 b) { u32x4 w; w.x = xpk(a[0], a[1]); w.y = xpk(a[2], a[3]); w.z = xpk(b[0], b[1]); w.w = xpk(b[2], b[3]); return w; }
__device__ __forceinline__ void xunpack8(const u32x4 w, f32x4& a, f32x4& b) { const f32x2 p = xun(w.x), q = xun(w.y), r = xun(w.z), s = xun(w.w); a = (f32x4){p[0], p[1], q[0], q[1]}; b = (f32x4){r[0], r[1], s[0], s[1]}; }
__device__ __forceinline__ void unpack8(const u32x4 w, f32x4& a, f32x4& b) { a = (f32x4){bf_lo(w.x), bf_hi(w.x), bf_lo(w.y), bf_hi(w.y)}; b = (f32x4){bf_lo(w.z), bf_hi(w.z), bf_lo(w.w), bf_hi(w.w)}; }
struct EpiResid {
    static constexpr bool PERM = true;
    const float* base32; const bf16_t* base16; bf16_t* out; const float* gate;
    __device__ __forceinline__ void operator()(const Acc& acc, const pg8::Unit& u, int wr, int wc, int fr, int fq) const {
        const int row0 = u.pm * 256 + wr * 64 + fr, col0 = u.pn * 256 + wc * 32 + 8 * fq;
        f32x4 gv[2][2];
#pragma unroll
        for (int bj = 0; bj < 2; ++bj)
#pragma unroll
            for (int n = 0; n < 2; ++n) gv[bj][n] = *(const f32x4*)(gate + col0 + bj * 128 + n * 4);
#pragma unroll
        for (int ai = 0; ai < 2; ++ai) {
            if (base32) {
#pragma unroll
                for (int mh = 0; mh < 4; mh += 2) { f32x4 xf[2][2][2];
#pragma unroll
                    for (int m = 0; m < 2; ++m)
#pragma unroll
                        for (int bj = 0; bj < 2; ++bj) { const float* p = base32 + (size_t)(row0 + ai * 128 + (mh + m) * 16) * DM + col0 + bj * 128; xf[m][bj][0] = __builtin_nontemporal_load((const f32x4*)p); xf[m][bj][1] = __builtin_nontemporal_load((const f32x4*)(p + 4)); }
#pragma unroll
                    for (int m = 0; m < 2; ++m) { const size_t off = (size_t)(row0 + ai * 128 + (mh + m) * 16) * DM + col0;
#pragma unroll
                        for (int bj = 0; bj < 2; ++bj) *(u32x4*)(out + off + bj * 128) = xpack8(xf[m][bj][0] + gv[bj][0] * acc[ai][bj][mh + m][0], xf[m][bj][1] + gv[bj][1] * acc[ai][bj][mh + m][1]); }
                    asm volatile("" ::: "memory"); }
            } else {
                u32x4 xb[4][2];
#pragma unroll
                for (int m = 0; m < 4; ++m)
#pragma unroll
                    for (int bj = 0; bj < 2; ++bj) xb[m][bj] = *(const u32x4*)(base16 + (size_t)(row0 + ai * 128 + m * 16) * DM + col0 + bj * 128);
#pragma unroll
                for (int m = 0; m < 4; ++m) { const size_t off = (size_t)(row0 + ai * 128 + m * 16) * DM + col0;
#pragma unroll
                    for (int bj = 0; bj < 2; ++bj) { f32x4 b0, b1; xunpack8(xb[m][bj], b0, b1);
                        *(u32x4*)(out + off + bj * 128) = xpack8(b0 + gv[bj][0] * acc[ai][bj][m][0], b1 + gv[bj][1] * acc[ai][bj][m][1]); } }
                asm volatile("" ::: "memory");
            }
        }
    }
};
__device__ __forceinline__ float silu_f(float x) { return x * __builtin_amdgcn_rcpf(1.f + __builtin_amdgcn_exp2f(-1.4426950408889634f * x)); }
struct EpiSwiGLU {
    static constexpr bool PERM = true;
    bf16_t* O;
    __device__ __forceinline__ void operator()(const Acc& acc, const pg8::Unit& u, int wr, int wc, int fr, int fq) const {
        const int row0 = u.pm * 256 + wr * 64 + fr, col0 = u.pn * 128 + wc * 32 + 8 * fq;
#pragma unroll
        for (int ai = 0; ai < 2; ++ai)
#pragma unroll
            for (int m = 0; m < 4; ++m) { f32x4 o0, o1;
#pragma unroll
                for (int e = 0; e < 4; ++e) { o0[e] = silu_f(acc[ai][0][m][0][e]) * acc[ai][1][m][0][e]; o1[e] = silu_f(acc[ai][0][m][1][e]) * acc[ai][1][m][1][e]; }
                *(u32x4*)(O + (size_t)(row0 + ai * 128 + m * 16) * FF + col0) = pack8(o0, o1); }
    }
};
__device__ __forceinline__ void rope8(f32x4& v0, f32x4& v1, const f32x4 cs0, const f32x4 cs1) {
    const float a0 = v0[0] * cs0[0] - v0[1] * cs0[1], b0 = v0[1] * cs0[0] + v0[0] * cs0[1];
    const float a1 = v0[2] * cs0[2] - v0[3] * cs0[3], b1 = v0[3] * cs0[2] + v0[2] * cs0[3];
    const float a2 = v1[0] * cs1[0] - v1[1] * cs1[1], b2 = v1[1] * cs1[0] + v1[0] * cs1[1];
    const float a3 = v1[2] * cs1[2] - v1[3] * cs1[3], b3 = v1[3] * cs1[2] + v1[2] * cs1[3];
    v0 = (f32x4){a0, b0, a1, b1}; v1 = (f32x4){a2, b2, a3, b3};
}
struct EpiDQKV {
    static constexpr bool PERM = true;
    bf16_t* QA; bf16_t* CKV; bf16_t* KR; float* SSQ; float* SSKV; const float* TAB;
    __device__ __forceinline__ void operator()(const Acc& acc, const pg8::Unit& u, int wr, int wc, int fr, int fq) const {
        const int row0 = u.pm * 256 + wr * 64 + fr;
        if (u.pn < 4) {
            bf16_t* O = (u.pn < 2) ? QA : CKV; float* SS = (u.pn < 2) ? SSQ : SSKV; const int ct = u.pn & 1, col0 = ct * 256 + wc * 32 + 8 * fq;
#pragma unroll
            for (int ai = 0; ai < 2; ++ai)
#pragma unroll
                for (int m = 0; m < 4; ++m) { const int row = row0 + ai * 128 + m * 16; float s = 0.f;
#pragma unroll
                    for (int bj = 0; bj < 2; ++bj) { const f32x4 v0 = acc[ai][bj][m][0], v1 = acc[ai][bj][m][1];
                        s += (v0[0] * v0[0] + v0[1] * v0[1]) + (v0[2] * v0[2] + v0[3] * v0[3]) + (v1[0] * v1[0] + v1[1] * v1[1]) + (v1[2] * v1[2] + v1[3] * v1[3]);
                        *(u32x4*)(O + (size_t)row * 512 + col0 + bj * 128) = pack8(v0, v1); }
                    s = xor_add<16>(s); s = xor_add<32>(s);
                    if (fq == 0) SS[(size_t)row * 8 + ct * 4 + wc] = s; }
        } else if (wc < 2) {
            const int col0 = wc * 32 + 8 * fq;
#pragma unroll
            for (int ai = 0; ai < 2; ++ai) { f32x4 t0[4], t1[4];
#pragma unroll
                for (int m = 0; m < 4; ++m) { const int row = row0 + ai * 128 + m * 16, rr = row < SEQ ? row : 0, pos = wc ? (rr & 63) : (rr >> 6); const f32x4* t = (const f32x4*)(TAB + (size_t)(pos * 16 + 4 * fq) * 2); t0[m] = t[0]; t1[m] = t[1]; }
#pragma unroll
                for (int m = 0; m < 4; ++m) { const int row = row0 + ai * 128 + m * 16; f32x4 v0 = acc[ai][0][m][0], v1 = acc[ai][0][m][1];
                    if (row < SEQ) rope8(v0, v1, t0[m], t1[m]);
                    *(u32x4*)(KR + (size_t)row * 64 + col0) = pack8(v0, v1); }
                asm volatile("" ::: "memory"); }
        }
    }
};
__device__ __forceinline__ float row_rstd8(const float* ss, int row, float inv_n) {
    const f32x4 a = *(const f32x4*)(ss + (size_t)row * 8), b = *(const f32x4*)(ss + (size_t)row * 8 + 4);
    return __builtin_amdgcn_rsqf(((a[0] + a[1]) + (a[2] + a[3]) + (b[0] + b[1]) + (b[2] + b[3])) * inv_n + EPS);
}
struct EpiUQ {
    static constexpr bool PERM = true;
    bf16_t* Q; const float* SSQ; const float* TAB;
    __device__ __forceinline__ void operator()(const Acc& acc, const pg8::Unit& u, int wr, int wc, int fr, int fq) const {
        const int row0 = u.pm * 256 + wr * 64 + fr;
        int c0[2], ropei[2];
#pragma unroll
        for (int bj = 0; bj < 2; ++bj) { c0[bj] = u.pn * 256 + bj * 128 + wc * 32 + 8 * fq; const int d0 = c0[bj] % QHD; ropei[bj] = (d0 >= QKN) ? ((d0 - QKN) >> 1) : -1; }
#pragma unroll
        for (int ai = 0; ai < 2; ++ai) {
            f32x4 sa[4], sb[4], t0[4], t1[4];
            const int ri = ropei[0] >= 0 ? ropei[0] : ropei[1];
#pragma unroll
            for (int m = 0; m < 4; ++m) { const int row = row0 + ai * 128 + m * 16; sa[m] = *(const f32x4*)(SSQ + (size_t)row * 8); sb[m] = *(const f32x4*)(SSQ + (size_t)row * 8 + 4); }
            if (ri >= 0) {
#pragma unroll
                for (int m = 0; m < 4; ++m) { const int row = row0 + ai * 128 + m * 16, rr = row < SEQ ? row : 0, pos = (ri >> 4) ? (rr & 63) : (rr >> 6); const f32x4* t = (const f32x4*)(TAB + (size_t)(pos * 16 + (ri & 15)) * 2); t0[m] = t[0]; t1[m] = t[1]; } }
#pragma unroll
            for (int m = 0; m < 4; ++m) { const int row = row0 + ai * 128 + m * 16;
                const float rs = __builtin_amdgcn_rsqf(((sa[m][0] + sa[m][1]) + (sa[m][2] + sa[m][3]) + (sb[m][0] + sb[m][1]) + (sb[m][2] + sb[m][3])) * (1.f / QLORA) + EPS);
#pragma unroll
                for (int bj = 0; bj < 2; ++bj) { f32x4 v0 = acc[ai][bj][m][0] * rs, v1 = acc[ai][bj][m][1] * rs;
                    if (ropei[bj] >= 0 && row < SEQ) rope8(v0, v1, t0[m], t1[m]);
                    *(u32x4*)(Q + (size_t)row * NQ + c0[bj]) = pack8(v0 * QSCALE, v1 * QSCALE); } }
            asm volatile("" ::: "memory");
        }
    }
};
struct EpiUKV {
    static constexpr bool PERM = true;
    bf16_t* KN; bf16_t* V; const float* SSKV;
    __device__ __forceinline__ void operator()(const Acc& acc, const pg8::Unit& u, int wr, int wc, int fr, int fq) const {
        const int row0 = u.pm * 256 + wr * 64 + fr, col0 = u.pn * 128 + wc * 32 + 8 * fq;
#pragma unroll
        for (int ai = 0; ai < 2; ++ai) {
            f32x4 sa[4], sb[4];
#pragma unroll
            for (int m = 0; m < 4; ++m) { const int row = row0 + ai * 128 + m * 16; sa[m] = *(const f32x4*)(SSKV + (size_t)row * 8); sb[m] = *(const f32x4*)(SSKV + (size_t)row * 8 + 4); }
#pragma unroll
            for (int m = 0; m < 4; ++m) { const int row = row0 + ai * 128 + m * 16;
                const float rs = __builtin_amdgcn_rsqf(((sa[m][0] + sa[m][1]) + (sa[m][2] + sa[m][3]) + (sb[m][0] + sb[m][1]) + (sb[m][2] + sb[m][3])) * (1.f / KVLORA) + EPS);
                *(u32x4*)(KN + (size_t)row * DM + col0) = pack8(acc[ai][0][m][0] * rs, acc[ai][0][m][1] * rs);
                *(u32x4*)(V + (size_t)row * DM + col0) = pack8(acc[ai][1][m][0] * rs, acc[ai][1][m][1] * rs); }
            asm volatile("" ::: "memory");
        }
    }
};

template <class Main> struct EpiWithSlab {
    static constexpr bool PERM = Main::PERM;
    static_assert(Main::PERM, "slab layout assumes 8 consecutive columns per lane");
    Main main; bf16_t* slab; int ldc;
    __device__ __forceinline__ void operator()(const Acc& acc, const pg8::Unit& u, int wr, int wc, int fr, int fq) const {
        if (u.pm != 32) { main(acc, u, wr, wc, fr, fq); return; }
        bf16_t* sp = slab + (size_t)u.aux * 256 * ldc + (size_t)(wr * 64 + fr) * ldc + u.pn * 256 + wc * 32 + 8 * fq;
#pragma unroll
        for (int ai = 0; ai < 2; ++ai)
#pragma unroll
            for (int m = 0; m < 4; ++m) { bf16_t* rp = sp + (size_t)(ai * 128 + m * 16) * ldc;
#pragma unroll
                for (int bj = 0; bj < 2; ++bj) *(u32x4*)(rp + bj * 128) = xpack8(acc[ai][bj][m][0], acc[ai][bj][m][1]); }
    }
};

namespace att {
__device__ __forceinline__ int crow(int r, int hi) { return (r & 3) + 8 * (r >> 2) + 4 * hi; }
constexpr float THR = 8.f;
__device__ __forceinline__ void partialSM(f32x16& p0, f32x16& p1, float& m_reg, float& alpha) {
    float pmax = p0[0];
#pragma unroll
    for (int r = 1; r < 16; ++r) pmax = fmaxf(pmax, p0[r]);
#pragma unroll
    for (int r = 0; r < 16; ++r) pmax = fmaxf(pmax, p1[r]);
    { auto rr = __builtin_amdgcn_permlane32_swap(__float_as_uint(pmax), __float_as_uint(pmax), false, false); pmax = fmaxf(__uint_as_float(rr[0]), __uint_as_float(rr[1])); }
    float mn;
    if (__builtin_expect(__all(pmax - m_reg <= THR), 1)) { mn = m_reg; alpha = 1.f; }
    else { mn = fmaxf(m_reg, pmax); alpha = __builtin_amdgcn_exp2f(m_reg - mn); m_reg = mn; }
#pragma unroll
    for (int r = 0; r < 16; ++r) { p0[r] = __builtin_amdgcn_exp2f(p0[r] - mn); p1[r] = p1[r] - mn; }
}
__device__ __forceinline__ void finishSM(const f32x16& p0, f32x16& p1, float alpha, float& l_reg, bf16x8& pa0, bf16x8& pa1, bf16x8& pa2, bf16x8& pa3) {
#pragma unroll
    for (int r = 0; r < 16; ++r) p1[r] = __builtin_amdgcn_exp2f(p1[r]);
    float ps = 0;
#pragma unroll
    for (int r = 0; r < 16; ++r) ps += p0[r];
#pragma unroll
    for (int r = 0; r < 16; ++r) ps += p1[r];
    { auto rr = __builtin_amdgcn_permlane32_swap(__float_as_uint(ps), __float_as_uint(ps), false, false); ps = __uint_as_float(rr[0]) + __uint_as_float(rr[1]); }
    l_reg = l_reg * alpha + ps;
#define PK4(P, BASE, OUT) do { unsigned a0 = cvt_pk_bf16(P[BASE + 0], P[BASE + 1]), a1 = cvt_pk_bf16(P[BASE + 2], P[BASE + 3]);   \
    unsigned b0 = cvt_pk_bf16(P[BASE + 4], P[BASE + 5]), b1 = cvt_pk_bf16(P[BASE + 6], P[BASE + 7]);                              \
    auto r0 = __builtin_amdgcn_permlane32_swap(a0, b0, false, false); auto r1 = __builtin_amdgcn_permlane32_swap(a1, b1, false, false); \
    u32x4 w = {r0[0], r1[0], r0[1], r1[1]}; OUT = *reinterpret_cast<bf16x8*>(&w); } while (0)
    PK4(p0, 0, pa0); PK4(p0, 8, pa1); PK4(p1, 0, pa2); PK4(p1, 8, pa3);
#undef PK4
}
__device__ __forceinline__ void unit_simple(const bf16_t* __restrict__ Q, const bf16_t* __restrict__ KN, const bf16_t* __restrict__ KR, const bf16_t* __restrict__ V, bf16_t* __restrict__ O,
                                            int h, int q0, int k0, int nkeys, LAS float* wsf) {
    const int tid = otid(), wid = tid >> 6, lane = tid & 63, r32 = lane & 31, hi = lane >> 5;
    const bf16_t* Qw = Q + (size_t)(q0 + wid * 32 + r32) * NQ + h * QHD + hi * 8;
    bf16x8 qn[8], qp[4];
#pragma unroll
    for (int d0 = 0; d0 < 8; ++d0) qn[d0] = *(const bf16x8*)(Qw + d0 * 16);
#pragma unroll
    for (int d0 = 0; d0 < 4; ++d0) qp[d0] = *(const bf16x8*)(Qw + QKN + d0 * 16);
    float m_reg = -1e30f, l_reg = 0.f; f32x16 o[4];
#pragma unroll
    for (int d = 0; d < 4; ++d) o[d] = f32x16{};
    for (int kt = 0; kt < nkeys; kt += 64) {
        f32x16 p0 = f32x16{}, p1 = f32x16{};
        const bf16_t* kn0 = KN + (size_t)(k0 + kt + r32) * DM + h * QKN + hi * 8; const bf16_t* kn1 = kn0 + (size_t)32 * DM;
#pragma unroll
        for (int d0 = 0; d0 < 8; ++d0) { const bf16x8 b0 = *(const bf16x8*)(kn0 + d0 * 16), b1 = *(const bf16x8*)(kn1 + d0 * 16);
            p0 = __builtin_amdgcn_mfma_f32_32x32x16_bf16(b0, qn[d0], p0, 0, 0, 0); p1 = __builtin_amdgcn_mfma_f32_32x32x16_bf16(b1, qn[d0], p1, 0, 0, 0); }
        const bf16_t* kr0 = KR + (size_t)(k0 + kt + r32) * QKR + hi * 8; const bf16_t* kr1 = kr0 + 32 * QKR;
#pragma unroll
        for (int d0 = 0; d0 < 4; ++d0) { const bf16x8 b0 = *(const bf16x8*)(kr0 + d0 * 16), b1 = *(const bf16x8*)(kr1 + d0 * 16);
            p0 = __builtin_amdgcn_mfma_f32_32x32x16_bf16(b0, qp[d0], p0, 0, 0, 0); p1 = __builtin_amdgcn_mfma_f32_32x32x16_bf16(b1, qp[d0], p1, 0, 0, 0); }
        float alpha; partialSM(p0, p1, m_reg, alpha);
        if (__any(alpha < 1.f)) { if (hi == 0) wsf[r32] = alpha; asm volatile("s_waitcnt lgkmcnt(0)" ::: "memory");
#pragma unroll
            for (int d = 0; d < 4; ++d)
#pragma unroll
                for (int r = 0; r < 16; ++r) o[d][r] *= wsf[crow(r, hi)];
            asm volatile("s_waitcnt lgkmcnt(0)" ::: "memory"); }
        bf16x8 pa[4]; finishSM(p0, p1, alpha, l_reg, pa[0], pa[1], pa[2], pa[3]);
#pragma unroll
        for (int ks = 0; ks < 4; ++ks) { const bf16_t* vb = V + (size_t)(k0 + kt + 16 * ks + 8 * hi) * DM + h * VD + r32;
#pragma unroll
            for (int d0 = 0; d0 < 4; ++d0) { bf16x8 bv;
#pragma unroll
                for (int j = 0; j < 8; ++j) bv[j] = (short)vb[(size_t)j * DM + d0 * 32];
                o[d0] = __builtin_amdgcn_mfma_f32_32x32x16_bf16(pa[ks], bv, o[d0], 0, 0, 0); } }
    }
    if (hi == 0) wsf[32 + r32] = l_reg; asm volatile("s_waitcnt lgkmcnt(0)" ::: "memory");
    bf16_t* Ow = O + (size_t)(q0 + wid * 32) * DM + h * VD + r32;
#pragma unroll
    for (int r = 0; r < 16; ++r) { const int orow = crow(r, hi); const float rl = __builtin_amdgcn_rcpf(wsf[32 + orow]);
#pragma unroll
        for (int d0 = 0; d0 < 4; ++d0) Ow[(size_t)orow * DM + d0 * 32] = (bf16_t)(cvt_pk_bf16(o[d0][r] * rl, 0.f) & 0xffffu); }
    asm volatile("s_waitcnt lgkmcnt(0)" ::: "memory");
}

constexpr int KN_SLOT = 16384, KR_SLOT = 8192, V_SLOT = 16384;
constexpr int L_KN = 0, L_KR = 3 * KN_SLOT, L_V = L_KR + 3 * KR_SLOT, L_WS = L_V + 3 * V_SLOT, ATT_LDS = L_WS + 8 * 256;
__device__ __forceinline__ void glds16(const void* gsrc, unsigned lds_dst) { unsigned keep;
    asm volatile("s_mov_b32 %0, m0\n\ts_mov_b32 m0, %2\n\ts_nop 0\n\tglobal_load_lds_dwordx4 %1, off\n\ts_mov_b32 m0, %0" : "=&s"(keep) : "v"(gsrc), "s"(lds_dst) : "memory"); }
__device__ __forceinline__ void glds16s(const char* sbase, unsigned voff, unsigned lds_dst) {
    asm volatile("s_mov_b32 m0, %2\n\ts_nop 0\n\tglobal_load_lds_dwordx4 %1, %0" :: "s"(sbase), "v"(voff), "s"(lds_dst) : "memory", "m0"); }
typedef short s16x4 __attribute__((ext_vector_type(4)));
__device__ __forceinline__ int v_rd_base(int lane) { return ((lane & 3) << 3) | (((lane >> 2) & 3) << 6) | (((lane >> 4) & 1) << 5) | (((lane >> 5) & 1) << 8); }
constexpr int v_rd_off(int d0, int ks, int half) { return d0 * 512 + ks * 4096 + half * 2048; }
template <int OFF> __device__ __forceinline__ s16x4 tr_read(int vb) { s16x4 r; asm volatile("ds_read_b64_tr_b16 %0, %1 offset:%2" : "=&v"(r) : "v"(vb), "i"(OFF) : "memory"); return r; }
template <int D0> __device__ __forceinline__ void pv_one(f32x16& od, int vb, bf16x8 pa0, bf16x8 pa1, bf16x8 pa2, bf16x8 pa3) {
    const s16x4 l0 = tr_read<v_rd_off(D0, 0, 0)>(vb), h0 = tr_read<v_rd_off(D0, 0, 1)>(vb), l1 = tr_read<v_rd_off(D0, 1, 0)>(vb), h1 = tr_read<v_rd_off(D0, 1, 1)>(vb);
    const s16x4 l2 = tr_read<v_rd_off(D0, 2, 0)>(vb), h2 = tr_read<v_rd_off(D0, 2, 1)>(vb), l3 = tr_read<v_rd_off(D0, 3, 0)>(vb), h3 = tr_read<v_rd_off(D0, 3, 1)>(vb);
    asm volatile("s_waitcnt lgkmcnt(0)" ::: "memory"); __builtin_amdgcn_sched_barrier(0);
#define PK(L, H) (bf16x8){L[0], L[1], L[2], L[3], H[0], H[1], H[2], H[3]}
    od = __builtin_amdgcn_mfma_f32_32x32x16_bf16(pa0, PK(l0, h0), od, 0, 0, 0);
    od = __builtin_amdgcn_mfma_f32_32x32x16_bf16(pa1, PK(l1, h1), od, 0, 0, 0);
    od = __builtin_amdgcn_mfma_f32_32x32x16_bf16(pa2, PK(l2, h2), od, 0, 0, 0);
    od = __builtin_amdgcn_mfma_f32_32x32x16_bf16(pa3, PK(l3, h3), od, 0, 0, 0);
#undef PK
}
__device__ __forceinline__ void pv_d0(f32x16* o, int vb, bf16x8 pa0, bf16x8 pa1, bf16x8 pa2, bf16x8 pa3) {
    pv_one<0>(o[0], vb, pa0, pa1, pa2, pa3); pv_one<1>(o[1], vb, pa0, pa1, pa2, pa3); pv_one<2>(o[2], vb, pa0, pa1, pa2, pa3); pv_one<3>(o[3], vb, pa0, pa1, pa2, pa3);
}
__device__ __forceinline__ void qkt(f32x16& p0, f32x16& p1, LAS unsigned char* kn, LAS unsigned char* kr, const bf16x8* qn, const bf16x8* qp, int r32, int hi) {
    p0 = f32x16{}; p1 = f32x16{};
#pragma unroll
    for (int d0 = 0; d0 < 8; ++d0) { const int cb = ((2 * d0 + hi) ^ (r32 & 15)) * 16;
        const bf16x8 b0 = *(const LAS bf16x8*)(kn + r32 * 256 + cb), b1 = *(const LAS bf16x8*)(kn + 8192 + r32 * 256 + cb);
        p0 = __builtin_amdgcn_mfma_f32_32x32x16_bf16(b0, qn[d0], p0, 0, 0, 0); p1 = __builtin_amdgcn_mfma_f32_32x32x16_bf16(b1, qn[d0], p1, 0, 0, 0); }
#pragma unroll
    for (int d0 = 0; d0 < 4; ++d0) { const int cb = ((2 * d0 + hi) ^ ((r32 >> 1) & 7)) * 16;
        const bf16x8 b0 = *(const LAS bf16x8*)(kr + r32 * 128 + cb), b1 = *(const LAS bf16x8*)(kr + 4096 + r32 * 128 + cb);
        p0 = __builtin_amdgcn_mfma_f32_32x32x16_bf16(b0, qp[d0], p0, 0, 0, 0); p1 = __builtin_amdgcn_mfma_f32_32x32x16_bf16(b1, qp[d0], p1, 0, 0, 0); }
}

typedef short v4i16_t __attribute__((ext_vector_type(4)));
template <int OFF> __device__ __forceinline__ s16x4 tr_rd(int vb) { return __builtin_bit_cast(s16x4, __builtin_amdgcn_ds_read_tr16_b64_v4i16((LAS v4i16_t*)(vb + OFF))); }
template <bool NOLDS> __device__ __forceinline__ void qkt_p(f32x16& p0, f32x16& p1, LAS unsigned char* kn, LAS unsigned char* kr, const bf16x8* qn, const bf16x8* qp, int r32, int hi) {
    const int swn = r32 & 15, swr = (r32 >> 1) & 7;
    LAS unsigned char* knr = kn + r32 * 256; LAS unsigned char* krr = kr + r32 * 128;
    bf16x8 k0[3], k1[3];
    p0 = f32x16{}; p1 = f32x16{};
#define KRD(D, I) do { if (NOLDS) { k0[I] = qn[(D) & 7]; k1[I] = qn[((D) + 1) & 7]; } else if ((D) < 8) { const int cb = ((2 * (D) + hi) ^ swn) * 16; k0[I] = *(const LAS bf16x8*)(knr + cb); k1[I] = *(const LAS bf16x8*)(knr + 8192 + cb); } \
                       else { const int cb = ((2 * ((D) - 8) + hi) ^ swr) * 16; k0[I] = *(const LAS bf16x8*)(krr + cb); k1[I] = *(const LAS bf16x8*)(krr + 4096 + cb); } } while (0)
    KRD(0, 0); KRD(1, 1); __builtin_amdgcn_sched_barrier(0);
#pragma unroll
    for (int D = 0; D < 12; ++D) {
        if (D + 2 < 12) KRD(D + 2, (D + 2) % 3);
        __builtin_amdgcn_sched_barrier(0);
        const bf16x8 q = D < 8 ? qn[D & 7] : qp[(D - 8) & 3];
        p0 = __builtin_amdgcn_mfma_f32_32x32x16_bf16(k0[D % 3], q, p0, 0, 0, 0); p1 = __builtin_amdgcn_mfma_f32_32x32x16_bf16(k1[D % 3], q, p1, 0, 0, 0);
        __builtin_amdgcn_sched_barrier(0);
    }
#undef KRD
}
template <bool NOLDS> __device__ __forceinline__ void pv_p(f32x16* o, int vb, bf16x8 pa0, bf16x8 pa1, bf16x8 pa2, bf16x8 pa3) {
    s16x4 va[8], vq[8];
#define VRD8(D0, X) do { if (NOLDS) { _Pragma("unroll") for (int _e = 0; _e < 8; ++_e) X[_e] = (s16x4){pa0[_e], pa1[_e], pa2[_e], pa3[_e]}; } else { X[0] = tr_rd<v_rd_off(D0, 0, 0)>(vb); X[1] = tr_rd<v_rd_off(D0, 0, 1)>(vb); X[2] = tr_rd<v_rd_off(D0, 1, 0)>(vb); X[3] = tr_rd<v_rd_off(D0, 1, 1)>(vb); \
                         X[4] = tr_rd<v_rd_off(D0, 2, 0)>(vb); X[5] = tr_rd<v_rd_off(D0, 2, 1)>(vb); X[6] = tr_rd<v_rd_off(D0, 3, 0)>(vb); X[7] = tr_rd<v_rd_off(D0, 3, 1)>(vb); } } while (0)
#define PKV(L, H) (bf16x8){L[0], L[1], L[2], L[3], H[0], H[1], H[2], H[3]}
#define PV4(OD, X) do { OD = __builtin_amdgcn_mfma_f32_32x32x16_bf16(pa0, PKV(X[0], X[1]), OD, 0, 0, 0); OD = __builtin_amdgcn_mfma_f32_32x32x16_bf16(pa1, PKV(X[2], X[3]), OD, 0, 0, 0); \
                         OD = __builtin_amdgcn_mfma_f32_32x32x16_bf16(pa2, PKV(X[4], X[5]), OD, 0, 0, 0); OD = __builtin_amdgcn_mfma_f32_32x32x16_bf16(pa3, PKV(X[6], X[7]), OD, 0, 0, 0); } while (0)
    VRD8(0, va); __builtin_amdgcn_sched_barrier(0);
    VRD8(1, vq); __builtin_amdgcn_sched_barrier(0); PV4(o[0], va); __builtin_amdgcn_sched_barrier(0);
    VRD8(2, va); __builtin_amdgcn_sched_barrier(0); PV4(o[1], vq); __builtin_amdgcn_sched_barrier(0);
    VRD8(3, vq); __builtin_amdgcn_sched_barrier(0); PV4(o[2], va); __builtin_amdgcn_sched_barrier(0);
    PV4(o[3], vq); __builtin_amdgcn_sched_barrier(0);
#undef VRD8
#undef PKV
#undef PV4
}
#define ATT_WAIT_BAR(N) asm volatile("s_waitcnt vmcnt(" #N ") lgkmcnt(0)\n\ts_barrier" ::: "memory")
__device__ __forceinline__ void unit_fast(const bf16_t* __restrict__ Q, const bf16_t* __restrict__ KN, const bf16_t* __restrict__ KR, const bf16_t* __restrict__ V, bf16_t* __restrict__ O,
                                          int h, int q0, int k0, int nkeys, LAS unsigned char* lds) {
    const int tid = otid(), wid = __builtin_amdgcn_readfirstlane(tid >> 6), lane = tid & 63, r32 = lane & 31, hi = lane >> 5;
    const unsigned lds0 = (unsigned)(uintptr_t)lds;
    LAS float* wsf = (LAS float*)(lds + L_WS) + wid * 64;
    unsigned kn_off[2], v_off[2], kr_off;
#pragma unroll
    for (int i = 0; i < 2; ++i) { const int row = 8 * wid + 4 * i + (lane >> 4), lc = (lane & 15) ^ (row & 15); kn_off[i] = (unsigned)(row * DM * 2 + h * QKN * 2 + lc * 16);
        const int s = 2 * (2 * wid + i) + (lane >> 5), kk = 8 * (s >> 2) + ((lane & 31) >> 2), k = (kk & ~0xC) | ((kk & 4) << 1) | ((kk & 8) >> 1), c = 32 * (s & 3) + 8 * (lane & 3);
        v_off[i] = (unsigned)(k * DM * 2 + h * VD * 2 + c * 2); }
    { const int row = 8 * wid + (lane >> 3), lc = (lane & 7) ^ ((row >> 1) & 7); kr_off = (unsigned)(row * QKR * 2 + lc * 16); }
    const char* KNg = (const char*)(KN + (size_t)k0 * DM); const char* KRg = (const char*)(KR + (size_t)k0 * QKR); const char* Vg = (const char*)(V + (size_t)k0 * DM);
    const unsigned dK = lds0 + L_KN + 2 * wid * 1024, dR = lds0 + L_KR + wid * 1024, dV = lds0 + L_V + 2 * wid * 1024;
#define DMA_K(t, sl) do { const char* _g = KNg + (size_t)(t) * (64 * DM * 2); const unsigned _d = (unsigned)__builtin_amdgcn_readfirstlane(dK + (sl) * KN_SLOT); \
        glds16(_g + kn_off[0], _d); glds16(_g + kn_off[1], _d + 1024); glds16(KRg + (size_t)(t) * (64 * QKR * 2) + kr_off, (unsigned)__builtin_amdgcn_readfirstlane(dR + (sl) * KR_SLOT)); } while (0)
#define DMA_V(t, sl) do { const char* _g = Vg + (size_t)(t) * (64 * DM * 2); const unsigned _d = (unsigned)__builtin_amdgcn_readfirstlane(dV + (sl) * V_SLOT); \
        glds16(_g + v_off[0], _d); glds16(_g + v_off[1], _d + 1024); } while (0)
    const int NT = nkeys / 64;
    DMA_K(0, 0); DMA_V(0, 0); DMA_K(1, 1);
    const bf16_t* Qw = Q + (size_t)(q0 + wid * 32 + r32) * NQ + h * QHD + hi * 8;
    bf16x8 qn[8], qp[4];
#pragma unroll
    for (int d0 = 0; d0 < 8; ++d0) qn[d0] = *(const bf16x8*)(Qw + d0 * 16);
#pragma unroll
    for (int d0 = 0; d0 < 4; ++d0) qp[d0] = *(const bf16x8*)(Qw + QKN + d0 * 16);
    float m_reg = -1e30f, l_reg = 0.f; f32x16 o[4];
#pragma unroll
    for (int d = 0; d < 4; ++d) o[d] = f32x16{};
    const int vb0 = (int)(lds0 + L_V) + v_rd_base(lane);
    f32x16 pA0, pA1, pB0, pB1; float alA, alB; bf16x8 pa0, pa1, pa2, pa3;
    int sa = 0, sb = 1, sc = 2;
#define ROT() do { const int _t = sa; sa = sb; sb = sc; sc = _t; } while (0)
#define RESC(a) do { if (__any((a) < 1.f)) { if (hi == 0) wsf[r32] = (a); asm volatile("s_waitcnt lgkmcnt(0)" ::: "memory"); \
        _Pragma("unroll") for (int d = 0; d < 4; ++d) _Pragma("unroll") for (int r = 0; r < 16; ++r) o[d][r] *= wsf[crow(r, hi)]; } } while (0)
    ATT_WAIT_BAR(0);
    { DMA_K((2 < NT ? 2 : NT - 1), sc); DMA_V(1, sb);
      qkt(pA0, pA1, lds + L_KN + sa * KN_SLOT, lds + L_KR + sa * KR_SLOT, qn, qp, r32, hi); partialSM(pA0, pA1, m_reg, alA);
      ATT_WAIT_BAR(5); ROT(); }
#define STEP(j, C0, C1, alC, P0, P1, alP) do { const int _kt = ((j) + 2 < NT) ? (j) + 2 : NT - 1, _vt = ((j) + 1 < NT) ? (j) + 1 : NT - 1; \
        DMA_K(_kt, sc); DMA_V(_vt, sb); __builtin_amdgcn_sched_barrier(0); \
        qkt_p<false>(C0, C1, lds + L_KN + sa * KN_SLOT, lds + L_KR + sa * KR_SLOT, qn, qp, r32, hi); \
        finishSM(P0, P1, alP, l_reg, pa0, pa1, pa2, pa3); __builtin_amdgcn_sched_barrier(0); \
        pv_p<false>(o, vb0 + sc * V_SLOT, pa0, pa1, pa2, pa3); \
        partialSM(C0, C1, m_reg, alC); RESC(alC); \
        ATT_WAIT_BAR(5); ROT(); } while (0)
#pragma unroll 1
    for (int j = 1; j + 1 < NT; j += 2) { STEP(j, pB0, pB1, alB, pA0, pA1, alA); STEP(j + 1, pA0, pA1, alA, pB0, pB1, alB); }
    STEP(NT - 1, pB0, pB1, alB, pA0, pA1, alA);
    finishSM(pB0, pB1, alB, l_reg, pa0, pa1, pa2, pa3); __builtin_amdgcn_sched_barrier(0);
    pv_d0(o, vb0 + sc * V_SLOT, pa0, pa1, pa2, pa3);
    if (hi == 0) wsf[32 + r32] = l_reg;
    ATT_WAIT_BAR(0);
    { LAS bf16_t* stg = (LAS bf16_t*)(lds + wid * 8192);
#pragma unroll
      for (int r = 0; r < 16; ++r) { const int orow = crow(r, hi); const float rl = __builtin_amdgcn_rcpf(wsf[32 + orow]);
#pragma unroll
          for (int d0 = 0; d0 < 4; ++d0) stg[orow * 128 + d0 * 32 + r32] = (bf16_t)(cvt_pk_bf16(o[d0][r] * rl, 0.f) & 0xffffu); }
      asm volatile("s_waitcnt lgkmcnt(0)" ::: "memory");
      bf16_t* Ow = O + (size_t)(q0 + wid * 32) * DM + h * VD;
#pragma unroll
      for (int i = 0; i < 8; ++i) { const int row = i * 4 + (lane >> 4), ch = lane & 15; const u32x4 v = *(const LAS u32x4*)(stg + row * 128 + ch * 8); *(u32x4*)(Ow + (size_t)row * DM + ch * 8) = v; } }
    ATT_WAIT_BAR(0);
#undef DMA_K
#undef DMA_V
#undef ROT
#undef RESC
#undef STEP
}


#define SB0() __builtin_amdgcn_sched_barrier(0)
#define PIN(x) asm volatile("" : "+v"(x))
#define PKQ(P, BASE, OUT) do { unsigned a0 = cvt_pk_bf16(P[BASE + 0], P[BASE + 1]), a1 = cvt_pk_bf16(P[BASE + 2], P[BASE + 3]);   \
    unsigned b0 = cvt_pk_bf16(P[BASE + 4], P[BASE + 5]), b1 = cvt_pk_bf16(P[BASE + 6], P[BASE + 7]);                              \
    auto r0 = __builtin_amdgcn_permlane32_swap(a0, b0, false, false); auto r1 = __builtin_amdgcn_permlane32_swap(a1, b1, false, false); \
    u32x4 w = {r0[0], r1[0], r0[1], r1[1]}; OUT = *reinterpret_cast<bf16x8*>(&w); } while (0)
__device__ __forceinline__ void regionA(f32x16& c0, f32x16& c1, LAS unsigned char* kn, LAS unsigned char* kr, const bf16x8* qn, const bf16x8* qp, int r32, int hi,
                                        f32x16& P0, f32x16& P1, float alP, float& l_reg, bf16x8& pa0, bf16x8& pa1, bf16x8& pa2, bf16x8& pa3,
                                        const char* gk, const char* gkr, unsigned ko0, unsigned ko1, unsigned kro, unsigned dk, unsigned dr) {
    const int swn = r32 & 15, swr = (r32 >> 1) & 7;
    LAS unsigned char* knr = kn + r32 * 256; LAS unsigned char* krr = kr + r32 * 128;
    bf16x8 ka0, ka1, kb0, kb1; float ps = 0.f, ps1 = 0.f, ps2 = 0.f, ps3 = 0.f;
    c0 = f32x16{}; c1 = f32x16{};
#define KRD(D, X0, X1) do { if ((D) < 8) { const int cb = ((2 * (D) + hi) ^ swn) * 16; X0 = *(const LAS bf16x8*)(knr + cb); X1 = *(const LAS bf16x8*)(knr + 8192 + cb); } \
                            else if ((D) < 12) { const int cb = ((2 * ((D) - 8) + hi) ^ swr) * 16; X0 = *(const LAS bf16x8*)(krr + cb); X1 = *(const LAS bf16x8*)(krr + 4096 + cb); } } while (0)
#define QOP(D) ((D) < 8 ? qn[(D) & 7] : qp[((D) - 8) & 3])
#define GAPA(D, X0, X1, WORK) do { \
        c0 = __builtin_amdgcn_mfma_f32_32x32x16_bf16(X0, QOP(D), c0, 0, 0, 0); c1 = __builtin_amdgcn_mfma_f32_32x32x16_bf16(X1, QOP(D), c1, 0, 0, 0); KRD((D) + 2, X0, X1); WORK; SB0(); } while (0)
    KRD(0, ka0, ka1); KRD(1, kb0, kb1); SB0();
    GAPA(0, ka0, ka1, { PKQ(P0, 0, pa0); PIN(pa0); });
    GAPA(1, kb0, kb1, { glds16s(gk, ko0, dk); PKQ(P0, 8, pa1); PIN(pa1); });
    GAPA(2, ka0, ka1, { _Pragma("unroll") for (int r = 0; r < 8; ++r) { ps += P0[r]; ps1 += P0[8 + r]; } PIN(ps); PIN(ps1); });
    GAPA(3, kb0, kb1, { _Pragma("unroll") for (int r = 0; r < 4; ++r) P1[r] = __builtin_amdgcn_exp2f(P1[r]); PIN(P1); });
    GAPA(4, ka0, ka1, { glds16s(gk, ko1, dk + 1024); _Pragma("unroll") for (int r = 4; r < 8; ++r) P1[r] = __builtin_amdgcn_exp2f(P1[r]); PIN(P1); });
    GAPA(5, kb0, kb1, { _Pragma("unroll") for (int r = 8; r < 12; ++r) P1[r] = __builtin_amdgcn_exp2f(P1[r]); PIN(P1); });
    GAPA(6, ka0, ka1, { _Pragma("unroll") for (int r = 12; r < 16; ++r) P1[r] = __builtin_amdgcn_exp2f(P1[r]); PIN(P1); });
    GAPA(7, kb0, kb1, { PKQ(P1, 0, pa2); PIN(pa2); });
    GAPA(8, ka0, ka1, { glds16s(gkr, kro, dr); PKQ(P1, 8, pa3); PIN(pa3); });
    GAPA(9, kb0, kb1, { _Pragma("unroll") for (int r = 0; r < 8; ++r) { ps2 += P1[r]; ps3 += P1[8 + r]; } PIN(ps2); PIN(ps3); });
    GAPA(10, ka0, ka1, { ps = (ps + ps1) + (ps2 + ps3); auto rr = __builtin_amdgcn_permlane32_swap(__float_as_uint(ps), __float_as_uint(ps), false, false); ps = __uint_as_float(rr[0]) + __uint_as_float(rr[1]); l_reg = l_reg * alP + ps; PIN(l_reg); });
    GAPA(11, kb0, kb1, { });
#undef KRD
#undef QOP
#undef GAPA
}
__device__ __forceinline__ void regionB(f32x16* o, int vb, bf16x8 pa0, bf16x8 pa1, bf16x8 pa2, bf16x8 pa3, f32x16& C0, f32x16& C1, float& m_reg, float& alC, const char* gv, unsigned vo0, unsigned vo1, unsigned dv) {
    s16x4 va[8]; float mn = 0.f;
#define VRD8(D0, X) do { X[0] = tr_rd<v_rd_off(D0, 0, 0)>(vb); X[1] = tr_rd<v_rd_off(D0, 0, 1)>(vb); X[2] = tr_rd<v_rd_off(D0, 1, 0)>(vb); X[3] = tr_rd<v_rd_off(D0, 1, 1)>(vb); \
                         X[4] = tr_rd<v_rd_off(D0, 2, 0)>(vb); X[5] = tr_rd<v_rd_off(D0, 2, 1)>(vb); X[6] = tr_rd<v_rd_off(D0, 3, 0)>(vb); X[7] = tr_rd<v_rd_off(D0, 3, 1)>(vb); } while (0)
#define PKV(L, H) (bf16x8){L[0], L[1], L[2], L[3], H[0], H[1], H[2], H[3]}
#define PV4(OD, X) do { OD = __builtin_amdgcn_mfma_f32_32x32x16_bf16(pa0, PKV(X[0], X[1]), OD, 0, 0, 0); OD = __builtin_amdgcn_mfma_f32_32x32x16_bf16(pa1, PKV(X[2], X[3]), OD, 0, 0, 0); \
                         OD = __builtin_amdgcn_mfma_f32_32x32x16_bf16(pa2, PKV(X[4], X[5]), OD, 0, 0, 0); OD = __builtin_amdgcn_mfma_f32_32x32x16_bf16(pa3, PKV(X[6], X[7]), OD, 0, 0, 0); } while (0)
    VRD8(0, va); SB0();
    PV4(o[0], va); VRD8(1, va);
    { float a = fmaxf(fmaxf(C0[0], C0[1]), C1[0]), b = fmaxf(fmaxf(C0[2], C0[3]), C1[1]); a = fmaxf(fmaxf(a, C1[2]), C1[3]);
      _Pragma("unroll") for (int r = 4; r < 16; r += 4) { a = fmaxf(fmaxf(a, C0[r]), C0[r + 1]); b = fmaxf(fmaxf(b, C0[r + 2]), C0[r + 3]); a = fmaxf(fmaxf(a, C1[r]), C1[r + 1]); b = fmaxf(fmaxf(b, C1[r + 2]), C1[r + 3]); }
      float pmax = fmaxf(a, b); { auto rr = __builtin_amdgcn_permlane32_swap(__float_as_uint(pmax), __float_as_uint(pmax), false, false); pmax = fmaxf(__uint_as_float(rr[0]), __uint_as_float(rr[1])); }
      const bool keep = __all(pmax - m_reg <= THR); mn = keep ? m_reg : fmaxf(m_reg, pmax); alC = keep ? 1.f : __builtin_amdgcn_exp2f(m_reg - mn); m_reg = mn; PIN(mn); PIN(alC); }
    SB0();
    PV4(o[1], va); VRD8(2, va);
    { glds16s(gv, vo0, dv); _Pragma("unroll") for (int r = 0; r < 16; ++r) { C0[r] -= mn; C1[r] -= mn; } PIN(C0); PIN(C1); }
    SB0();
    PV4(o[2], va); VRD8(3, va);
    { _Pragma("unroll") for (int r = 0; r < 8; ++r) C0[r] = __builtin_amdgcn_exp2f(C0[r]); PIN(C0); }
    SB0();
    PV4(o[3], va);
    { glds16s(gv, vo1, dv + 1024); _Pragma("unroll") for (int r = 8; r < 16; ++r) C0[r] = __builtin_amdgcn_exp2f(C0[r]); PIN(C0); }
    SB0();
#undef VRD8
#undef PKV
#undef PV4
}
__device__ __forceinline__ void unit_il(const bf16_t* __restrict__ Q, const bf16_t* __restrict__ KN, const bf16_t* __restrict__ KR, const bf16_t* __restrict__ V, bf16_t* __restrict__ O,
                                          int h, int q0, int k0, int nkeys, LAS unsigned char* lds) {
    const int tid = otid(), wid = __builtin_amdgcn_readfirstlane(tid >> 6), lane = tid & 63, r32 = lane & 31, hi = lane >> 5;
    const unsigned lds0 = (unsigned)(uintptr_t)lds;
    LAS float* wsf = (LAS float*)(lds + L_WS) + wid * 64;
    unsigned kn_off[2], v_off[2], kr_off;
#pragma unroll
    for (int i = 0; i < 2; ++i) { const int row = 8 * wid + 4 * i + (lane >> 4), lc = (lane & 15) ^ (row & 15); kn_off[i] = (unsigned)(row * DM * 2 + h * QKN * 2 + lc * 16);
        const int s = 2 * (2 * wid + i) + (lane >> 5), kk = 8 * (s >> 2) + ((lane & 31) >> 2), k = (kk & ~0xC) | ((kk & 4) << 1) | ((kk & 8) >> 1), c = 32 * (s & 3) + 8 * (lane & 3);
        v_off[i] = (unsigned)(k * DM * 2 + h * VD * 2 + c * 2); }
    { const int row = 8 * wid + (lane >> 3), lc = (lane & 7) ^ ((row >> 1) & 7); kr_off = (unsigned)(row * QKR * 2 + lc * 16); }
    const char* KNg = (const char*)(KN + (size_t)k0 * DM); const char* KRg = (const char*)(KR + (size_t)k0 * QKR); const char* Vg = (const char*)(V + (size_t)k0 * DM);
    const unsigned dK = lds0 + L_KN + 2 * wid * 1024, dR = lds0 + L_KR + wid * 1024, dV = lds0 + L_V + 2 * wid * 1024;
#define DMA_K(t, sl) do { const char* _g = KNg + (size_t)(t) * (64 * DM * 2); const unsigned _d = (unsigned)__builtin_amdgcn_readfirstlane(dK + (sl) * KN_SLOT); \
        glds16s(_g, kn_off[0], _d); glds16s(_g, kn_off[1], _d + 1024); glds16s(KRg + (size_t)(t) * (64 * QKR * 2), kr_off, (unsigned)__builtin_amdgcn_readfirstlane(dR + (sl) * KR_SLOT)); } while (0)
#define DMA_V(t, sl) do { const char* _g = Vg + (size_t)(t) * (64 * DM * 2); const unsigned _d = (unsigned)__builtin_amdgcn_readfirstlane(dV + (sl) * V_SLOT); \
        glds16s(_g, v_off[0], _d); glds16s(_g, v_off[1], _d + 1024); } while (0)
    const int NT = nkeys / 64;
    DMA_K(0, 0); DMA_V(0, 0); DMA_K(1, 1);
    const bf16_t* Qw = Q + (size_t)(q0 + wid * 32 + r32) * NQ + h * QHD + hi * 8;
    bf16x8 qn[8], qp[4];
#pragma unroll
    for (int d0 = 0; d0 < 8; ++d0) qn[d0] = *(const bf16x8*)(Qw + d0 * 16);
#pragma unroll
    for (int d0 = 0; d0 < 4; ++d0) qp[d0] = *(const bf16x8*)(Qw + QKN + d0 * 16);
    float m_reg = -1e30f, l_reg = 0.f; f32x16 o[4];
#pragma unroll
    for (int d = 0; d < 4; ++d) o[d] = f32x16{};
    const int vb0 = (int)(lds0 + L_V) + v_rd_base(lane);
    f32x16 pA0, pA1, pB0, pB1; float alA, alB; bf16x8 pa0, pa1, pa2, pa3;
    int sa = 0, sb = 1, sc = 2;
#define ROT() do { const int _t = sa; sa = sb; sb = sc; sc = _t; } while (0)
#define RESC(a) do { if (__any((a) < 1.f)) { if (hi == 0) wsf[r32] = (a); asm volatile("s_waitcnt lgkmcnt(0)" ::: "memory"); \
        _Pragma("unroll") for (int d = 0; d < 4; ++d) _Pragma("unroll") for (int r = 0; r < 16; ++r) o[d][r] *= wsf[crow(r, hi)]; } } while (0)
    ATT_WAIT_BAR(0);
    { DMA_K((2 < NT ? 2 : NT - 1), sc); DMA_V(1, sb);
      qkt(pA0, pA1, lds + L_KN + sa * KN_SLOT, lds + L_KR + sa * KR_SLOT, qn, qp, r32, hi); partialSM(pA0, pA1, m_reg, alA);
      ATT_WAIT_BAR(5); ROT(); }
#define STEP(j, C0, C1, alC, P0, P1, alP) do { const int _kt = ((j) + 2 < NT) ? (j) + 2 : NT - 1, _vt = ((j) + 1 < NT) ? (j) + 1 : NT - 1; \
        const char* _gk = KNg + (size_t)_kt * (64 * DM * 2); const char* _gv = Vg + (size_t)_vt * (64 * DM * 2); \
        const unsigned _dk = (unsigned)__builtin_amdgcn_readfirstlane(dK + sc * KN_SLOT), _dr = (unsigned)__builtin_amdgcn_readfirstlane(dR + sc * KR_SLOT), _dv = (unsigned)__builtin_amdgcn_readfirstlane(dV + sb * V_SLOT); SB0(); \
        regionA(C0, C1, lds + L_KN + sa * KN_SLOT, lds + L_KR + sa * KR_SLOT, qn, qp, r32, hi, P0, P1, alP, l_reg, pa0, pa1, pa2, pa3, _gk, KRg + (size_t)_kt * (64 * QKR * 2), kn_off[0], kn_off[1], kr_off, _dk, _dr); \
        regionB(o, vb0 + sc * V_SLOT, pa0, pa1, pa2, pa3, C0, C1, m_reg, alC, _gv, v_off[0], v_off[1], _dv); RESC(alC); \
        ATT_WAIT_BAR(5); ROT(); } while (0)
#pragma unroll 1
    for (int j = 1; j + 1 < NT; j += 2) { STEP(j, pB0, pB1, alB, pA0, pA1, alA); STEP(j + 1, pA0, pA1, alA, pB0, pB1, alB); }
    STEP(NT - 1, pB0, pB1, alB, pA0, pA1, alA);
    finishSM(pB0, pB1, alB, l_reg, pa0, pa1, pa2, pa3); __builtin_amdgcn_sched_barrier(0);
    pv_d0(o, vb0 + sc * V_SLOT, pa0, pa1, pa2, pa3);
    if (hi == 0) wsf[32 + r32] = l_reg;
    ATT_WAIT_BAR(0);
    { LAS bf16_t* stg = (LAS bf16_t*)(lds + wid * 8192);
#pragma unroll
      for (int r = 0; r < 16; ++r) { const int orow = crow(r, hi); const float rl = __builtin_amdgcn_rcpf(wsf[32 + orow]);
#pragma unroll
          for (int d0 = 0; d0 < 4; ++d0) stg[orow * 128 + d0 * 32 + r32] = (bf16_t)(cvt_pk_bf16(o[d0][r] * rl, 0.f) & 0xffffu); }
      asm volatile("s_waitcnt lgkmcnt(0)" ::: "memory");
      bf16_t* Ow = O + (size_t)(q0 + wid * 32) * DM + h * VD;
#pragma unroll
      for (int i = 0; i < 8; ++i) { const int row = i * 4 + (lane >> 4), ch = lane & 15; const u32x4 v = *(const LAS u32x4*)(stg + row * 128 + ch * 8); *(u32x4*)(Ow + (size_t)row * DM + ch * 8) = v; } }
    ATT_WAIT_BAR(0);
#undef DMA_K
#undef DMA_V
#undef ROT
#undef RESC
#undef STEP
}

}

constexpr size_t MiB = 1u << 20;
constexpr size_t al(size_t x) { return (x + 255) / 256 * 256; }
constexpr size_t WS_CTL = 0, CTL_BYTES = 1 * MiB;
constexpr size_t WS_MOD = WS_CTL + CTL_BYTES, MOD_BYTES = (size_t)DEPTH * 2 * 6 * DM * 4;
constexpr size_t ZERO_BYTES = al(WS_MOD + MOD_BYTES);
constexpr size_t WS_TAB = ZERO_BYTES;
constexpr size_t WS_SSQ = al(WS_TAB + 128 * 16 * 2 * 4), WS_SSKV = al(WS_SSQ + (size_t)R * 8 * 4);
constexpr size_t WS_WIN = al(WS_SSKV + (size_t)R * 8 * 4);
constexpr size_t WS_WINB = WS_WIN + (size_t)2 * EVEN_IN * DM * 2;
constexpr size_t WS_POOLT = WS_WINB + (size_t)2 * DM * 1024 * 2;
constexpr size_t WS_WOUT = WS_POOLT + (size_t)2 * 4 * 256 * 256 * 2;
constexpr size_t WS_WDQKV = WS_WOUT + (size_t)2 * DM * DM * 2;
constexpr size_t WS_WUQ = WS_WDQKV + (size_t)2 * NDQKV * DM * 2;
constexpr size_t WS_WUKV = WS_WUQ + (size_t)2 * NQ * QLORA * 2;
constexpr size_t WS_WO = WS_WUKV + (size_t)2 * NKV * KVLORA * 2;
constexpr size_t WS_WGU = WS_WO + (size_t)2 * DM * DM * 2;
constexpr size_t WS_WDN = WS_WGU + (size_t)4 * 2 * FF * DM * 2;
constexpr size_t WS_X = al(WS_WDN + (size_t)4 * DM * FF * 2);
constexpr size_t WS_H = WS_X + (size_t)R * DM * 4;
constexpr size_t WS_Z = WS_H + (size_t)R * DM * 2;
constexpr size_t WS_CAT = WS_Z + (size_t)R * EVEN_IN * 2;
constexpr size_t WS_ACT = WS_CAT + (size_t)R * DM * 2;
constexpr size_t WS_Q = WS_ACT + (size_t)R * FF * 2;
constexpr size_t WS_KN = WS_Q + (size_t)R * NQ * 2;
constexpr size_t WS_V = WS_KN + (size_t)R * DM * 2;
constexpr size_t WS_KR = WS_V + (size_t)R * DM * 2;
constexpr size_t WS_QA = al(WS_KR + (size_t)R * QKR * 2);
constexpr size_t WS_CKV = WS_QA + (size_t)R * QLORA * 2;
constexpr size_t WS_SLAB = al(WS_CKV + (size_t)R * KVLORA * 2);
constexpr size_t WS_END = WS_SLAB + (size_t)11 * 256 * DM * 4;

constexpr int RING_BYTES = 131072, MISC_OFF = RING_BYTES + 320, LDS_BYTES = 147456;
constexpr int NWAVES = 8;

#define XB_TMO      128
#define XB_XCNT(j)  (256  + 64 * (j))
#define XB_XSUB(j)  (1280 + 64 * (j))
#define XB_XGEN(j)  (2304 + 64 * (j))
#define XB_TOP      3328
#define XB_TOPGEN   3392
#define XCD_BAR_WORDS 3456
#define XB_SPIN_CAP (1u << 18)
__device__ __forceinline__ unsigned xb_ld(unsigned* p)              { return __hip_atomic_load(p, __ATOMIC_RELAXED, __HIP_MEMORY_SCOPE_AGENT); }
__device__ __forceinline__ unsigned xb_add(unsigned* p, unsigned v) { return __hip_atomic_fetch_add(p, v, __ATOMIC_RELAXED, __HIP_MEMORY_SCOPE_AGENT); }
__device__ __forceinline__ unsigned xb_xcc_id() { return (unsigned)__builtin_amdgcn_s_getreg((3 << 11) | 20) & 0xFu; }
#define XB_SPIN(cond, bar) do { unsigned _sp = 0; while (cond) { __builtin_amdgcn_s_sleep(1); \
    if ((++_sp & 255u) == 0u) { if (xb_ld(&(bar)[XB_TMO])) break; if (_sp > XB_SPIN_CAP) { atomicAdd(&(bar)[XB_TMO], 1u); break; } } } } while (0)
struct XcdBarrier { unsigned* bar; unsigned x; volatile LAS unsigned* st; };
__device__ __forceinline__ XcdBarrier xcd_barrier_post(unsigned* bar, volatile LAS unsigned* st) {
    XcdBarrier b; b.bar = bar; b.x = xb_xcc_id(); b.st = st;
    if (threadIdx.x == 0) (void)xb_add(&bar[XB_XCNT(b.x)], 1u);
    return b;
}
__device__ __forceinline__ void xcd_barrier_complete(unsigned* bar, unsigned x, unsigned& nloc, unsigned& nx) {
    const unsigned G = gridDim.x * gridDim.y * gridDim.z;
    unsigned sum, cnt, mine, sp = 0u;
    for (;;) {
        sum = 0u; cnt = 0u; mine = 0u;
#pragma unroll
        for (unsigned j = 0; j < 16; ++j) { const unsigned c = xb_ld(&bar[XB_XCNT(j)]); sum += c; cnt += (c > 0u) ? 1u : 0u; mine = (j == x) ? c : mine; }
        if (sum == G) break;
        __builtin_amdgcn_s_sleep(1);
        if ((++sp & 255u) == 0u) { if (xb_ld(&bar[XB_TMO])) break; if (sp > XB_SPIN_CAP) { atomicAdd(&bar[XB_TMO], 1u); break; } }
    }
    nloc = mine > 0u ? mine : 1u; nx = cnt > 0u ? cnt : 1u;
}
__device__ __attribute__((noinline)) void xcd_barrier_ni(unsigned* bar_, unsigned x_, volatile LAS unsigned* st_) {
    XcdBarrier b; b.bar = bar_; b.x = x_; b.st = st_;
    asm volatile("s_waitcnt vmcnt(0)" ::: "memory");
    __syncthreads();
    if (threadIdx.x == 0) {
        unsigned* bar = b.bar;
        __builtin_amdgcn_s_waitcnt(0);
        unsigned nloc = b.st[0], nx = b.st[1];
        if (nloc == 0u) { xcd_barrier_complete(bar, b.x, nloc, nx); b.st[0] = nloc; b.st[1] = nx; }
        const unsigned old = xb_add(&bar[XB_XSUB(b.x)], 1u);
        const unsigned gen = old / nloc;
        if (old + 1u == (gen + 1u) * nloc) {
            __builtin_amdgcn_fence(__ATOMIC_RELEASE, "agent");
            asm volatile("s_waitcnt vmcnt(0)" ::: "memory");
            const unsigned og = xb_add(&bar[XB_TOP], 1u);
            const unsigned tg = og / nx;
            if (og + 1u == (tg + 1u) * nx) xb_add(&bar[XB_TOPGEN], 1u);
            else XB_SPIN(xb_ld(&bar[XB_TOPGEN]) == tg, bar);
            __builtin_amdgcn_fence(__ATOMIC_ACQUIRE, "agent");
            xb_add(&bar[XB_XGEN(b.x)], 1u);
            asm volatile("s_waitcnt vmcnt(0)" ::: "memory");
        } else {
            XB_SPIN(xb_ld(&bar[XB_XGEN(b.x)]) == gen, bar);
            __builtin_amdgcn_fence(__ATOMIC_ACQUIRE, "agent");
            asm volatile("s_waitcnt vmcnt(0)" ::: "memory");
        }
    }
    __syncthreads();
}

struct Args { const float* in[24]; float* out; unsigned char* ws; int ph_lo, ph_hi; };

__device__ __forceinline__ void transpose_item(const float* W, int ldw, int k0, int n0, bf16_t* WT, int ldt, int drow, bool perm, const float* kscale, LAS float* scr, int lane) {
    float tv[32];
    const float* wp = W + (size_t)(k0 + (lane >> 5)) * ldw + n0 + (lane & 31);
#pragma unroll
    for (int i = 0; i < 32; ++i) tv[i] = __builtin_nontemporal_load(wp + (size_t)(2 * i) * ldw);
    if (kscale) {
#pragma unroll
        for (int i = 0; i < 32; ++i) tv[i] *= kscale[k0 + 2 * i + (lane >> 5)]; }
#pragma unroll
    for (int i = 0; i < 32; ++i) scr[(2 * i + (lane >> 5)) * 33 + (lane & 31)] = tv[i];
    asm volatile("s_waitcnt lgkmcnt(0)" ::: "memory");
    const int c = lane & 7;
#pragma unroll
    for (int j = 0; j < 4; ++j) { const int nn = (lane >> 3) + 8 * j; const LAS float* s = scr + (8 * c) * 33 + nn;
        u32x4 o; o.x = cvt_pk_bf16(s[0 * 33], s[1 * 33]); o.y = cvt_pk_bf16(s[2 * 33], s[3 * 33]); o.z = cvt_pk_bf16(s[4 * 33], s[5 * 33]); o.w = cvt_pk_bf16(s[6 * 33], s[7 * 33]);
        const int dn = perm ? (2 * (nn & 15) + (nn >> 4)) : nn;
        *(u32x4*)(WT + (size_t)(drow + dn) * ldt + k0 + 8 * c) = o; }
    asm volatile("s_waitcnt lgkmcnt(0)" ::: "memory");
}
struct TJob { const float* W; int ldw, K, col0, ncols; bf16_t* WT; int ldt, kind, drow0; const float* kscale; };
__device__ __forceinline__ long tjob_items(const TJob& j) { return (long)(j.K / 64) * (j.ncols / 32); }
__device__ __forceinline__ void tjob_run(const TJob& j, long item, LAS float* scr, int lane) {
    const int nblk = j.ncols / 32, kb = (int)(item / nblk), nb = (int)(item % nblk), n0 = j.col0 + 32 * nb, rel = 32 * nb;
    int drow; bool perm = false;
    if (j.kind == 1) drow = 256 * (rel / 128) + (rel % 128);
    else if (j.kind == 2) drow = 256 * (rel / 128) + 128 + (rel % 128);
    else { drow = j.drow0 + rel; if (j.kind == 3) perm = (rel % QHD) >= QKN; if (j.kind == 4) perm = true; }
    transpose_item(j.W, j.ldw, 64 * kb, n0, j.WT, j.ldt, drow, perm, j.kscale, scr, lane);
}
constexpr int NTJOBS = 2 * (2 + 4) + 2 * 6 + 4 * 3;
__device__ __forceinline__ TJob get_tjob(unsigned char* ws, int id) {
    TJob j{}; j.kscale = nullptr; j.kind = 0; j.drow0 = 0; j.col0 = 0;
    if (id < 12) { const int l = id / 6, s = id % 6;
        if (s == 0) { j.W = INP(8) + (size_t)l * DM * EVEN_IN; j.ldw = EVEN_IN; j.K = DM; j.col0 = 1024; j.ncols = 3072; j.WT = (bf16_t*)(ws + WS_WIN) + (size_t)l * EVEN_IN * DM; j.ldt = DM; j.drow0 = 1024; }
        else if (s == 1) { j.W = INP(12) + (size_t)l * DM * DM; j.ldw = DM; j.K = DM; j.ncols = DM; j.WT = (bf16_t*)(ws + WS_WOUT) + (size_t)l * DM * DM; j.ldt = DM; }
        else { const int g = s - 2; j.W = INP(9) + (size_t)(l * 4 + g) * 65536; j.ldw = 256; j.K = 256; j.ncols = 256; j.WT = (bf16_t*)(ws + WS_POOLT) + (size_t)(l * 4 + g) * 65536; j.ldt = 256; }
    } else if (id < 24) { const int l = (id - 12) / 6, s = (id - 12) % 6;
        bf16_t* wd = (bf16_t*)(ws + WS_WDQKV) + (size_t)l * NDQKV * DM;
        if (s == 0) { j.W = INP(13) + (size_t)l * DM * QLORA; j.ldw = QLORA; j.K = DM; j.ncols = QLORA; j.WT = wd; j.ldt = DM; }
        else if (s == 1) { j.W = INP(16) + (size_t)l * DM * 576; j.ldw = 576; j.K = DM; j.ncols = KVLORA; j.WT = wd; j.ldt = DM; j.drow0 = 512; }
        else if (s == 2) { j.W = INP(16) + (size_t)l * DM * 576; j.ldw = 576; j.K = DM; j.col0 = 512; j.ncols = 64; j.WT = wd; j.ldt = DM; j.drow0 = 1024; j.kind = 4; }
        else if (s == 3) { j.W = INP(15) + (size_t)l * QLORA * NQ; j.ldw = NQ; j.K = QLORA; j.ncols = NQ; j.WT = (bf16_t*)(ws + WS_WUQ) + (size_t)l * NQ * QLORA; j.ldt = QLORA; j.kind = 3; j.kscale = INP(14) + l * QLORA; }
        else if (s == 4) { j.W = INP(18) + (size_t)l * KVLORA * NKV; j.ldw = NKV; j.K = KVLORA; j.ncols = NKV; j.WT = (bf16_t*)(ws + WS_WUKV) + (size_t)l * NKV * KVLORA; j.ldt = KVLORA; j.kscale = INP(17) + l * KVLORA; }
        else { j.W = INP(19) + (size_t)l * DM * DM; j.ldw = DM; j.K = DM; j.ncols = DM; j.WT = (bf16_t*)(ws + WS_WO) + (size_t)l * DM * DM; j.ldt = DM; }
    } else { const int l = (id - 24) / 3, s = (id - 24) % 3;
        if (s == 0) { j.W = INP(20) + (size_t)l * DM * FF; j.ldw = FF; j.K = DM; j.ncols = FF; j.WT = (bf16_t*)(ws + WS_WGU) + (size_t)l * 2 * FF * DM; j.ldt = DM; j.kind = 1; }
        else if (s == 1) { j.W = INP(21) + (size_t)l * DM * FF; j.ldw = FF; j.K = DM; j.ncols = FF; j.WT = (bf16_t*)(ws + WS_WGU) + (size_t)l * 2 * FF * DM; j.ldt = DM; j.kind = 2; }
        else { j.W = INP(22) + (size_t)l * FF * DM; j.ldw = DM; j.K = FF; j.ncols = DM; j.WT = (bf16_t*)(ws + WS_WDN) + (size_t)l * DM * FF; j.ldt = FF; }
    }
    return j;
}

__device__ __forceinline__ void prologue(unsigned char* ws, LAS unsigned char* lds, int gw, int NGW, int wave, int lane, int njobs) {
    {
        float* MOD = (float*)(ws + WS_MOD);
        const float* c0 = INP(1); const float* c1 = INP(3);
        LAS float* red = (LAS float*)lds;
        const int bxp = gw / NWAVES, Gp = NGW / NWAVES, tidp = wave * 64 + lane;
        for (int task = bxp; task < 4 * 64; task += Gp) {
            const int l = task / 64, cg = task % 64, col = cg * 192 + 3 * lane;
            const float* Wp = INP(4) + ((size_t)l * DM + wave * 256) * (6 * DM) + col;
            float s0[3] = {0.f, 0.f, 0.f}, s1[3] = {0.f, 0.f, 0.f};
#pragma unroll 1
            for (int kb = 0; kb < 256; kb += 64) {
                const float x0 = c0[wave * 256 + kb + lane], x1 = c1[wave * 256 + kb + lane];
                const float sv0 = x0 / (1.f + __expf(-x0)), sv1 = x1 / (1.f + __expf(-x1));
#pragma unroll 8
                for (int k = 0; k < 64; ++k) { const float* wp = Wp + (size_t)(kb + k) * (6 * DM);
                    const float w0 = __builtin_nontemporal_load(wp), w1 = __builtin_nontemporal_load(wp + 1), w2 = __builtin_nontemporal_load(wp + 2);
                    const float a0 = __builtin_bit_cast(float, __builtin_amdgcn_readlane(__builtin_bit_cast(int, sv0), k)), a1 = __builtin_bit_cast(float, __builtin_amdgcn_readlane(__builtin_bit_cast(int, sv1), k));
                    s0[0] += w0 * a0; s0[1] += w1 * a0; s0[2] += w2 * a0; s1[0] += w0 * a1; s1[1] += w1 * a1; s1[2] += w2 * a1; }
            }
#pragma unroll
            for (int e = 0; e < 3; ++e) { red[(wave * 2 + 0) * 192 + 3 * lane + e] = s0[e]; red[(wave * 2 + 1) * 192 + 3 * lane + e] = s1[e]; }
            __syncthreads();
            if (tidp < 384) { const int s = tidp / 192, cc = tidp % 192; float acc = INP(5)[(size_t)l * 6 * DM + cg * 192 + cc];
#pragma unroll
              for (int w = 0; w < NWAVES; ++w) acc += red[(w * 2 + s) * 192 + cc];
              MOD[((size_t)l * 2 + s) * 6 * DM + cg * 192 + cc] = acc; }
            __syncthreads();
        }
    }
    {
        LAS float* scr = (LAS float*)(lds + wave * 16384);
        long base = 0;
        for (int id = 0; id < njobs; ++id) {
            const TJob j = get_tjob(ws, id); const long n = tjob_items(j);
            long first = ((long)gw - base % NGW + NGW) % NGW;
            for (long it = first; it < n; it += NGW) tjob_run(j, it, scr, lane);
            base += n;
        }
    }
    {
        bf16_t* WB = (bf16_t*)(ws + WS_WINB);
        const long n8 = (long)2 * DM * 1024 / 8;
        for (long i = (long)gw * 64 + lane; i < n8; i += (long)NGW * 64) { const long e = i * 8; const int l = (int)(e / ((long)DM * 1024)); const long rem = e % ((long)DM * 1024); const int k = (int)(rem / 1024), m = (int)(rem % 1024);
            const float* s = INP(8) + ((size_t)l * DM + k) * EVEN_IN + m; const f32x4 v0 = *(const f32x4*)s, v1 = *(const f32x4*)(s + 4);
            *(u32x4*)(WB + e) = pack8(v0, v1); }
    }
    {
        float* TAB = (float*)(ws + WS_TAB);
        for (int i = gw * 64 + lane; i < 128 * 16; i += NGW * 64) { const int pos = i >> 4, f = i & 15; const float inv = powf(10000.f, -(float)f / 16.f); const float ang = (float)pos * inv; TAB[2 * i] = cosf(ang); TAB[2 * i + 1] = sinf(ang); }
        const long nz = (long)2 * (NDQKV - 1088) * DM / 8;
        for (long i = (long)gw * 64 + lane; i < nz; i += (long)NGW * 64) { const long e = i * 8; const int l = (int)(e / ((long)(NDQKV - 1088) * DM)); const long rem = e % ((long)(NDQKV - 1088) * DM);
            *(u32x4*)((bf16_t*)(ws + WS_WDQKV) + (size_t)l * NDQKV * DM + (size_t)1088 * DM + rem) = (u32x4){0u, 0u, 0u, 0u}; }
    }
}

constexpr int DEF_PER_LAYER = 3 * 5632;
__device__ __forceinline__ void deferred_convert(unsigned char* ws, LAS unsigned char* lds, int L, int r_begin, int r_cap, int rank, int quota, int wave, int lane) {
    LAS float* scr = (LAS float*)(lds + wave * 16384);
    for (int k = wave; k < quota; k += NWAVES) {
        const int r = r_begin + rank * quota + k; if (r >= r_cap) break;
        const int s = r / 5632;
        const TJob j = get_tjob(ws, 24 + 3 * L + s); tjob_run(j, r - s * 5632, scr, lane);
    }
}

__device__ __forceinline__ void norm_mod_phase(const float* xl, const float* xc, const float* g, const float* modl, const float* modc, int which, bf16_t* H, int gw, int NGW, int lane, int nrows) {
#pragma unroll 1
    for (int pass = 0; pass < 2; ++pass) {
        const int rlo = pass ? SEQ : 0, rhi = pass ? nrows : (nrows < SEQ ? nrows : SEQ);
        if (rlo >= rhi) continue;
        const float* mod = pass ? modc : modl; const float* xb = pass ? xc : xl;
        const float* sh = mod + (which ? 3 : 0) * DM; const float* sc = sh + DM;
        f32x4 A[8], B[8];
#pragma unroll
        for (int j = 0; j < 8; ++j) { const int c = 256 * j + 4 * lane; A[j] = *(const f32x4*)(g + c); B[j] = *(const f32x4*)(sc + c); }
        __builtin_amdgcn_sched_barrier(0);
#pragma unroll
        for (int j = 0; j < 8; ++j) { const int c = 256 * j + 4 * lane; A[j] = A[j] * (B[j] + 1.f); B[j] = *(const f32x4*)(sh + c); }
        for (int row = rlo + gw; row < rhi; row += NGW) {
            const f32x4* xr = (const f32x4*)(xb + (size_t)row * DM) + lane; f32x4 v[8]; float ss = 0.f;
#pragma unroll
            for (int j = 0; j < 8; ++j) v[j] = __builtin_nontemporal_load(xr + 64 * j);
            asm volatile("" : "+v"(v[0]), "+v"(v[1]), "+v"(v[2]), "+v"(v[3]), "+v"(v[4]), "+v"(v[5]), "+v"(v[6]), "+v"(v[7]));
#pragma unroll
            for (int j = 0; j < 8; ++j) ss += (v[j][0] * v[j][0] + v[j][1] * v[j][1]) + (v[j][2] * v[j][2] + v[j][3] * v[j][3]);
            const float rstd = __builtin_amdgcn_rsqf(wave_sum(ss) * (1.f / DM) + EPS);
            u32x2* o = (u32x2*)(H + (size_t)row * DM) + lane;
#pragma unroll
            for (int j = 0; j < 8; ++j) { const f32x4 y = v[j] * rstd * A[j] + B[j]; u32x2 w; w.x = cvt_pk_bf16(y[0], y[1]); w.y = cvt_pk_bf16(y[2], y[3]); o[64 * j] = w; }
        }
    }
}
__device__ __forceinline__ void norm_mod_phase16(const bf16_t* X, const float* g, const float* mod, int which, bf16_t* H, int gw, int NGW, int lane) {
    const float* sh = mod + (which ? 3 : 0) * DM; const float* sc = sh + DM;
    f32x4 A[4][2], B[4][2];
#pragma unroll
    for (int j = 0; j < 4; ++j)
#pragma unroll
        for (int h = 0; h < 2; ++h) { const int c = 512 * j + 8 * lane + 4 * h; A[j][h] = *(const f32x4*)(g + c); B[j][h] = *(const f32x4*)(sc + c); }
    __builtin_amdgcn_sched_barrier(0);
#pragma unroll
    for (int j = 0; j < 4; ++j)
#pragma unroll
        for (int h = 0; h < 2; ++h) { const int c = 512 * j + 8 * lane + 4 * h; A[j][h] = A[j][h] * (B[j][h] + 1.f); B[j][h] = *(const f32x4*)(sh + c); }
    for (int row = gw; row < SEQ; row += 2 * NGW) {
        const int row2 = row + NGW; const bool has2 = row2 < SEQ; const int r2 = has2 ? row2 : row;
        const u32x4* xr = (const u32x4*)(X + (size_t)row * DM) + lane; const u32x4* xs = (const u32x4*)(X + (size_t)r2 * DM) + lane;
        u32x4 ra[4], rb[4];
#pragma unroll
        for (int j = 0; j < 4; ++j) ra[j] = xr[64 * j];
#pragma unroll
        for (int j = 0; j < 4; ++j) rb[j] = xs[64 * j];
        f32x4 v[4][2], w[4][2]; float ss = 0.f, st = 0.f;
#pragma unroll
        for (int j = 0; j < 4; ++j) { xunpack8(ra[j], v[j][0], v[j][1]);
#pragma unroll
            for (int h = 0; h < 2; ++h) ss += (v[j][h][0] * v[j][h][0] + v[j][h][1] * v[j][h][1]) + (v[j][h][2] * v[j][h][2] + v[j][h][3] * v[j][h][3]); }
#pragma unroll
        for (int j = 0; j < 4; ++j) { xunpack8(rb[j], w[j][0], w[j][1]);
#pragma unroll
            for (int h = 0; h < 2; ++h) st += (w[j][h][0] * w[j][h][0] + w[j][h][1] * w[j][h][1]) + (w[j][h][2] * w[j][h][2] + w[j][h][3] * w[j][h][3]); }
        const float rstd = __builtin_amdgcn_rsqf(wave_sum(ss) * (1.f / DM) + EPS), rstd2 = __builtin_amdgcn_rsqf(wave_sum(st) * (1.f / DM) + EPS);
        u32x4* o = (u32x4*)(H + (size_t)row * DM) + lane;
#pragma unroll
        for (int j = 0; j < 4; ++j) o[64 * j] = pack8(v[j][0] * rstd * A[j][0] + B[j][0], v[j][1] * rstd * A[j][1] + B[j][1]);
        if (has2) { u32x4* o2 = (u32x4*)(H + (size_t)row2 * DM) + lane;
#pragma unroll
            for (int j = 0; j < 4; ++j) o2[64 * j] = pack8(w[j][0] * rstd2 * A[j][0] + B[j][0], w[j][1] * rstd2 * A[j][1] + B[j][1]); }
    }
}
__device__ __forceinline__ void final_norm_phase(const bf16_t* X, const float* g, float* out, int gw, int NGW, int lane) {
    f32x4 G[4][2];
#pragma unroll
    for (int j = 0; j < 4; ++j)
#pragma unroll
        for (int h = 0; h < 2; ++h) G[j][h] = *(const f32x4*)(g + 512 * j + 8 * lane + 4 * h);
    for (int row = gw; row < SEQ; row += NGW) {
        const u32x4* xr = (const u32x4*)(X + (size_t)row * DM) + lane; f32x4 v[4][2]; float ss = 0.f;
#pragma unroll
        for (int j = 0; j < 4; ++j) { xunpack8(xr[64 * j], v[j][0], v[j][1]);
#pragma unroll
            for (int h = 0; h < 2; ++h) ss += (v[j][h][0] * v[j][h][0] + v[j][h][1] * v[j][h][1]) + (v[j][h][2] * v[j][h][2] + v[j][h][3] * v[j][h][3]); }
        const float rstd = __builtin_amdgcn_rsqf(wave_sum(ss) * (1.f / DM) + EPS);
        float* o = out + (size_t)row * DM + 8 * lane;
#pragma unroll
        for (int j = 0; j < 4; ++j) { *(f32x4*)(o + 512 * j) = v[j][0] * rstd * G[j][0]; *(f32x4*)(o + 512 * j + 4) = v[j][1] * rstd * G[j][1]; }
    }
}
template <int S>
__device__ __forceinline__ void ctx_norm_phase(const float* __restrict__ x32, const bf16_t* x16, bf16_t* Xc, const bf16_t* __restrict__ slab, const float* __restrict__ gate, const float* __restrict__ g, const float* __restrict__ modc, int which, bf16_t* __restrict__ Hc, LAS float* red, int bx, int G, int tid) {
    const int col = 4 * tid, lane = tid & 63, wave = tid >> 6;
    const float* sh = modc + (which ? 3 : 0) * DM; const float* sc = sh + DM;
    for (int r = bx; r < CTXL; r += G) {
        f32x4 v; u32x2 sw[S > 0 ? S : 1];
        if (x32) v = *(const f32x4*)(x32 + (size_t)r * DM + col);
        else { const u32x2 w = *(const u32x2*)(x16 + (size_t)r * DM + col); const f32x2 p = xun(w.x), q = xun(w.y); v = (f32x4){p[0], p[1], q[0], q[1]}; }
#pragma unroll
        for (int s = 0; s < S; ++s) sw[s] = *(const u32x2*)(slab + ((size_t)s * 256 + r) * DM + col);
        const f32x4 gv = *(const f32x4*)(g + col), scv = *(const f32x4*)(sc + col), shv = *(const f32x4*)(sh + col);
        if (S > 0) { const f32x4 gt = *(const f32x4*)(gate + col); f32x4 a = {0.f, 0.f, 0.f, 0.f};
#pragma unroll
            for (int s = 0; s < S; ++s) { const f32x2 p = xun(sw[s].x), q = xun(sw[s].y); a += (f32x4){p[0], p[1], q[0], q[1]}; }
            v += gt * a;
            u32x2 w; w.x = xpk(v[0], v[1]); w.y = xpk(v[2], v[3]); *(u32x2*)(Xc + (size_t)r * DM + col) = w;
            const f32x2 p = xun(w.x), q = xun(w.y); v = (f32x4){p[0], p[1], q[0], q[1]}; }
        float ss = wave_sum((v[0] * v[0] + v[1] * v[1]) + (v[2] * v[2] + v[3] * v[3]));
        if (lane == 0) red[wave] = ss;
        __syncthreads();
        float tot = 0.f;
#pragma unroll
        for (int w = 0; w < NWAVES; ++w) tot += red[w];
        __syncthreads();
        const float rstd = __builtin_amdgcn_rsqf(tot * (1.f / DM) + EPS);
        const f32x4 A = gv * (scv + 1.f), y = v * rstd * A + shv;
        u32x2 w; w.x = cvt_pk_bf16(y[0], y[1]); w.y = cvt_pk_bf16(y[2], y[3]); *(u32x2*)(Hc + (size_t)r * DM + col) = w;
    }
}
__device__ __forceinline__ void ld8f(const bf16_t* p, float (&f)[8]) { const u32x4 w = *(const u32x4*)p; f[0] = bf_lo(w.x); f[1] = bf_hi(w.x); f[2] = bf_lo(w.y); f[3] = bf_hi(w.y); f[4] = bf_lo(w.z); f[5] = bf_hi(w.z); f[6] = bf_lo(w.w); f[7] = bf_hi(w.w); }
__device__ __forceinline__ void ld8s(const bf16_t* ZS, int q, int c, float (&f)[8]) {
    f32x4 a = {0.f, 0.f, 0.f, 0.f}, b = a;
#pragma unroll
    for (int s = 0; s < 4; ++s) { f32x4 x, y; xunpack8(*(const u32x4*)(ZS + ((size_t)s * 256 + q) * EVEN_IN + c), x, y); a += x; b += y; }
    f[0] = a[0]; f[1] = a[1]; f[2] = a[2]; f[3] = a[3]; f[4] = b[0]; f[5] = b[1]; f[6] = b[2]; f[7] = b[3];
}
__device__ __forceinline__ void ld4s_raw(const bf16_t* __restrict__ ZS, int q, int c, u32x4 (&r)[4]) {
#pragma unroll
    for (int s = 0; s < 4; ++s) r[s] = *(const u32x4*)(ZS + ((size_t)s * 256 + q) * EVEN_IN + c);
}
__device__ __forceinline__ void sum4s(const u32x4 (&r)[4], float (&f)[8]) {
    f32x4 a = {0.f, 0.f, 0.f, 0.f}, b = a;
#pragma unroll
    for (int s = 0; s < 4; ++s) { f32x4 x, y; xunpack8(r[s], x, y); a += x; b += y; }
    f[0] = a[0]; f[1] = a[1]; f[2] = a[2]; f[3] = a[3]; f[4] = b[0]; f[5] = b[1]; f[6] = b[2]; f[7] = b[3];
}
__device__ __forceinline__ void acc8m(float (&s)[8], const u32x4 w, float m) {
    s[0] += m * bf_lo(w.x); s[1] += m * bf_hi(w.x); s[2] += m * bf_lo(w.y); s[3] += m * bf_hi(w.y); s[4] += m * bf_lo(w.z); s[5] += m * bf_hi(w.z); s[6] += m * bf_lo(w.w); s[7] += m * bf_hi(w.w);
}
__device__ __forceinline__ void up8(const u32x4 w, float (&f)[8]) { f[0] = bf_lo(w.x); f[1] = bf_hi(w.x); f[2] = bf_lo(w.y); f[3] = bf_hi(w.y); f[4] = bf_lo(w.z); f[5] = bf_hi(w.z); f[6] = bf_lo(w.w); f[7] = bf_hi(w.w); }
__device__ __forceinline__ void mixer_ctx_token(const bf16_t* __restrict__ ZS, const float* __restrict__ convw, bf16_t* __restrict__ CAT, int tl, int ch) {
    constexpr int n = CTXL; const int t = SEQ + tl;
    float o[8], f[8];
    if (ch < 128) {
        const int c = 8 * ch, hw = 1 << (c >> 8); const int lo = (tl - hw) < 0 ? 0 : (tl - hw), hi = (tl + hw) > n ? n : (tl + hw);
        float s[8] = {0.f, 0.f, 0.f, 0.f, 0.f, 0.f, 0.f, 0.f};
#pragma unroll 1
        for (int qb = tl - hw; qb < tl + hw; qb += 4) {
            u32x4 rw[4][4];
#pragma unroll
            for (int j = 0; j < 4; ++j) { const int q = qb + j, qc = q < 0 ? 0 : (q > n - 1 ? n - 1 : q); ld4s_raw(ZS, qc, c, rw[j]); }
#pragma unroll
            for (int j = 0; j < 4; ++j) { const int q = qb + j; const float m = (q >= 0 && q < n && q < tl + hw) ? 1.f : 0.f; float fa[8]; sum4s(rw[j], fa);
#pragma unroll
                for (int e = 0; e < 8; ++e) s[e] += m * fa[e]; }
        }
        { u32x4 rw[4]; ld4s_raw(ZS, tl, c, rw); sum4s(rw, f); }
        const float ic = 1.f / (float)(hi - lo);
#pragma unroll
        for (int e = 0; e < 8; ++e) o[e] = s[e] * ic - f[e];
        *(u32x4*)(CAT + (size_t)t * DM + c) = pack8((f32x4){o[0], o[1], o[2], o[3]}, (f32x4){o[4], o[5], o[6], o[7]});
    } else {
        const int c = 8 * (ch - 128); float cv[8] = {0.f, 0.f, 0.f, 0.f, 0.f, 0.f, 0.f, 0.f};
        u32x4 rg[3][4], rv[3][4], rf[4];
#pragma unroll
        for (int k = 0; k < 3; ++k) { const int q = tl + k - 1, qc = q < 0 ? 0 : (q > n - 1 ? n - 1 : q); ld4s_raw(ZS, qc, 2048 + c, rg[k]); ld4s_raw(ZS, qc, 3072 + c, rv[k]); }
        ld4s_raw(ZS, tl, 1024 + c, rf);
#pragma unroll
        for (int k = 0; k < 3; ++k) { const int q = tl + k - 1; const float m = (q >= 0 && q < n) ? 1.f : 0.f; float g[8], v[8]; sum4s(rg[k], g); sum4s(rv[k], v);
            const f32x4 w0 = *(const f32x4*)(convw + k * 1024 + c), w1 = *(const f32x4*)(convw + k * 1024 + c + 4);
#pragma unroll
            for (int e = 0; e < 4; ++e) { cv[e] += m * g[e] * v[e] * w0[e]; cv[4 + e] += m * g[4 + e] * v[4 + e] * w1[e]; } }
        sum4s(rf, f);
#pragma unroll
        for (int e = 0; e < 8; ++e) o[e] = f[e] * cv[e];
        *(u32x4*)(CAT + (size_t)t * DM + 1024 + c) = pack8((f32x4){o[0], o[1], o[2], o[3]}, (f32x4){o[4], o[5], o[6], o[7]});
    }
}
__device__ __forceinline__ void mixer_run16(const bf16_t* __restrict__ Z, const float* __restrict__ convw, bf16_t* __restrict__ CAT, int t0, int ch) {
    if (ch < 128) {
        const int c = 8 * ch, hw = 1 << (c >> 8);
        const bf16_t* Zc = Z + c;
        float s[8] = {0.f, 0.f, 0.f, 0.f, 0.f, 0.f, 0.f, 0.f};
#pragma unroll 1
        for (int qb = t0 - hw; qb < t0 + hw; qb += 4) {
            u32x4 w[4];
#pragma unroll
            for (int j = 0; j < 4; ++j) { const int q = qb + j, qc = q < 0 ? 0 : (q > SEQ - 1 ? SEQ - 1 : q); w[j] = *(const u32x4*)(Zc + (size_t)qc * EVEN_IN); }
#pragma unroll
            for (int j = 0; j < 4; ++j) { const int q = qb + j; acc8m(s, w[j], (q >= 0 && q < SEQ && q < t0 + hw) ? 1.f : 0.f); }
        }
#pragma unroll 1
        for (int i0 = 0; i0 < 16; i0 += 4) {
            u32x4 wc[4], wp[4], wm[4];
#pragma unroll
            for (int i = 0; i < 4; ++i) { const int t = t0 + i0 + i, tp = (t + hw) > SEQ - 1 ? SEQ - 1 : (t + hw), tm = (t - hw) < 0 ? 0 : (t - hw);
                wc[i] = *(const u32x4*)(Zc + (size_t)t * EVEN_IN); wp[i] = *(const u32x4*)(Zc + (size_t)tp * EVEN_IN); wm[i] = *(const u32x4*)(Zc + (size_t)tm * EVEN_IN); }
#pragma unroll
            for (int i = 0; i < 4; ++i) { const int t = t0 + i0 + i; const int lo = (t - hw) < 0 ? 0 : (t - hw), hi = (t + hw) > SEQ ? SEQ : (t + hw);
                const float ic = 1.f / (float)(hi - lo); float f[8], o[8]; up8(wc[i], f);
#pragma unroll
                for (int e = 0; e < 8; ++e) o[e] = s[e] * ic - f[e];
                *(u32x4*)(CAT + (size_t)t * DM + c) = pack8((f32x4){o[0], o[1], o[2], o[3]}, (f32x4){o[4], o[5], o[6], o[7]});
                acc8m(s, wp[i], (t + hw < SEQ) ? 1.f : 0.f); acc8m(s, wm[i], (t - hw >= 0) ? -1.f : 0.f); }
        }
    } else {
        const int c = 8 * (ch - 128); const bf16_t* Zb = Z + 1024 + c; const bf16_t* Zg = Z + 2048 + c; const bf16_t* Zv = Z + 3072 + c;
        float up[8], uc[8], w0[8], w1[8], w2[8];
#pragma unroll
        for (int e = 0; e < 8; ++e) { w0[e] = convw[c + e]; w1[e] = convw[1024 + c + e]; w2[e] = convw[2048 + c + e]; }
        { const int tq = t0 > 0 ? t0 - 1 : 0; const float m = t0 > 0 ? 1.f : 0.f;
          const u32x4 a = *(const u32x4*)(Zg + (size_t)tq * EVEN_IN), b = *(const u32x4*)(Zv + (size_t)tq * EVEN_IN), a2 = *(const u32x4*)(Zg + (size_t)t0 * EVEN_IN), b2 = *(const u32x4*)(Zv + (size_t)t0 * EVEN_IN);
          float x[8], y[8]; up8(a, x); up8(b, y);
#pragma unroll
          for (int e = 0; e < 8; ++e) up[e] = m * x[e] * y[e];
          up8(a2, x); up8(b2, y);
#pragma unroll
          for (int e = 0; e < 8; ++e) uc[e] = x[e] * y[e]; }
#pragma unroll 1
        for (int i0 = 0; i0 < 16; i0 += 4) {
            u32x4 g[4], v[4], fb[4];
#pragma unroll
            for (int i = 0; i < 4; ++i) { const int t = t0 + i0 + i, tn = (t + 1) > SEQ - 1 ? SEQ - 1 : (t + 1);
                g[i] = *(const u32x4*)(Zg + (size_t)tn * EVEN_IN); v[i] = *(const u32x4*)(Zv + (size_t)tn * EVEN_IN); fb[i] = *(const u32x4*)(Zb + (size_t)t * EVEN_IN); }
#pragma unroll
            for (int i = 0; i < 4; ++i) { const int t = t0 + i0 + i; const float m = (t + 1 < SEQ) ? 1.f : 0.f; float x[8], y[8], f[8], o[8]; up8(g[i], x); up8(v[i], y); up8(fb[i], f);
#pragma unroll
                for (int e = 0; e < 8; ++e) { const float un = m * x[e] * y[e]; o[e] = f[e] * (up[e] * w0[e] + uc[e] * w1[e] + un * w2[e]); up[e] = uc[e]; uc[e] = un; }
                *(u32x4*)(CAT + (size_t)t * DM + 1024 + c) = pack8((f32x4){o[0], o[1], o[2], o[3]}, (f32x4){o[4], o[5], o[6], o[7]}); }
        }
    }
}
__device__ __forceinline__ void mixer_phase(const bf16_t* Z, const bf16_t* ZS, const float* convw, bf16_t* CAT, int wg, int nwg, int tid) {
    const int ch = tid & 255, tsub = tid >> 8;
    for (int blk = wg; blk < SEQ / 32; blk += nwg) {
        mixer_run16(Z, convw, CAT, blk * 32 + 16 * tsub, ch);
        if (tsub == 0) mixer_ctx_token(ZS, convw, CAT, blk, ch);
    }
}

template <class Epi, class Sched>
__device__ __forceinline__ void run_gemm(LAS unsigned char* lds, const pg8::Gemm g, const Sched& S, const Epi& E) {
#if MK_SIMPLE_GEMM
    pg8::gemm_simple<Epi, Sched>(g, S, E);
#else
    pg8::gemm_phase<Epi, Sched, true, true>(lds, g, S, E);
#endif
}
constexpr int N_PHASES = 1 + 8 * DEPTH + 1;

__global__ void __launch_bounds__(NWAVES * 64, 2) mk_fwd(Args args) {
    extern __shared__ __attribute__((aligned(16))) unsigned char lds_raw[];
    LAS unsigned char* lds = (LAS unsigned char*)lds_raw;
    volatile LAS unsigned* MISC = (volatile LAS unsigned*)(lds + MISC_OFF);
    const int G = gridDim.x, NGW = G * NWAVES;
    for (int u = threadIdx.x; u < (LDS_BYTES - RING_BYTES) / 4; u += NWAVES * 64) ((LAS unsigned*)(lds + RING_BYTES))[u] = 0u;
    __syncthreads();
#if MK_ONE_LAUNCH
    XcdBarrier bar = xcd_barrier_post((unsigned*)(KARG(unsigned char*, 200) + WS_CTL) + 4096, MISC + 8);
#define GRID_BAR() xcd_barrier_ni(bar.bar, bar.x, bar.st)
#else
#define GRID_BAR() do {} while (0)
#endif
#if MK_ONE_LAUNCH
    constexpr int lo = 0, hi = N_PHASES;
#else
    const int lo = KARG(int, 208), hi = KARG(int, 212);
#endif
#define IN(k) (lo <= (k) && (k) < hi)
#ifndef PH_MASK
#define PH_MASK 0xffffffffu
#endif
#define PH_ON(b) ((PH_MASK >> (b)) & 1u)
#define SEAM(k) do { if ((k) + 1 < hi) GRID_BAR(); } while (0)
#define WSP() unsigned char* ws = KARG(unsigned char*, 200); const int tid = otid(), lane = tid & 63, wave = __builtin_amdgcn_readfirstlane(tid >> 6), bx = obid(), gw = bx * NWAVES + wave; (void)lane; (void)gw
#define MODL(l) ((const float*)(ws + WS_MOD) + (size_t)((l) * 2 + 0) * 6 * DM)
#define MODC(l) ((const float*)(ws + WS_MOD) + (size_t)((l) * 2 + 1) * 6 * DM)

    if (PH_ON(0) && IN(0)) { WSP(); prologue(ws, lds, gw, NGW, wave, lane, (G == 256) ? 26 : NTJOBS); SEAM(0); }

#pragma unroll 1
    for (int l = 0; l < DEPTH; ++l) {
        const int pb = 1 + 8 * l, i2 = l >> 1; const bool lastl = (l == DEPTH - 1);
        if (IN(pb + 0)) {
            WSP();
            const int nf = ((l & 1) == 0 && PH_ON(2) && G > 64) ? 32 : 0;
            if (PH_ON(1) && bx >= nf) { bf16_t* X = (bf16_t*)(ws + WS_X); const int gwn = gw - nf * NWAVES, NGWn = NGW - nf * NWAVES, bxn = bx - nf, Gn = G - nf;
              if (l == 0) norm_mod_phase(INP(0), INP(0), INP(6) + l * DM, MODL(l), MODC(l), 0, (bf16_t*)(ws + WS_H), gwn, NGWn, lane, SEQ);
              else norm_mod_phase16(X, INP(6) + l * DM, MODL(l), 0, (bf16_t*)(ws + WS_H), gwn, NGWn, lane);
              if (l == 0) ctx_norm_phase<0>(INP(2), X + (size_t)SEQ * DM, X + (size_t)SEQ * DM, (const bf16_t*)(ws + WS_SLAB), nullptr, INP(6) + l * DM, MODC(l), 0, (bf16_t*)(ws + WS_H) + (size_t)SEQ * DM, (LAS float*)(lds + MISC_OFF + 64), bxn, Gn, tid);
              else ctx_norm_phase<11>(nullptr, X + (size_t)SEQ * DM, X + (size_t)SEQ * DM, (const bf16_t*)(ws + WS_SLAB), MODC(l - 1) + 5 * DM, INP(6) + l * DM, MODC(l), 0, (bf16_t*)(ws + WS_H) + (size_t)SEQ * DM, (LAS float*)(lds + MISC_OFF + 64), bxn, Gn, tid); }
            if (PH_ON(2) && (l & 1) == 0) {
                pg8::Gemm g{(const bf16_t*)(ws + WS_POOLT) + (size_t)i2 * 4 * 65536, (const bf16_t*)(ws + WS_WINB) + (size_t)i2 * DM * 1024, 256, 1024, 4};
                pg8::FoldOrder S{bx}; EpiBf16 E{(bf16_t*)(ws + WS_WIN) + (size_t)i2 * EVEN_IN * DM, DM, INP(10) + i2 * 1024};
                pg8::gemm_simple<EpiBf16, pg8::FoldOrder>(g, S, E);
            }
            SEAM(pb + 0);
        }
        if ((l & 1) == 0) {
            if (PH_ON(3) && IN(pb + 1)) { WSP(); pg8::Gemm g{(const bf16_t*)(ws + WS_H), (const bf16_t*)(ws + WS_WIN) + (size_t)i2 * EVEN_IN * DM, DM, DM, DM / 64};
                pg8::LatCtxOrder S; S.so.init(SEQ / 256, EVEN_IN / 256, G, bx, DM / 64); S.ntn = EVEN_IN / 256; S.nsl = 4 * (EVEN_IN / 256); S.kchunk = DM / 4;
                EpiWithSlab<EpiBf16> E{{(bf16_t*)(ws + WS_Z), EVEN_IN, nullptr}, (bf16_t*)(ws + WS_SLAB), EVEN_IN};
                run_gemm(lds, g, S, E);
                if (G == 256 && bx >= 64) { if (l == 0) deferred_convert(ws, lds, 0, 11264, 14336, bx - 64, 16, wave, lane); else deferred_convert(ws, lds, 2, 10752, 13824, bx - 64, 16, wave, lane); }
                SEAM(pb + 1); }
            if (PH_ON(4) && IN(pb + 2)) { WSP(); mixer_phase((const bf16_t*)(ws + WS_Z), (const bf16_t*)(ws + WS_SLAB), INP(11) + (size_t)i2 * 3 * 1024, (bf16_t*)(ws + WS_CAT), bx, G, tid); SEAM(pb + 2); }
            if (PH_ON(5) && IN(pb + 3)) { WSP(); bf16_t* X = (bf16_t*)(ws + WS_X); const float* xl = (l == 0) ? INP(0) : nullptr;
                pg8::Gemm g{(const bf16_t*)(ws + WS_CAT), (const bf16_t*)(ws + WS_WOUT) + (size_t)i2 * DM * DM, DM, DM, DM / 64};
                pg8::LatCtxOrder S; S.so.init(SEQ / 256, DM / 256, G, bx, DM / 64); S.ntn = DM / 256; S.nsl = 8 * (DM / 256); S.kchunk = DM / 8;
                EpiWithSlab<EpiResid> E{{xl, X, X, MODL(l) + 2 * DM}, (bf16_t*)(ws + WS_SLAB), DM}; run_gemm(lds, g, S, E);
                if (G == 256 && bx >= 64) { if (l == 0) deferred_convert(ws, lds, 0, 14336, 16896, bx - 64, 14, wave, lane); else deferred_convert(ws, lds, 2, 13824, 16896, bx - 64, 16, wave, lane); }
                SEAM(pb + 3); }
        } else {
            if (PH_ON(6) && IN(pb + 1)) { WSP(); pg8::Gemm g{(const bf16_t*)(ws + WS_H), (const bf16_t*)(ws + WS_WDQKV) + (size_t)i2 * NDQKV * DM, DM, DM, DM / 64}; pg8::StaticOrder S; S.init(NPANEL, NDQKV / 256, G, bx, DM / 64);
                EpiDQKV E{(bf16_t*)(ws + WS_QA), (bf16_t*)(ws + WS_CKV), (bf16_t*)(ws + WS_KR), (float*)(ws + WS_SSQ), (float*)(ws + WS_SSKV), (const float*)(ws + WS_TAB)}; run_gemm(lds, g, S, E);
                if (G == 256 && bx >= 165) deferred_convert(ws, lds, l, 10752, 16896, bx - 165, 68, wave, lane);
                SEAM(pb + 1); }
            if (IN(pb + 2)) {
                if (PH_ON(7)) { WSP(); pg8::Gemm g{(const bf16_t*)(ws + WS_QA), (const bf16_t*)(ws + WS_WUQ) + (size_t)i2 * NQ * QLORA, QLORA, QLORA, QLORA / 64}; pg8::StaticOrder S; S.init(lastl ? SEQ / 256 : NPANEL, NQ / 256, G, bx, QLORA / 64);
                  EpiUQ E{(bf16_t*)(ws + WS_Q), (const float*)(ws + WS_SSQ), (const float*)(ws + WS_TAB)}; run_gemm(lds, g, S, E); }
                if (PH_ON(8)) { WSP(); pg8::Gemm g{(const bf16_t*)(ws + WS_CKV), (const bf16_t*)(ws + WS_WUKV) + (size_t)i2 * NKV * KVLORA, KVLORA, KVLORA, KVLORA / 64}; pg8::StaticOrder S; S.init(NPANEL, NKV / 256, G, G - 1 - bx, KVLORA / 64);
                  EpiUKV E{(bf16_t*)(ws + WS_KN), (bf16_t*)(ws + WS_V), (const float*)(ws + WS_SSKV)}; run_gemm(lds, g, S, E); }
                SEAM(pb + 2); }
            if (PH_ON(9) && IN(pb + 3)) {
                WSP(); LAS float* wsf = (LAS float*)(lds) + wave * 64; (void)wsf;
                const bf16_t* Qb = (const bf16_t*)(ws + WS_Q); const bf16_t* KN = (const bf16_t*)(ws + WS_KN); const bf16_t* KR = (const bf16_t*)(ws + WS_KR); const bf16_t* Vb = (const bf16_t*)(ws + WS_V); bf16_t* CAT = (bf16_t*)(ws + WS_CAT);
                const int nunits = 2 * 256 + (lastl ? 0 : NHEAD);
#pragma unroll 1
                for (int uid = bx; uid < nunits; uid += G) {
#if MK_SIMPLE_ATTN
                    if (uid < 512) att::unit_simple(Qb, KN, KR, Vb, CAT, (uid & 7) + 8 * (uid >> 8), ((uid >> 3) & 31) * 256, 0, R, wsf);
                    else att::unit_simple(Qb, KN, KR, Vb, CAT, uid - 512, SEQ, SEQ, CTXL, wsf);
#else
                    if (uid < 512) att::unit_il(Qb, KN, KR, Vb, CAT, (uid & 7) + 8 * (uid >> 8), ((uid >> 3) & 31) * 256, 0, R, lds);
                    else att::unit_il(Qb, KN, KR, Vb, CAT, uid - 512, SEQ, SEQ, CTXL, lds);
#endif
                }
                SEAM(pb + 3); }
            if (PH_ON(10) && IN(pb + 4)) { WSP(); bf16_t* X = (bf16_t*)(ws + WS_X); pg8::Gemm g{(const bf16_t*)(ws + WS_CAT), (const bf16_t*)(ws + WS_WO) + (size_t)i2 * DM * DM, DM, DM, DM / 64};
                pg8::LatCtxOrder S; S.so.init(SEQ / 256, DM / 256, G, bx, DM / 64); S.ntn = DM / 256; S.nsl = lastl ? 0 : 8 * (DM / 256); S.kchunk = DM / 8;
                EpiWithSlab<EpiResid> E{{nullptr, X, X, MODL(l) + 2 * DM}, (bf16_t*)(ws + WS_SLAB), DM}; run_gemm(lds, g, S, E); SEAM(pb + 4); }
        }
        const int fb = pb + ((l & 1) ? 5 : 4);
        if (PH_ON(11) && IN(fb)) { WSP(); bf16_t* X = (bf16_t*)(ws + WS_X); norm_mod_phase16(X, INP(7) + l * DM, MODL(l), 1, (bf16_t*)(ws + WS_H), gw, NGW, lane);
            if (!lastl) ctx_norm_phase<8>((l == 0) ? INP(2) : nullptr, X + (size_t)SEQ * DM, X + (size_t)SEQ * DM, (const bf16_t*)(ws + WS_SLAB), MODC(l) + 2 * DM, INP(7) + l * DM, MODC(l), 1,
                                          (bf16_t*)(ws + WS_H) + (size_t)SEQ * DM, (LAS float*)(lds + MISC_OFF + 64), bx, G, tid);
            SEAM(fb); }
        if (PH_ON(12) && IN(fb + 1)) { WSP(); pg8::Gemm g{(const bf16_t*)(ws + WS_H), (const bf16_t*)(ws + WS_WGU) + (size_t)l * 2 * FF * DM, DM, DM, DM / 64}; pg8::StaticOrder S; S.init(lastl ? SEQ / 256 : NPANEL, 2 * FF / 256, G, bx, DM / 64); EpiSwiGLU E{(bf16_t*)(ws + WS_ACT)};
            run_gemm(lds, g, S, E);
            if (G == 256 && !lastl && bx >= 172) deferred_convert(ws, lds, l + 1, 0, 6720, bx - 172, 80, wave, lane);
            SEAM(fb + 1); }
        if (PH_ON(13) && IN(fb + 2)) { WSP(); bf16_t* X = (bf16_t*)(ws + WS_X); pg8::Gemm g{(const bf16_t*)(ws + WS_ACT), (const bf16_t*)(ws + WS_WDN) + (size_t)l * DM * FF, FF, FF, FF / 64};
            pg8::LatCtxOrder S; S.so.init(SEQ / 256, DM / 256, G, bx, FF / 64); S.ntn = DM / 256; S.nsl = lastl ? 0 : 11 * (DM / 256); S.kchunk = FF / 11;
            EpiWithSlab<EpiResid> E{{nullptr, X, X, MODL(l) + 5 * DM}, (bf16_t*)(ws + WS_SLAB), DM}; run_gemm(lds, g, S, E);
            if (G == 256 && !lastl && bx >= 88) deferred_convert(ws, lds, l + 1, 6720, 10752, bx - 88, 24, wave, lane);
            SEAM(fb + 2); }
    }
    if (PH_ON(14) && IN(N_PHASES - 1)) { WSP(); final_norm_phase((const bf16_t*)(ws + WS_X), INP(23), KARG(float*, 192), gw, NGW, lane); }
#undef IN
#undef SEAM
}

extern "C" void kernel_launch(void* const* d_in, const int* in_sizes, int n_in, void* d_out, int out_size, void* d_ws, size_t ws_size, hipStream_t stream) {
    static int grid = 0;
    if (grid == 0) {
        if (n_in != 24 || in_sizes[0] != SEQ * DM || out_size != SEQ * DM || ws_size < WS_END) { fprintf(stderr, "kernel_launch: unexpected shapes (n_in %d, in0 %d, out %d, ws %zu < %zu)\n", n_in, n_in > 0 ? in_sizes[0] : -1, out_size, ws_size, (size_t)WS_END); grid = -1; return; }
        int dev = 0, cus = 0, per_cu = 0;
        if (hipGetDevice(&dev) != hipSuccess || hipDeviceGetAttribute(&cus, hipDeviceAttributeMultiprocessorCount, dev) != hipSuccess) { grid = -1; return; }
        if (hipFuncSetAttribute((const void*)mk_fwd, hipFuncAttributeMaxDynamicSharedMemorySize, LDS_BYTES) != hipSuccess) { fprintf(stderr, "kernel_launch: hipFuncSetAttribute failed\n"); grid = -1; return; }
        if (hipOccupancyMaxActiveBlocksPerMultiprocessor(&per_cu, (const void*)mk_fwd, NWAVES * 64, LDS_BYTES) != hipSuccess || per_cu < 1) fprintf(stderr, "kernel_launch: occupancy query says %d\n", per_cu);
        (void)hipGetLastError();
        grid = cus;
    }
    if (grid < 0) return;
    (void)hipMemsetAsync((char*)d_ws, 0, 32768, stream);
    Args a{};
    for (int i = 0; i < 24; ++i) a.in[i] = (const float*)d_in[i];
    a.out = (float*)d_out; a.ws = (unsigned char*)d_ws;
#if MK_ONE_LAUNCH
    a.ph_lo = 0; a.ph_hi = N_PHASES;
    hipLaunchKernelGGL(mk_fwd, dim3(grid), dim3(NWAVES * 64), LDS_BYTES, stream, a);
#else
    for (int k = 0; k < N_PHASES; ++k) {
        if (k >= 1 && k < N_PHASES - 1) { const int l = (k - 1) / 8, s = (k - 1) % 8; if ((l & 1) == 0 && s == 7) continue; }
        a.ph_lo = k; a.ph_hi = k + 1;
        hipLaunchKernelGGL(mk_fwd, dim3(grid), dim3(NWAVES * 64), LDS_BYTES, stream, a);
    }
#endif
    const hipError_t le = hipPeekAtLastError();
    if (le != hipSuccess) fprintf(stderr, "kernel_launch: launch failed: %s\n", hipGetErrorName(le));
}
```

```cpp
#include <hip/hip_runtime.h>
#include <cstdio>
#include <cstdint>

#ifndef MK_ONE_LAUNCH
#define MK_ONE_LAUNCH 1
#endif
#ifndef MK_SIMPLE_ATTN
#define MK_SIMPLE_ATTN 0
#endif
#ifndef MK_SIMPLE_GEMM
#define MK_SIMPLE_GEMM 0
#endif

#define LAS __attribute__((address_space(3)))
#define GAS __attribute__((address_space(1)))
typedef unsigned short bf16_t;
typedef short bf16x8 __attribute__((ext_vector_type(8)));
typedef float f32x4 __attribute__((ext_vector_type(4)));
typedef float f32x2 __attribute__((ext_vector_type(2)));
typedef float f32x16 __attribute__((ext_vector_type(16)));
typedef unsigned u32x4 __attribute__((ext_vector_type(4)));
typedef unsigned u32x2 __attribute__((ext_vector_type(2)));

constexpr int DM = 2048, SEQ = 8192, CTXL = 256, R = SEQ + CTXL, NPANEL = R / 256, DEPTH = 4;
constexpr int EVEN_IN = 4096, FF = 5632, QLORA = 512, KVLORA = 512, NHEAD = 16, QKN = 128, QKR = 64, VD = 128, QHD = QKN + QKR;
constexpr int NQ = NHEAD * QHD  , NKV = NHEAD * (QKN + VD)  , NDQKV = 1280  ;
constexpr float EPS = 1e-6f;
constexpr float QSCALE = 0.07216878364870322f * 1.4426950408889634f;

__device__ __forceinline__ unsigned cvt_pk_bf16(float lo, float hi) { unsigned r; asm volatile("v_cvt_pk_bf16_f32 %0, %1, %2" : "=v"(r) : "v"(lo), "v"(hi)); return r; }
__device__ __forceinline__ float bf_lo(unsigned w) { return __uint_as_float(w << 16); }
__device__ __forceinline__ float bf_hi(unsigned w) { return __uint_as_float(w & 0xffff0000u); }
template <int K> __device__ __forceinline__ float xor_add(float v) {
    if constexpr (K < 32) return v + __builtin_bit_cast(float, __builtin_amdgcn_ds_swizzle(__builtin_bit_cast(int, v), (K << 10) | 0x1F));
    else { auto rr = __builtin_amdgcn_permlane32_swap(__float_as_uint(v), __float_as_uint(v), false, false); return __uint_as_float(rr[0]) + __uint_as_float(rr[1]); }
}
__device__ __forceinline__ float wave_sum(float v) { v = xor_add<1>(v); v = xor_add<2>(v); v = xor_add<4>(v); v = xor_add<8>(v); v = xor_add<16>(v); return xor_add<32>(v); }

__device__ __forceinline__ int otid() { int t = threadIdx.x; asm volatile("" : "+v"(t)); return t; }
__device__ __forceinline__ int obid() { int b = blockIdx.x; asm volatile("" : "+s"(b)); return b; }
template <class T> __device__ __forceinline__ T karg_ld(int off) { const __attribute__((address_space(4))) char* k = (const __attribute__((address_space(4))) char*)__builtin_amdgcn_kernarg_segment_ptr(); asm volatile("" : "+s"(k)); return *(const __attribute__((address_space(4))) T*)(k + off); }
#define KARG(type, off) karg_ld<type>(off)
#define INP(k) KARG(const float*, 8 * (k))
namespace pg8 {
constexpr int BM = 256, BK = 64, HALF = 128, HTB = HALF * BK * 2, STAGE_BYTES = 8 * HTB, NXCD = 8, WGM = 8;
__host__ __device__ __forceinline__ int lds_byte(int r, int c) { const int st = (r >> 4) * 2 + (c >> 5), rr = r & 15, cc = c & 31, ob = rr * 64 + cc * 2; return st * 1024 + (ob ^ (((ob >> 9) & 1) << 5)); }
__host__ __device__ __forceinline__ void stage_rc(int b, int& Rr, int& C) { const int st = b / 1024, sb = b % 1024, swz = sb ^ (((sb >> 9) & 1) << 5); Rr = (st >> 1) * 16 + swz / 64; C = (st & 1) * 32 + (swz % 64) / 2; }
__host__ __device__ __forceinline__ int perm32(int rho) { const int n = rho >> 4, i = rho & 15; return 8 * (i >> 2) + 4 * n + (i & 3); }

struct Unit { int pm, pn, ka, kb, nt, aux; };
struct Gemm { const bf16_t* A; const bf16_t* Bt; int lda, ldb, nt; };

struct StaticOrder {
    int nM, nN, nwg, G, c, nt;
    __device__ void init(int nM_, int nN_, int G_, int c_, int nt_) { nM = nM_; nN = nN_; nwg = nM * nN; G = G_; c = c_; nt = nt_; }
    __device__ __forceinline__ bool next(int i, Unit& u) const {
        const long L = (long)i * G + c; if (L >= nwg) return false;
        int wgid = (int)L; { const int q = nwg / NXCD, r = nwg % NXCD, xcd = wgid % NXCD, off = wgid / NXCD; wgid = (xcd < r ? xcd * (q + 1) : r * (q + 1) + (xcd - r) * q) + off; }
        const int nig = WGM * nN, gid = wgid / nig, fm = gid * WGM, gsz = (nM - fm) < WGM ? (nM - fm) : WGM;
        u.pm = fm + ((wgid % nig) % gsz); u.pn = (wgid % nig) / gsz; u.ka = 0; u.kb = 0; u.nt = nt; u.aux = 0; return true;
    }
};
struct FoldOrder {
    int c;
    __device__ bool next(int i, Unit& u) const { if (i > 0 || c >= 32) return false; u.pm = c & 3; u.pn = c >> 2; u.ka = 0; u.kb = 256 * (c & 3); u.nt = 4; u.aux = 0; return true; }
};

struct LatCtxOrder {
    StaticOrder so; int ntn, nsl, kchunk;
    __device__ __forceinline__ bool next(int i, Unit& u) const {
        Unit a; a.pm = 0; a.pn = 0; a.ka = 0; a.kb = 0; a.nt = so.nt; a.aux = 0;
        const bool ok1 = so.next(i, a);
        const int nL = so.c < so.nwg ? (so.nwg - so.c + so.G - 1) / so.G : 0, s = so.c + (i - nL) * so.G;
        const bool ok2 = !ok1 && s >= 0 && s < nsl;
        const int sl = s / ntn, ko = sl * kchunk;
        u.pm = ok1 ? a.pm : 32; u.pn = ok1 ? a.pn : s - sl * ntn; u.aux = ok1 ? 0 : sl; u.ka = ok1 ? 0 : ko; u.kb = ok1 ? 0 : ko; u.nt = ok1 ? so.nt : kchunk / 64;
        return ok1 || ok2;
    }
};
__device__ __forceinline__ void pg8_glds(const char* sbase, unsigned voff, unsigned lds_dst) {
    asm volatile("s_mov_b32 m0, %2\n\ts_nop 0\n\tglobal_load_lds_dwordx4 %1, %0" :: "s"(sbase), "v"(voff), "s"(lds_dst) : "memory", "m0"); }
template <class Epi, class Sched>
__device__ __forceinline__ void gemm_simple(const Gemm g, const Sched& S, const Epi& E) {
    const int tid = otid(), wid = __builtin_amdgcn_readfirstlane(tid >> 6), lane = tid & 63, wr = wid >> 2, wc = wid & 3, fr = lane & 15, fq = lane >> 4;
    Unit u;
    for (int i = 0; S.next(i, u); ++i) {
        f32x4 acc[2][2][4][2];
#pragma unroll
        for (int a = 0; a < 2; ++a)
#pragma unroll
            for (int b = 0; b < 2; ++b)
#pragma unroll
                for (int m = 0; m < 4; ++m)
#pragma unroll
                    for (int n = 0; n < 2; ++n) acc[a][b][m][n] = (f32x4){0.f, 0.f, 0.f, 0.f};
        const bf16_t* A = g.A + (size_t)u.pm * 256 * g.lda + u.ka + (size_t)(64 * wr + fr) * g.lda + fq * 8;
        int rb[2];
#pragma unroll
        for (int n = 0; n < 2; ++n) { const int rho = 16 * n + fr; rb[n] = Epi::PERM ? perm32(rho) : rho; }
        const bf16_t* B = g.Bt + (size_t)u.pn * 256 * g.ldb + u.kb + (size_t)(32 * wc) * g.ldb + fq * 8;
        bf16x8 a[2][4], b[2][2], an[2][4], bn[2][2];
        const int kend = u.nt * 64;
#define GS_LOAD(DA, DB, KK) do { _Pragma("unroll") for (int ai = 0; ai < 2; ++ai) _Pragma("unroll") for (int m = 0; m < 4; ++m) DA[ai][m] = *(const bf16x8*)(A + (size_t)(128 * ai + 16 * m) * g.lda + (KK)); \
            _Pragma("unroll") for (int bj = 0; bj < 2; ++bj) _Pragma("unroll") for (int n = 0; n < 2; ++n) DB[bj][n] = *(const bf16x8*)(B + (size_t)(128 * bj + rb[n]) * g.ldb + (KK)); } while (0)
        GS_LOAD(a, b, 0);
#pragma unroll 1
        for (int kk = 0; kk < kend; kk += 32) {
            const int kn = (kk + 32 < kend) ? kk + 32 : kk;
            GS_LOAD(an, bn, kn);
#pragma unroll
            for (int ai = 0; ai < 2; ++ai)
#pragma unroll
                for (int bj = 0; bj < 2; ++bj)
#pragma unroll
                    for (int m = 0; m < 4; ++m)
#pragma unroll
                        for (int n = 0; n < 2; ++n) acc[ai][bj][m][n] = __builtin_amdgcn_mfma_f32_16x16x32_bf16(b[bj][n], a[ai][m], acc[ai][bj][m][n], 0, 0, 0);
#pragma unroll
            for (int ai = 0; ai < 2; ++ai)
#pragma unroll
                for (int m = 0; m < 4; ++m) a[ai][m] = an[ai][m];
#pragma unroll
            for (int bj = 0; bj < 2; ++bj)
#pragma unroll
                for (int n = 0; n < 2; ++n) b[bj][n] = bn[bj][n];
        }
#undef GS_LOAD
        E(acc, u, wr, wc, fr, fq);
    }
}

template <class Epi, class Sched, bool ALIGN_EPI = true, bool SP2 = true>
__device__ __forceinline__ void gemm_phase(LAS unsigned char* lds, const Gemm g, const Sched& S, const Epi& E) {
    const int tid = otid(), wid = __builtin_amdgcn_readfirstlane(tid >> 6), lane = tid & 63, wr = wid >> 2, wc = wid & 3, fr = lane & 15, fq = lane >> 4;
    unsigned voffA[2], voffB[2];
#pragma unroll
    for (int i = 0; i < 2; ++i) { int Rr, C; stage_rc(tid * 16 + i * 8192, Rr, C); const int Rb = Epi::PERM ? ((Rr & ~31) + perm32(Rr & 31)) : Rr;
        voffA[i] = (unsigned)(Rr * g.lda + C) * 2u; voffB[i] = (unsigned)(Rb * g.ldb + C) * 2u; }
    const size_t kstep = (size_t)(BK * 2);
    const size_t hstepA = (size_t)HALF * g.lda * 2, hstepB = (size_t)HALF * g.ldb * 2;
    const size_t tstepA = 2 * hstepA, tstepB = 2 * hstepB;
    const unsigned ldsw = (unsigned)wid * 1024u, lds0 = (unsigned)(uintptr_t)lds;
    const int aoff = lds_byte(wr * 64 + fr, fq * 8), boff = lds_byte(wc * 32 + fr, fq * 8);
    LAS unsigned char* ldsA = lds + aoff; LAS unsigned char* ldsB = lds + 4 * HTB + boff;
    asm volatile("" : "+v"(ldsA), "+v"(ldsB));
#define PG8_SA(b, h) (((b) * 2 + (h)) * HTB)
#define PG8_SB(b, h) ((4 + (b) * 2 + (h)) * HTB)
#define PG8_STAGE(bufoff, gbase, voff) do { _Pragma("unroll") for (int _i = 0; _i < 2; ++_i) \
        pg8_glds((const char*)(gbase), (voff)[_i], (unsigned)__builtin_amdgcn_readfirstlane((int)(lds0 + (unsigned)(bufoff) + ldsw + (unsigned)(_i * 8192)))); } while (0)
#define PG8_LDA(dst, b, h) do { _Pragma("unroll") for (int m = 0; m < 4; ++m) _Pragma("unroll") for (int k = 0; k < 2; ++k) dst[m][k] = *(const LAS bf16x8*)(ldsA + PG8_SA(b, h) + m * 2048 + k * 1024); } while (0)
#define PG8_LDB(dst, b, h) do { _Pragma("unroll") for (int n = 0; n < 2; ++n) _Pragma("unroll") for (int k = 0; k < 2; ++k) dst[n][k] = *(const LAS bf16x8*)(ldsB + ((b) * 2 + (h)) * HTB + n * 2048 + k * 1024); } while (0)
#define PG8_MMA(ai, bj, At, Bt) do { __builtin_amdgcn_s_setprio(1); _Pragma("unroll") for (int m = 0; m < 4; ++m) _Pragma("unroll") for (int n = 0; n < 2; ++n) _Pragma("unroll") for (int k = 0; k < 2; ++k) \
        acc[ai][bj][m][n] = __builtin_amdgcn_mfma_f32_16x16x32_bf16(Bt[n][k], At[m][k], acc[ai][bj][m][n], 0, 0, 0); __builtin_amdgcn_s_setprio(0); } while (0)
#define PG8_WAIT_V(n) asm volatile("s_waitcnt vmcnt(" #n ")" ::: "memory")
#define PG8_WAIT_L(n) asm volatile("s_waitcnt lgkmcnt(" #n ")" ::: "memory")
#define PG8_BAR __builtin_amdgcn_s_barrier()
#define PG8_SCHED __builtin_amdgcn_sched_barrier(0)
    Unit cur, nxt; int ui = 0;
    if (!S.next(0, cur)) return;
    f32x4 acc[2][2][4][2];
#pragma unroll
    for (int a = 0; a < 2; ++a)
#pragma unroll
        for (int b = 0; b < 2; ++b)
#pragma unroll
            for (int m = 0; m < 4; ++m)
#pragma unroll
                for (int n = 0; n < 2; ++n) acc[a][b][m][n] = (f32x4){0.f, 0.f, 0.f, 0.f};
    bf16x8 At[4][2], B0[2][2], B1[2][2];
    const char* cA = (const char*)g.A + (size_t)cur.pm * tstepA + (size_t)cur.ka * 2; const char* cB = (const char*)g.Bt + (size_t)cur.pn * tstepB + (size_t)cur.kb * 2;
    if constexpr (SP2) {
        PG8_STAGE(PG8_SB(0, 0), cB, voffB); PG8_STAGE(PG8_SB(0, 1), cB + hstepB, voffB); PG8_STAGE(PG8_SA(0, 0), cA, voffA); PG8_STAGE(PG8_SA(0, 1), cA + hstepA, voffA);
        if (wr == 1) PG8_BAR;
        PG8_WAIT_V(2); PG8_BAR;
        PG8_STAGE(PG8_SB(1, 0), cB + kstep, voffB); PG8_STAGE(PG8_SA(1, 0), cA + kstep, voffA); PG8_STAGE(PG8_SB(1, 1), cB + hstepB + kstep, voffB);
        PG8_WAIT_V(6); PG8_BAR;
    } else {
        PG8_STAGE(PG8_SB(0, 0), cB, voffB); PG8_STAGE(PG8_SA(0, 0), cA, voffA); PG8_STAGE(PG8_SB(0, 1), cB + hstepB, voffB); PG8_STAGE(PG8_SA(0, 1), cA + hstepA, voffA);
        if (wr == 1) PG8_BAR;
        PG8_WAIT_V(4); PG8_BAR;
        PG8_STAGE(PG8_SB(1, 0), cB + kstep, voffB); PG8_STAGE(PG8_SA(1, 0), cA + kstep, voffA); PG8_STAGE(PG8_SB(1, 1), cB + hstepB + kstep, voffB);
        PG8_WAIT_V(6); PG8_BAR;
    }
    for (;;) {
        const bool has_next = S.next(ui + 1, nxt);
        const char* nA = has_next ? (const char*)g.A + (size_t)nxt.pm * tstepA + (size_t)nxt.ka * 2 : cA; const char* nB = has_next ? (const char*)g.Bt + (size_t)nxt.pn * tstepB + (size_t)nxt.kb * 2 : cB;
        const int nt = cur.nt;
        for (int t = 0; t < nt; t += 2) {
            const bool last = (t == nt - 2);
            const char* a1 = cA + (size_t)(t + 1) * kstep;
            const char* a2 = last ? nA : cA + (size_t)(t + 2) * kstep; const char* b2 = last ? nB : cB + (size_t)(t + 2) * kstep;
            const char* a3 = a2 + kstep; const char* b3 = b2 + kstep;
            if constexpr (SP2) {
            PG8_LDB(B0, 0, 0); PG8_LDB(B1, 0, 1); PG8_SCHED; PG8_LDA(At, 0, 0); PG8_STAGE(PG8_SA(1, 1), a1 + hstepA, voffA);
            PG8_WAIT_V(8); PG8_WAIT_L(0); PG8_BAR; PG8_MMA(0, 0, At, B0); PG8_MMA(0, 1, At, B1); PG8_BAR; PG8_SCHED;
            PG8_LDA(At, 0, 1); PG8_STAGE(PG8_SB(0, 0), b2, voffB); PG8_STAGE(PG8_SB(0, 1), b2 + hstepB, voffB); PG8_STAGE(PG8_SA(0, 0), a2, voffA);
            PG8_WAIT_V(8); PG8_WAIT_L(0); PG8_BAR; PG8_MMA(1, 0, At, B0); PG8_MMA(1, 1, At, B1); PG8_BAR; PG8_SCHED;
            PG8_LDB(B0, 1, 0); PG8_LDB(B1, 1, 1); PG8_SCHED; PG8_LDA(At, 1, 0); PG8_STAGE(PG8_SA(0, 1), a2 + hstepA, voffA);
            PG8_WAIT_V(8); PG8_WAIT_L(0); PG8_BAR; PG8_MMA(0, 0, At, B0); PG8_MMA(0, 1, At, B1); PG8_BAR; PG8_SCHED;
            PG8_LDA(At, 1, 1); PG8_STAGE(PG8_SB(1, 0), b3, voffB); PG8_STAGE(PG8_SB(1, 1), b3 + hstepB, voffB); PG8_STAGE(PG8_SA(1, 0), a3, voffA);
            PG8_WAIT_V(8); PG8_WAIT_L(0); PG8_BAR; PG8_MMA(1, 0, At, B0); PG8_MMA(1, 1, At, B1); PG8_BAR; PG8_SCHED;
            } else {
            PG8_LDB(B0, 0, 0); PG8_SCHED; PG8_LDA(At, 0, 0); PG8_STAGE(PG8_SA(1, 1), a1 + hstepA, voffA);
            PG8_WAIT_L(8); PG8_BAR; PG8_WAIT_L(0); PG8_MMA(0, 0, At, B0); PG8_BAR; PG8_SCHED;
            PG8_LDB(B1, 0, 1); PG8_STAGE(PG8_SB(0, 0), b2, voffB);
            PG8_BAR; PG8_WAIT_L(0); PG8_MMA(0, 1, At, B1); PG8_BAR;
            PG8_LDA(At, 0, 1); PG8_STAGE(PG8_SA(0, 0), a2, voffA);
            PG8_BAR; PG8_WAIT_L(0); PG8_MMA(1, 0, At, B0); PG8_BAR; PG8_SCHED;
            PG8_STAGE(PG8_SB(0, 1), b2 + hstepB, voffB);
            PG8_WAIT_V(6); PG8_BAR; PG8_MMA(1, 1, At, B1); PG8_BAR;
            PG8_LDB(B0, 1, 0); PG8_SCHED; PG8_LDA(At, 1, 0); PG8_STAGE(PG8_SA(0, 1), a2 + hstepA, voffA);
            PG8_WAIT_L(8); PG8_BAR; PG8_WAIT_L(0); PG8_MMA(0, 0, At, B0); PG8_BAR; PG8_SCHED;
            PG8_LDB(B1, 1, 1); PG8_STAGE(PG8_SB(1, 0), b3, voffB);
            PG8_BAR; PG8_WAIT_L(0); PG8_MMA(0, 1, At, B1); PG8_BAR;
            PG8_LDA(At, 1, 1); PG8_STAGE(PG8_SA(1, 0), a3, voffA);
            PG8_BAR; PG8_WAIT_L(0); PG8_MMA(1, 0, At, B0); PG8_BAR; PG8_SCHED;
            PG8_STAGE(PG8_SB(1, 1), b3 + hstepB, voffB);
            PG8_WAIT_V(6); PG8_BAR; PG8_MMA(1, 1, At, B1); PG8_BAR;
            }
        }
        if constexpr (ALIGN_EPI) { if (wr == 0) PG8_BAR; }
        E(acc, cur, wr, wc, fr, fq);
        if (!has_next) break;
#pragma unroll
        for (int a = 0; a < 2; ++a)
#pragma unroll
            for (int b = 0; b < 2; ++b)
#pragma unroll
                for (int m = 0; m < 4; ++m)
#pragma unroll
                    for (int n = 0; n < 2; ++n) acc[a][b][m][n] = (f32x4){0.f, 0.f, 0.f, 0.f};
        cur = nxt; cA = nA; cB = nB; ++ui;
        if constexpr (ALIGN_EPI) { if (wr == 1) PG8_BAR; }
    }
    PG8_WAIT_V(0);
    if constexpr (!ALIGN_EPI) { if (wr == 0) PG8_BAR; }
    PG8_BAR;
#undef PG8_SA
#undef PG8_SB
#undef PG8_STAGE
#undef PG8_LDA
#undef PG8_LDB
#undef PG8_MMA
#undef PG8_WAIT_V
#undef PG8_WAIT_L
#undef PG8_BAR
#undef PG8_SCHED
}
}

typedef f32x4 Acc[2][2][4][2];
__device__ __forceinline__ u32x4 pack8(f32x4 v0, f32x4 v1) { u32x4 w; w.x = cvt_pk_bf16(v0[0], v0[1]); w.y = cvt_pk_bf16(v0[2], v0[3]); w.z = cvt_pk_bf16(v1[0], v1[1]); w.w = cvt_pk_bf16(v1[2], v1[3]); return w; }

struct EpiBf16 {
    static constexpr bool PERM = true;
    bf16_t* O; int ldc; const float* rs;
    __device__ __forceinline__ void operator()(const Acc& acc, const pg8::Unit& u, int wr, int wc, int fr, int fq) const {
        const int row0 = u.pm * 256 + wr * 64 + fr, col0 = u.pn * 256 + wc * 32 + 8 * fq;
        float sv[2][4];
#pragma unroll
        for (int ai = 0; ai < 2; ++ai)
#pragma unroll
            for (int m = 0; m < 4; ++m) sv[ai][m] = rs ? rs[row0 + ai * 128 + m * 16] : 1.f;
#pragma unroll
        for (int ai = 0; ai < 2; ++ai)
#pragma unroll
            for (int m = 0; m < 4; ++m) { const int row = row0 + ai * 128 + m * 16; const float s = sv[ai][m]; bf16_t* rowp = O + (size_t)row * ldc + col0;
#pragma unroll
                for (int bj = 0; bj < 2; ++bj) *(u32x4*)(rowp + bj * 128) = pack8(acc[ai][bj][m][0] * s, acc[ai][bj][m][1] * s); }
    }
};
typedef _Float16 h2_t __attribute__((ext_vector_type(2)));
__device__ __forceinline__ unsigned xpk(float lo, float hi) { const f32x2 v = {lo, hi}; const h2_t h = __builtin_convertvector(v, h2_t); return __builtin_bit_cast(unsigned, h); }
__device__ __forceinline__ f32x2 xun(unsigned w) { return __builtin_convertvector(__builtin_bit_cast(h2_t, w), f32x2); }
__device__ __forceinline__ u32x4 xpack8(f32x4 a, f32x4 b) { u32x4 w; w.x = xpk(a[0], a[1]); w.y = xpk(a[2], a[3]); w.z = xpk(b[0], b[1]); w.w = xpk(b[2], b[3]); return w; }
__device__ __forceinline__ void xunpack8(const u32x4 w, f32x4& a, f32x4& b) { const f32x2 p = xun(w.x), q = xun(w.y), r = xun(w.z), s = xun(w.w); a = (f32x4){p[0], p[1], q[0], q[1]}; b = (f32x4){r[0], r[1], s[0], s[1]}; }
__device__ __forceinline__ void unpack8(const u32x4 w, f32x4& a, f32x4& b) { a = (f32x4){bf_lo(w.x), bf_hi(w.x), bf_lo(w.y), bf_hi(w.y)}; b = (f32x4){bf_lo(w.z), bf_hi(w.z), bf_lo(w.w), bf_hi(w.w)}; }
struct EpiResid {
    static constexpr bool PERM = true;
    const float* base32; const bf16_t* base16; bf16_t* out; const float* gate;
    __device__ __forceinline__ void operator()(const Acc& acc, const pg8::Unit& u, int wr, int wc, int fr, int fq) const {
        const int row0 = u.pm * 256 + wr * 64 + fr, col0 = u.pn * 256 + wc * 32 + 8 * fq;
        f32x4 gv[2][2];
#pragma unroll
        for (int bj = 0; bj < 2; ++bj)
#pragma unroll
            for (int n = 0; n < 2; ++n) gv[bj][n] = *(const f32x4*)(gate + col0 + bj * 128 + n * 4);
#pragma unroll
        for (int ai = 0; ai < 2; ++ai) {
            if (base32) {
#pragma unroll
                for (int mh = 0; mh < 4; mh += 2) { f32x4 xf[2][2][2];
#pragma unroll
                    for (int m = 0; m < 2; ++m)
#pragma unroll
                        for (int bj = 0; bj < 2; ++bj) { const float* p = base32 + (size_t)(row0 + ai * 128 + (mh + m) * 16) * DM + col0 + bj * 128; xf[m][bj][0] = __builtin_nontemporal_load((const f32x4*)p); xf[m][bj][1] = __builtin_nontemporal_load((const f32x4*)(p + 4)); }
#pragma unroll
                    for (int m = 0; m < 2; ++m) { const size_t off = (size_t)(row0 + ai * 128 + (mh + m) * 16) * DM + col0;
#pragma unroll
                        for (int bj = 0; bj < 2; ++bj) *(u32x4*)(out + off + bj * 128) = xpack8(xf[m][bj][0] + gv[bj][0] * acc[ai][bj][mh + m][0], xf[m][bj][1] + gv[bj][1] * acc[ai][bj][mh + m][1]); }
                    asm volatile("" ::: "memory"); }
            } else {
                u32x4 xb[4][2];
#pragma unroll
                for (int m = 0; m < 4; ++m)
#pragma unroll
                    for (int bj = 0; bj < 2; ++bj) xb[m][bj] = *(const u32x4*)(base16 + (size_t)(row0 + ai * 128 + m * 16) * DM + col0 + bj * 128);
#pragma unroll
                for (int m = 0; m < 4; ++m) { const size_t off = (size_t)(row0 + ai * 128 + m * 16) * DM + col0;
#pragma unroll
                    for (int bj = 0; bj < 2; ++bj) { f32x4 b0, b1; xunpack8(xb[m][bj], b0, b1);
                        *(u32x4*)(out + off + bj * 128) = xpack8(b0 + gv[bj][0] * acc[ai][bj][m][0], b1 + gv[bj][1] * acc[ai][bj][m][1]); } }
                asm volatile("" ::: "memory");
            }
        }
    }
};
__device__ __forceinline__ float silu_f(float x) { return x * __builtin_amdgcn_rcpf(1.f + __builtin_amdgcn_exp2f(-1.4426950408889634f * x)); }
struct EpiSwiGLU {
    static constexpr bool PERM = true;
    bf16_t* O;
    __device__ __forceinline__ void operator()(const Acc& acc, const pg8::Unit& u, int wr, int wc, int fr, int fq) const {
        const int row0 = u.pm * 256 + wr * 64 + fr, col0 = u.pn * 128 + wc * 32 + 8 * fq;
#pragma unroll
        for (int ai = 0; ai < 2; ++ai)
#pragma unroll
            for (int m = 0; m < 4; ++m) { f32x4 o0, o1;
#pragma unroll
                for (int e = 0; e < 4; ++e) { o0[e] = silu_f(acc[ai][0][m][0][e]) * acc[ai][1][m][0][e]; o1[e] = silu_f(acc[ai][0][m][1][e]) * acc[ai][1][m][1][e]; }
                *(u32x4*)(O + (size_t)(row0 + ai * 128 + m * 16) * FF + col0) = pack8(o0, o1); }
    }
};
__device__ __forceinline__ void rope8(f32x4& v0, f32x4& v1, const f32x4 cs0, const f32x4 cs1) {
    const float a0 = v0[0] * cs0[0] - v0[1] * cs0[1], b0 = v0[1] * cs0[0] + v0[0] * cs0[1];
    const float a1 = v0[2] * cs0[2] - v0[3] * cs0[3], b1 = v0[3] * cs0[2] + v0[2] * cs0[3];
    const float a2 = v1[0] * cs1[0] - v1[1] * cs1[1], b2 = v1[1] * cs1[0] + v1[0] * cs1[1];
    const float a3 = v1[2] * cs1[2] - v1[3] * cs1[3], b3 = v1[3] * cs1[2] + v1[2] * cs1[3];
    v0 = (f32x4){a0, b0, a1, b1}; v1 = (f32x4){a2, b2, a3, b3};
}
struct EpiDQKV {
    static constexpr bool PERM = true;
    bf16_t* QA; bf16_t* CKV; bf16_t* KR; float* SSQ; float* SSKV; const float* TAB;
    __device__ __forceinline__ void operator()(const Acc& acc, const pg8::Unit& u, int wr, int wc, int fr, int fq) const {
        const int row0 = u.pm * 256 + wr * 64 + fr;
        if (u.pn < 4) {
            bf16_t* O = (u.pn < 2) ? QA : CKV; float* SS = (u.pn < 2) ? SSQ : SSKV; const int ct = u.pn & 1, col0 = ct * 256 + wc * 32 + 8 * fq;
#pragma unroll
            for (int ai = 0; ai < 2; ++ai)
#pragma unroll
                for (int m = 0; m < 4; ++m) { const int row = row0 + ai * 128 + m * 16; float s = 0.f;
#pragma unroll
                    for (int bj = 0; bj < 2; ++bj) { const f32x4 v0 = acc[ai][bj][m][0], v1 = acc[ai][bj][m][1];
                        s += (v0[0] * v0[0] + v0[1] * v0[1]) + (v0[2] * v0[2] + v0[3] * v0[3]) + (v1[0] * v1[0] + v1[1] * v1[1]) + (v1[2] * v1[2] + v1[3] * v1[3]);
                        *(u32x4*)(O + (size_t)row * 512 + col0 + bj * 128) = pack8(v0, v1); }
                    s = xor_add<16>(s); s = xor_add<32>(s);
                    if (fq == 0) SS[(size_t)row * 8 + ct * 4 + wc] = s; }
        } else if (wc < 2) {
            const int col0 = wc * 32 + 8 * fq;
#pragma unroll
            for (int ai = 0; ai < 2; ++ai) { f32x4 t0[4], t1[4];
#pragma unroll
                for (int m = 0; m < 4; ++m) { const int row = row0 + ai * 128 + m * 16, rr = row < SEQ ? row : 0, pos = wc ? (rr & 63) : (rr >> 6); const f32x4* t = (const f32x4*)(TAB + (size_t)(pos * 16 + 4 * fq) * 2); t0[m] = t[0]; t1[m] = t[1]; }
#pragma unroll
                for (int m = 0; m < 4; ++m) { const int row = row0 + ai * 128 + m * 16; f32x4 v0 = acc[ai][0][m][0], v1 = acc[ai][0][m][1];
                    if (row < SEQ) rope8(v0, v1, t0[m], t1[m]);
                    *(u32x4*)(KR + (size_t)row * 64 + col0) = pack8(v0, v1); }
                asm volatile("" ::: "memory"); }
        }
    }
};
__device__ __forceinline__ float row_rstd8(const float* ss, int row, float inv_n) {
    const f32x4 a = *(const f32x4*)(ss + (size_t)row * 8), b = *(const f32x4*)(ss + (size_t)row * 8 + 4);
    return __builtin_amdgcn_rsqf(((a[0] + a[1]) + (a[2] + a[3]) + (b[0] + b[1]) + (b[2] + b[3])) * inv_n + EPS);
}
struct EpiUQ {
    static constexpr bool PERM = true;
    bf16_t* Q; const float* SSQ; const float* TAB;
    __device__ __forceinline__ void operator()(const Acc& acc, const pg8::Unit& u, int wr, int wc, int fr, int fq) const {
        const int row0 = u.pm * 256 + wr * 64 + fr;
        int c0[2], ropei[2];
#pragma unroll
        for (int bj = 0; bj < 2; ++bj) { c0[bj] = u.pn * 256 + bj * 128 + wc * 32 + 8 * fq; const int d0 = c0[bj] % QHD; ropei[bj] = (d0 >= QKN) ? ((d0 - QKN) >> 1) : -1; }
#pragma unroll
        for (int ai = 0; ai < 2; ++ai) {
            f32x4 sa[4], sb[4], t0[4], t1[4];
            const int ri = ropei[0] >= 0 ? ropei[0] : ropei[1];
#pragma unroll
            for (int m = 0; m < 4; ++m) { const int row = row0 + ai * 128 + m * 16; sa[m] = *(const f32x4*)(SSQ + (size_t)row * 8); sb[m] = *(const f32x4*)(SSQ + (size_t)row * 8 + 4); }
            if (ri >= 0) {
#pragma unroll
                for (int m = 0; m < 4; ++m) { const int row = row0 + ai * 128 + m * 16, rr = row < SEQ ? row : 0, pos = (ri >> 4) ? (rr & 63) : (rr >> 6); const f32x4* t = (const f32x4*)(TAB + (size_t)(pos * 16 + (ri & 15)) * 2); t0[m] = t[0]; t1[m] = t[1]; } }
#pragma unroll
            for (int m = 0; m < 4; ++m) { const int row = row0 + ai * 128 + m * 16;
                const float rs = __builtin_amdgcn_rsqf(((sa[m][0] + sa[m][1]) + (sa[m][2] + sa[m][3]) + (sb[m][0] + sb[m][1]) + (sb[m][2] + sb[m][3])) * (1.f / QLORA) + EPS);
#pragma unroll
                for (int bj = 0; bj < 2; ++bj) { f32x4 v0 = acc[ai][bj][m][0] * rs, v1 = acc[ai][bj][m][1] * rs;
                    if (ropei[bj] >= 0 && row < SEQ) rope8(v0, v1, t0[m], t1[m]);
                    *(u32x4*)(Q + (size_t)row * NQ + c0[bj]) = pack8(v0 * QSCALE, v1 * QSCALE); } }
            asm volatile("" ::: "memory");
        }
    }
};
struct EpiUKV {
    static constexpr bool PERM = true;
    bf16_t* KN; bf16_t* V; const float* SSKV;
    __device__ __forceinline__ void operator()(const Acc& acc, const pg8::Unit& u, int wr, int wc, int fr, int fq) const {
        const int row0 = u.pm * 256 + wr * 64 + fr, col0 = u.pn * 128 + wc * 32 + 8 * fq;
#pragma unroll
        for (int ai = 0; ai < 2; ++ai) {
            f32x4 sa[4], sb[4];
#pragma unroll
            for (int m = 0; m < 4; ++m) { const int row = row0 + ai * 128 + m * 16; sa[m] = *(const f32x4*)(SSKV + (size_t)row * 8); sb[m] = *(const f32x4*)(SSKV + (size_t)row * 8 + 4); }
#pragma unroll
            for (int m = 0; m < 4; ++m) { const int row = row0 + ai * 128 + m * 16;
                const float rs = __builtin_amdgcn_rsqf(((sa[m][0] + sa[m][1]) + (sa[m][2] + sa[m][3]) + (sb[m][0] + sb[m][1]) + (sb[m][2] + sb[m][3])) * (1.f / KVLORA) + EPS);
                *(u32x4*)(KN + (size_t)row * DM + col0) = pack8(acc[ai][0][m][0] * rs, acc[ai][0][m][1] * rs);
                *(u32x4*)(V + (size_t)row * DM + col0) = pack8(acc[ai][1][m][0] * rs, acc[ai][1][m][1] * rs); }
            asm volatile("" ::: "memory");
        }
    }
};

template <class Main> struct EpiWithSlab {
    static constexpr bool PERM = Main::PERM;
    static_assert(Main::PERM, "slab layout assumes 8 consecutive columns per lane");
    Main main; bf16_t* slab; int ldc;
    __device__ __forceinline__ void operator()(const Acc& acc, const pg8::Unit& u, int wr, int wc, int fr, int fq) const {
        if (u.pm != 32) { main(acc, u, wr, wc, fr, fq); return; }
        bf16_t* sp = slab + (size_t)u.aux * 256 * ldc + (size_t)(wr * 64 + fr) * ldc + u.pn * 256 + wc * 32 + 8 * fq;
#pragma unroll
        for (int ai = 0; ai < 2; ++ai)
#pragma unroll
            for (int m = 0; m < 4; ++m) { bf16_t* rp = sp + (size_t)(ai * 128 + m * 16) * ldc;
#pragma unroll
                for (int bj = 0; bj < 2; ++bj) *(u32x4*)(rp + bj * 128) = xpack8(acc[ai][bj][m][0], acc[ai][bj][m][1]); }
    }
};

namespace att {
__device__ __forceinline__ int crow(int r, int hi) { return (r & 3) + 8 * (r >> 2) + 4 * hi; }
constexpr float THR = 8.f;
__device__ __forceinline__ void partialSM(f32x16& p0, f32x16& p1, float& m_reg, float& alpha) {
    float pmax = p0[0];
#pragma unroll
    for (int r = 1; r < 16; ++r) pmax = fmaxf(pmax, p0[r]);
#pragma unroll
    for (int r = 0; r < 16; ++r) pmax = fmaxf(pmax, p1[r]);
    { auto rr = __builtin_amdgcn_permlane32_swap(__float_as_uint(pmax), __float_as_uint(pmax), false, false); pmax = fmaxf(__uint_as_float(rr[0]), __uint_as_float(rr[1])); }
    float mn;
    if (__builtin_expect(__all(pmax - m_reg <= THR), 1)) { mn = m_reg; alpha = 1.f; }
    else { mn = fmaxf(m_reg, pmax); alpha = __builtin_amdgcn_exp2f(m_reg - mn); m_reg = mn; }
#pragma unroll
    for (int r = 0; r < 16; ++r) { p0[r] = __builtin_amdgcn_exp2f(p0[r] - mn); p1[r] = p1[r] - mn; }
}
__device__ __forceinline__ void finishSM(const f32x16& p0, f32x16& p1, float alpha, float& l_reg, bf16x8& pa0, bf16x8& pa1, bf16x8& pa2, bf16x8& pa3) {
#pragma unroll
    for (int r = 0; r < 16; ++r) p1[r] = __builtin_amdgcn_exp2f(p1[r]);
    float ps = 0;
#pragma unroll
    for (int r = 0; r < 16; ++r) ps += p0[r];
#pragma unroll
    for (int r = 0; r < 16; ++r) ps += p1[r];
    { auto rr = __builtin_amdgcn_permlane32_swap(__float_as_uint(ps), __float_as_uint(ps), false, false); ps = __uint_as_float(rr[0]) + __uint_as_float(rr[1]); }
    l_reg = l_reg * alpha + ps;
#define PK4(P, BASE, OUT) do { unsigned a0 = cvt_pk_bf16(P[BASE + 0], P[BASE + 1]), a1 = cvt_pk_bf16(P[BASE + 2], P[BASE + 3]);   \
    unsigned b0 = cvt_pk_bf16(P[BASE + 4], P[BASE + 5]), b1 = cvt_pk_bf16(P[BASE + 6], P[BASE + 7]);                              \
    auto r0 = __builtin_amdgcn_permlane32_swap(a0, b0, false, false); auto r1 = __builtin_amdgcn_permlane32_swap(a1, b1, false, false); \
    u32x4 w = {r0[0], r1[0], r0[1], r1[1]}; OUT = *reinterpret_cast<bf16x8*>(&w); } while (0)
    PK4(p0, 0, pa0); PK4(p0, 8, pa1); PK4(p1, 0, pa2); PK4(p1, 8, pa3);
#undef PK4
}
__device__ __forceinline__ void unit_simple(const bf16_t* __restrict__ Q, const bf16_t* __restrict__ KN, const bf16_t* __restrict__ KR, const bf16_t* __restrict__ V, bf16_t* __restrict__ O,
                                            int h, int q0, int k0, int nkeys, LAS float* wsf) {
    const int tid = otid(), wid = tid >> 6, lane = tid & 63, r32 = lane & 31, hi = lane >> 5;
    const bf16_t* Qw = Q + (size_t)(q0 + wid * 32 + r32) * NQ + h * QHD + hi * 8;
    bf16x8 qn[8], qp[4];
#pragma unroll
    for (int d0 = 0; d0 < 8; ++d0) qn[d0] = *(const bf16x8*)(Qw + d0 * 16);
#pragma unroll
    for (int d0 = 0; d0 < 4; ++d0) qp[d0] = *(const bf16x8*)(Qw + QKN + d0 * 16);
    float m_reg = -1e30f, l_reg = 0.f; f32x16 o[4];
#pragma unroll
    for (int d = 0; d < 4; ++d) o[d] = f32x16{};
    for (int kt = 0; kt < nkeys; kt += 64) {
        f32x16 p0 = f32x16{}, p1 = f32x16{};
        const bf16_t* kn0 = KN + (size_t)(k0 + kt + r32) * DM + h * QKN + hi * 8; const bf16_t* kn1 = kn0 + (size_t)32 * DM;
#pragma unroll
        for (int d0 = 0; d0 < 8; ++d0) { const bf16x8 b0 = *(const bf16x8*)(kn0 + d0 * 16), b1 = *(const bf16x8*)(kn1 + d0 * 16);
            p0 = __builtin_amdgcn_mfma_f32_32x32x16_bf16(b0, qn[d0], p0, 0, 0, 0); p1 = __builtin_amdgcn_mfma_f32_32x32x16_bf16(b1, qn[d0], p1, 0, 0, 0); }
        const bf16_t* kr0 = KR + (size_t)(k0 + kt + r32) * QKR + hi * 8; const bf16_t* kr1 = kr0 + 32 * QKR;
#pragma unroll
        for (int d0 = 0; d0 < 4; ++d0) { const bf16x8 b0 = *(const bf16x8*)(kr0 + d0 * 16), b1 = *(const bf16x8*)(kr1 + d0 * 16);
            p0 = __builtin_amdgcn_mfma_f32_32x32x16_bf16(b0, qp[d0], p0, 0, 0, 0); p1 = __builtin_amdgcn_mfma_f32_32x32x16_bf16(b1, qp[d0], p1, 0, 0, 0); }
        float alpha; partialSM(p0, p1, m_reg, alpha);
        if (__any(alpha < 1.f)) { if (hi == 0) wsf[r32] = alpha; asm volatile("s_waitcnt lgkmcnt(0)" ::: "memory");
#pragma unroll
            for (int d = 0; d < 4; ++d)
#pragma unroll
                for (int r = 0; r < 16; ++r) o[d][r] *= wsf[crow(r, hi)];
            asm volatile("s_waitcnt lgkmcnt(0)" ::: "memory"); }
        bf16x8 pa[4]; finishSM(p0, p1, alpha, l_reg, pa[0], pa[1], pa[2], pa[3]);
#pragma unroll
        for (int ks = 0; ks < 4; ++ks) { const bf16_t* vb = V + (size_t)(k0 + kt + 16 * ks + 8 * hi) * DM + h * VD + r32;
#pragma unroll
            for (int d0 = 0; d0 < 4; ++d0) { bf16x8 bv;
#pragma unroll
                for (int j = 0; j < 8; ++j) bv[j] = (short)vb[(size_t)j * DM + d0 * 32];
                o[d0] = __builtin_amdgcn_mfma_f32_32x32x16_bf16(pa[ks], bv, o[d0], 0, 0, 0); } }
    }
    if (hi == 0) wsf[32 + r32] = l_reg; asm volatile("s_waitcnt lgkmcnt(0)" ::: "memory");
    bf16_t* Ow = O + (size_t)(q0 + wid * 32) * DM + h * VD + r32;
#pragma unroll
    for (int r = 0; r < 16; ++r) { const int orow = crow(r, hi); const float rl = __builtin_amdgcn_rcpf(wsf[32 + orow]);
#pragma unroll
        for (int d0 = 0; d0 < 4; ++d0) Ow[(size_t)orow * DM + d0 * 32] = (bf16_t)(cvt_pk_bf16(o[d0][r] * rl, 0.f) & 0xffffu); }
    asm volatile("s_waitcnt lgkmcnt(0)" ::: "memory");
}

constexpr int KN_SLOT = 16384, KR_SLOT = 8192, V_SLOT = 16384;
constexpr int L_KN = 0, L_KR = 3 * KN_SLOT, L_V = L_KR + 3 * KR_SLOT, L_WS = L_V + 3 * V_SLOT, ATT_LDS = L_WS + 8 * 256;
__device__ __forceinline__ void glds16(const void* gsrc, unsigned lds_dst) { unsigned keep;
    asm volatile("s_mov_b32 %0, m0\n\ts_mov_b32 m0, %2\n\ts_nop 0\n\tglobal_load_lds_dwordx4 %1, off\n\ts_mov_b32 m0, %0" : "=&s"(keep) : "v"(gsrc), "s"(lds_dst) : "memory"); }
__device__ __forceinline__ void glds16s(const char* sbase, unsigned voff, unsigned lds_dst) {
    asm volatile("s_mov_b32 m0, %2\n\ts_nop 0\n\tglobal_load_lds_dwordx4 %1, %0" :: "s"(sbase), "v"(voff), "s"(lds_dst) : "memory", "m0"); }
typedef short s16x4 __attribute__((ext_vector_type(4)));
__device__ __forceinline__ int v_rd_base(int lane) { return ((lane & 3) << 3) | (((lane >> 2) & 3) << 6) | (((lane >> 4) & 1) << 5) | (((lane >> 5) & 1) << 8); }
constexpr int v_rd_off(int d0, int ks, int half) { return d0 * 512 + ks * 4096 + half * 2048; }
template <int OFF> __device__ __forceinline__ s16x4 tr_read(int vb) { s16x4 r; asm volatile("ds_read_b64_tr_b16 %0, %1 offset:%2" : "=&v"(r) : "v"(vb), "i"(OFF) : "memory"); return r; }
template <int D0> __device__ __forceinline__ void pv_one(f32x16& od, int vb, bf16x8 pa0, bf16x8 pa1, bf16x8 pa2, bf16x8 pa3) {
    const s16x4 l0 = tr_read<v_rd_off(D0, 0, 0)>(vb), h0 = tr_read<v_rd_off(D0, 0, 1)>(vb), l1 = tr_read<v_rd_off(D0, 1, 0)>(vb), h1 = tr_read<v_rd_off(D0, 1, 1)>(vb);
    const s16x4 l2 = tr_read<v_rd_off(D0, 2, 0)>(vb), h2 = tr_read<v_rd_off(D0, 2, 1)>(vb), l3 = tr_read<v_rd_off(D0, 3, 0)>(vb), h3 = tr_read<v_rd_off(D0, 3, 1)>(vb);
    asm volatile("s_waitcnt lgkmcnt(0)" ::: "memory"); __builtin_amdgcn_sched_barrier(0);
#define PK(L, H) (bf16x8){L[0], L[1], L[2], L[3], H[0], H[1], H[2], H[3]}
    od = __builtin_amdgcn_mfma_f32_32x32x16_bf16(pa0, PK(l0, h0), od, 0, 0, 0);
    od = __builtin_amdgcn_mfma_f32_32x32x16_bf16(pa1, PK(l1, h1), od, 0, 0, 0);
    od = __builtin_amdgcn_mfma_f32_32x32x16_bf16(pa2, PK(l2, h2), od, 0, 0, 0);
    od = __builtin_amdgcn_mfma_f32_32x32x16_bf16(pa3, PK(l3, h3), od, 0, 0, 0);
#undef PK
}
__device__ __forceinline__ void pv_d0(f32x16* o, int vb, bf16x8 pa0, bf16x8 pa1, bf16x8 pa2, bf16x8 pa3) {
    pv_one<0>(o[0], vb, pa0, pa1, pa2, pa3); pv_one<1>(o[1], vb, pa0, pa1, pa2, pa3); pv_one<2>(o[2], vb, pa0, pa1, pa2, pa3); pv_one<3>(o[3], vb, pa0, pa1, pa2, pa3);
}
__device__ __forceinline__ void qkt(f32x16& p0, f32x16& p1, LAS unsigned char* kn, LAS unsigned char* kr, const bf16x8* qn, const bf16x8* qp, int r32, int hi) {
    p0 = f32x16{}; p1 = f32x16{};
#pragma unroll
    for (int d0 = 0; d0 < 8; ++d0) { const int cb = ((2 * d0 + hi) ^ (r32 & 15)) * 16;
        const bf16x8 b0 = *(const LAS bf16x8*)(kn + r32 * 256 + cb), b1 = *(const LAS bf16x8*)(kn + 8192 + r32 * 256 + cb);
        p0 = __builtin_amdgcn_mfma_f32_32x32x16_bf16(b0, qn[d0], p0, 0, 0, 0); p1 = __builtin_amdgcn_mfma_f32_32x32x16_bf16(b1, qn[d0], p1, 0, 0, 0); }
#pragma unroll
    for (int d0 = 0; d0 < 4; ++d0) { const int cb = ((2 * d0 + hi) ^ ((r32 >> 1) & 7)) * 16;
        const bf16x8 b0 = *(const LAS bf16x8*)(kr + r32 * 128 + cb), b1 = *(const LAS bf16x8*)(kr + 4096 + r32 * 128 + cb);
        p0 = __builtin_amdgcn_mfma_f32_32x32x16_bf16(b0, qp[d0], p0, 0, 0, 0); p1 = __builtin_amdgcn_mfma_f32_32x32x16_bf16(b1, qp[d0], p1, 0, 0, 0); }
}

typedef short v4i16_t __attribute__((ext_vector_type(4)));
template <int OFF> __device__ __forceinline__ s16x4 tr_rd(int vb) { return __builtin_bit_cast(s16x4, __builtin_amdgcn_ds_read_tr16_b64_v4i16((LAS v4i16_t*)(vb + OFF))); }
template <bool NOLDS> __device__ __forceinline__ void qkt_p(f32x16& p0, f32x16& p1, LAS unsigned char* kn, LAS unsigned char* kr, const bf16x8* qn, const bf16x8* qp, int r32, int hi) {
    const int swn = r32 & 15, swr = (r32 >> 1) & 7;
    LAS unsigned char* knr = kn + r32 * 256; LAS unsigned char* krr = kr + r32 * 128;
    bf16x8 k0[3], k1[3];
    p0 = f32x16{}; p1 = f32x16{};
#define KRD(D, I) do { if (NOLDS) { k0[I] = qn[(D) & 7]; k1[I] = qn[((D) + 1) & 7]; } else if ((D) < 8) { const int cb = ((2 * (D) + hi) ^ swn) * 16; k0[I] = *(const LAS bf16x8*)(knr + cb); k1[I] = *(const LAS bf16x8*)(knr + 8192 + cb); } \
                       else { const int cb = ((2 * ((D) - 8) + hi) ^ swr) * 16; k0[I] = *(const LAS bf16x8*)(krr + cb); k1[I] = *(const LAS bf16x8*)(krr + 4096 + cb); } } while (0)
    KRD(0, 0); KRD(1, 1); __builtin_amdgcn_sched_barrier(0);
#pragma unroll
    for (int D = 0; D < 12; ++D) {
        if (D + 2 < 12) KRD(D + 2, (D + 2) % 3);
        __builtin_amdgcn_sched_barrier(0);
        const bf16x8 q = D < 8 ? qn[D & 7] : qp[(D - 8) & 3];
        p0 = __builtin_amdgcn_mfma_f32_32x32x16_bf16(k0[D % 3], q, p0, 0, 0, 0); p1 = __builtin_amdgcn_mfma_f32_32x32x16_bf16(k1[D % 3], q, p1, 0, 0, 0);
        __builtin_amdgcn_sched_barrier(0);
    }
#undef KRD
}
template <bool NOLDS> __device__ __forceinline__ void pv_p(f32x16* o, int vb, bf16x8 pa0, bf16x8 pa1, bf16x8 pa2, bf16x8 pa3) {
    s16x4 va[8], vq[8];
#define VRD8(D0, X) do { if (NOLDS) { _Pragma("unroll") for (int _e = 0; _e < 8; ++_e) X[_e] = (s16x4){pa0[_e], pa1[_e], pa2[_e], pa3[_e]}; } else { X[0] = tr_rd<v_rd_off(D0, 0, 0)>(vb); X[1] = tr_rd<v_rd_off(D0, 0, 1)>(vb); X[2] = tr_rd<v_rd_off(D0, 1, 0)>(vb); X[3] = tr_rd<v_rd_off(D0, 1, 1)>(vb); \
                         X[4] = tr_rd<v_rd_off(D0, 2, 0)>(vb); X[5] = tr_rd<v_rd_off(D0, 2, 1)>(vb); X[6] = tr_rd<v_rd_off(D0, 3, 0)>(vb); X[7] = tr_rd<v_rd_off(D0, 3, 1)>(vb); } } while (0)
#define PKV(L, H) (bf16x8){L[0], L[1], L[2], L[3], H[0], H[1], H[2], H[3]}
#define PV4(OD, X) do { OD = __builtin_amdgcn_mfma_f32_32x32x16_bf16(pa0, PKV(X[0], X[1]), OD, 0, 0, 0); OD = __builtin_amdgcn_mfma_f32_32x32x16_bf16(pa1, PKV(X[2], X[3]), OD, 0, 0, 0); \
                         OD = __builtin_amdgcn_mfma_f32_32x32x16_bf16(pa2, PKV(X[4], X[5]), OD, 0, 0, 0); OD = __builtin_amdgcn_mfma_f32_32x32x16_bf16(pa3, PKV(X[6], X[7]), OD, 0, 0, 0); } while (0)
    VRD8(0, va); __builtin_amdgcn_sched_barrier(0);
    VRD8(1, vq); __builtin_amdgcn_sched_barrier(0); PV4(o[0], va); __builtin_amdgcn_sched_barrier(0);
    VRD8(2, va); __builtin_amdgcn_sched_barrier(0); PV4(o[1], vq); __builtin_amdgcn_sched_barrier(0);
    VRD8(3, vq); __builtin_amdgcn_sched_barrier(0); PV4(o[2], va); __builtin_amdgcn_sched_barrier(0);
    PV4(o[3], vq); __builtin_amdgcn_sched_barrier(0);
#undef VRD8
#undef PKV
#undef PV4
}
#define ATT_WAIT_BAR(N) asm volatile("s_waitcnt vmcnt(" #N ") lgkmcnt(0)\n\ts_barrier" ::: "memory")
__device__ __forceinline__ void unit_fast(const bf16_t* __restrict__ Q, const bf16_t* __restrict__ KN, const bf16_t* __restrict__ KR, const bf16_t* __restrict__ V, bf16_t* __restrict__ O,
                                          int h, int q0, int k0, int nkeys, LAS unsigned char* lds) {
    const int tid = otid(), wid = __builtin_amdgcn_readfirstlane(tid >> 6), lane = tid & 63, r32 = lane & 31, hi = lane >> 5;
    const unsigned lds0 = (unsigned)(uintptr_t)lds;
    LAS float* wsf = (LAS float*)(lds + L_WS) + wid * 64;
    unsigned kn_off[2], v_off[2], kr_off;
#pragma unroll
    for (int i = 0; i < 2; ++i) { const int row = 8 * wid + 4 * i + (lane >> 4), lc = (lane & 15) ^ (row & 15); kn_off[i] = (unsigned)(row * DM * 2 + h * QKN * 2 + lc * 16);
        const int s = 2 * (2 * wid + i) + (lane >> 5), kk = 8 * (s >> 2) + ((lane & 31) >> 2), k = (kk & ~0xC) | ((kk & 4) << 1) | ((kk & 8) >> 1), c = 32 * (s & 3) + 8 * (lane & 3);
        v_off[i] = (unsigned)(k * DM * 2 + h * VD * 2 + c * 2); }
    { const int row = 8 * wid + (lane >> 3), lc = (lane & 7) ^ ((row >> 1) & 7); kr_off = (unsigned)(row * QKR * 2 + lc * 16); }
    const char* KNg = (const char*)(KN + (size_t)k0 * DM); const char* KRg = (const char*)(KR + (size_t)k0 * QKR); const char* Vg = (const char*)(V + (size_t)k0 * DM);
    const unsigned dK = lds0 + L_KN + 2 * wid * 1024, dR = lds0 + L_KR + wid * 1024, dV = lds0 + L_V + 2 * wid * 1024;
#define DMA_K(t, sl) do { const char* _g = KNg + (size_t)(t) * (64 * DM * 2); const unsigned _d = (unsigned)__builtin_amdgcn_readfirstlane(dK + (sl) * KN_SLOT); \
        glds16(_g + kn_off[0], _d); glds16(_g + kn_off[1], _d + 1024); glds16(KRg + (size_t)(t) * (64 * QKR * 2) + kr_off, (unsigned)__builtin_amdgcn_readfirstlane(dR + (sl) * KR_SLOT)); } while (0)
#define DMA_V(t, sl) do { const char* _g = Vg + (size_t)(t) * (64 * DM * 2); const unsigned _d = (unsigned)__builtin_amdgcn_readfirstlane(dV + (sl) * V_SLOT); \
        glds16(_g + v_off[0], _d); glds16(_g + v_off[1], _d + 1024); } while (0)
    const int NT = nkeys / 64;
    DMA_K(0, 0); DMA_V(0, 0); DMA_K(1, 1);
    const bf16_t* Qw = Q + (size_t)(q0 + wid * 32 + r32) * NQ + h * QHD + hi * 8;
    bf16x8 qn[8], qp[4];
#pragma unroll
    for (int d0 = 0; d0 < 8; ++d0) qn[d0] = *(const bf16x8*)(Qw + d0 * 16);
#pragma unroll
    for (int d0 = 0; d0 < 4; ++d0) qp[d0] = *(const bf16x8*)(Qw + QKN + d0 * 16);
    float m_reg = -1e30f, l_reg = 0.f; f32x16 o[4];
#pragma unroll
    for (int d = 0; d < 4; ++d) o[d] = f32x16{};
    const int vb0 = (int)(lds0 + L_V) + v_rd_base(lane);
    f32x16 pA0, pA1, pB0, pB1; float alA, alB; bf16x8 pa0, pa1, pa2, pa3;
    int sa = 0, sb = 1, sc = 2;
#define ROT() do { const int _t = sa; sa = sb; sb = sc; sc = _t; } while (0)
#define RESC(a) do { if (__any((a) < 1.f)) { if (hi == 0) wsf[r32] = (a); asm volatile("s_waitcnt lgkmcnt(0)" ::: "memory"); \
        _Pragma("unroll") for (int d = 0; d < 4; ++d) _Pragma("unroll") for (int r = 0; r < 16; ++r) o[d][r] *= wsf[crow(r, hi)]; } } while (0)
    ATT_WAIT_BAR(0);
    { DMA_K((2 < NT ? 2 : NT - 1), sc); DMA_V(1, sb);
      qkt(pA0, pA1, lds + L_KN + sa * KN_SLOT, lds + L_KR + sa * KR_SLOT, qn, qp, r32, hi); partialSM(pA0, pA1, m_reg, alA);
      ATT_WAIT_BAR(5); ROT(); }
#define STEP(j, C0, C1, alC, P0, P1, alP) do { const int _kt = ((j) + 2 < NT) ? (j) + 2 : NT - 1, _vt = ((j) + 1 < NT) ? (j) + 1 : NT - 1; \
        DMA_K(_kt, sc); DMA_V(_vt, sb); __builtin_amdgcn_sched_barrier(0); \
        qkt_p<false>(C0, C1, lds + L_KN + sa * KN_SLOT, lds + L_KR + sa * KR_SLOT, qn, qp, r32, hi); \
        finishSM(P0, P1, alP, l_reg, pa0, pa1, pa2, pa3); __builtin_amdgcn_sched_barrier(0); \
        pv_p<false>(o, vb0 + sc * V_SLOT, pa0, pa1, pa2, pa3); \
        partialSM(C0, C1, m_reg, alC); RESC(alC); \
        ATT_WAIT_BAR(5); ROT(); } while (0)
#pragma unroll 1
    for (int j = 1; j + 1 < NT; j += 2) { STEP(j, pB0, pB1, alB, pA0, pA1, alA); STEP(j + 1, pA0, pA1, alA, pB0, pB1, alB); }
    STEP(NT - 1, pB0, pB1, alB, pA0, pA1, alA);
    finishSM(pB0, pB1, alB, l_reg, pa0, pa1, pa2, pa3); __builtin_amdgcn_sched_barrier(0);
    pv_d0(o, vb0 + sc * V_SLOT, pa0, pa1, pa2, pa3);
    if (hi == 0) wsf[32 + r32] = l_reg;
    ATT_WAIT_BAR(0);
    { LAS bf16_t* stg = (LAS bf16_t*)(lds + wid * 8192);
#pragma unroll
      for (int r = 0; r < 16; ++r) { const int orow = crow(r, hi); const float rl = __builtin_amdgcn_rcpf(wsf[32 + orow]);
#pragma unroll
          for (int d0 = 0; d0 < 4; ++d0) stg[orow * 128 + d0 * 32 + r32] = (bf16_t)(cvt_pk_bf16(o[d0][r] * rl, 0.f) & 0xffffu); }
      asm volatile("s_waitcnt lgkmcnt(0)" ::: "memory");
      bf16_t* Ow = O + (size_t)(q0 + wid * 32) * DM + h * VD;
#pragma unroll
      for (int i = 0; i < 8; ++i) { const int row = i * 4 + (lane >> 4), ch = lane & 15; const u32x4 v = *(const LAS u32x4*)(stg + row * 128 + ch * 8); *(u32x4*)(Ow + (size_t)row * DM + ch * 8) = v; } }
    ATT_WAIT_BAR(0);
#undef DMA_K
#undef DMA_V
#undef ROT
#undef RESC
#undef STEP
}


#define SB0() __builtin_amdgcn_sched_barrier(0)
#define PIN(x) asm volatile("" : "+v"(x))
#define PKQ(P, BASE, OUT) do { unsigned a0 = cvt_pk_bf16(P[BASE + 0], P[BASE + 1]), a1 = cvt_pk_bf16(P[BASE + 2], P[BASE + 3]);   \
    unsigned b0 = cvt_pk_bf16(P[BASE + 4], P[BASE + 5]), b1 = cvt_pk_bf16(P[BASE + 6], P[BASE + 7]);                              \
    auto r0 = __builtin_amdgcn_permlane32_swap(a0, b0, false, false); auto r1 = __builtin_amdgcn_permlane32_swap(a1, b1, false, false); \
    u32x4 w = {r0[0], r1[0], r0[1], r1[1]}; OUT = *reinterpret_cast<bf16x8*>(&w); } while (0)
__device__ __forceinline__ void regionA(f32x16& c0, f32x16& c1, LAS unsigned char* kn, LAS unsigned char* kr, const bf16x8* qn, const bf16x8* qp, int r32, int hi,
                                        f32x16& P0, f32x16& P1, float alP, float& l_reg, bf16x8& pa0, bf16x8& pa1, bf16x8& pa2, bf16x8& pa3,
                                        const char* gk, const char* gkr, unsigned ko0, unsigned ko1, unsigned kro, unsigned dk, unsigned dr) {
    const int swn = r32 & 15, swr = (r32 >> 1) & 7;
    LAS unsigned char* knr = kn + r32 * 256; LAS unsigned char* krr = kr + r32 * 128;
    bf16x8 ka0, ka1, kb0, kb1; float ps = 0.f, ps1 = 0.f, ps2 = 0.f, ps3 = 0.f;
    c0 = f32x16{}; c1 = f32x16{};
#define KRD(D, X0, X1) do { if ((D) < 8) { const int cb = ((2 * (D) + hi) ^ swn) * 16; X0 = *(const LAS bf16x8*)(knr + cb); X1 = *(const LAS bf16x8*)(knr + 8192 + cb); } \
                            else if ((D) < 12) { const int cb = ((2 * ((D) - 8) + hi) ^ swr) * 16; X0 = *(const LAS bf16x8*)(krr + cb); X1 = *(const LAS bf16x8*)(krr + 4096 + cb); } } while (0)
#define QOP(D) ((D) < 8 ? qn[(D) & 7] : qp[((D) - 8) & 3])
#define GAPA(D, X0, X1, WORK) do { \
        c0 = __builtin_amdgcn_mfma_f32_32x32x16_bf16(X0, QOP(D), c0, 0, 0, 0); c1 = __builtin_amdgcn_mfma_f32_32x32x16_bf16(X1, QOP(D), c1, 0, 0, 0); KRD((D) + 2, X0, X1); WORK; SB0(); } while (0)
    KRD(0, ka0, ka1); KRD(1, kb0, kb1); SB0();
    GAPA(0, ka0, ka1, { PKQ(P0, 0, pa0); PIN(pa0); });
    GAPA(1, kb0, kb1, { glds16s(gk, ko0, dk); PKQ(P0, 8, pa1); PIN(pa1); });
    GAPA(2, ka0, ka1, { _Pragma("unroll") for (int r = 0; r < 8; ++r) { ps += P0[r]; ps1 += P0[8 + r]; } PIN(ps); PIN(ps1); });
    GAPA(3, kb0, kb1, { _Pragma("unroll") for (int r = 0; r < 4; ++r) P1[r] = __builtin_amdgcn_exp2f(P1[r]); PIN(P1); });
    GAPA(4, ka0, ka1, { glds16s(gk, ko1, dk + 1024); _Pragma("unroll") for (int r = 4; r < 8; ++r) P1[r] = __builtin_amdgcn_exp2f(P1[r]); PIN(P1); });
    GAPA(5, kb0, kb1, { _Pragma("unroll") for (int r = 8; r < 12; ++r) P1[r] = __builtin_amdgcn_exp2f(P1[r]); PIN(P1); });
    GAPA(6, ka0, ka1, { _Pragma("unroll") for (int r = 12; r < 16; ++r) P1[r] = __builtin_amdgcn_exp2f(P1[r]); PIN(P1); });
    GAPA(7, kb0, kb1, { PKQ(P1, 0, pa2); PIN(pa2); });
    GAPA(8, ka0, ka1, { glds16s(gkr, kro, dr); PKQ(P1, 8, pa3); PIN(pa3); });
    GAPA(9, kb0, kb1, { _Pragma("unroll") for (int r = 0; r < 8; ++r) { ps2 += P1[r]; ps3 += P1[8 + r]; } PIN(ps2); PIN(ps3); });
    GAPA(10, ka0, ka1, { ps = (ps + ps1) + (ps2 + ps3); auto rr = __builtin_amdgcn_permlane32_swap(__float_as_uint(ps), __float_as_uint(ps), false, false); ps = __uint_as_float(rr[0]) + __uint_as_float(rr[1]); l_reg = l_reg * alP + ps; PIN(l_reg); });
    GAPA(11, kb0, kb1, { });
#undef KRD
#undef QOP
#undef GAPA
}
__device__ __forceinline__ void regionB(f32x16* o, int vb, bf16x8 pa0, bf16x8 pa1, bf16x8 pa2, bf16x8 pa3, f32x16& C0, f32x16& C1, float& m_reg, float& alC, const char* gv, unsigned vo0, unsigned vo1, unsigned dv) {
    s16x4 va[8]; float mn = 0.f;
#define VRD8(D0, X) do { X[0] = tr_rd<v_rd_off(D0, 0, 0)>(vb); X[1] = tr_rd<v_rd_off(D0, 0, 1)>(vb); X[2] = tr_rd<v_rd_off(D0, 1, 0)>(vb); X[3] = tr_rd<v_rd_off(D0, 1, 1)>(vb); \
                         X[4] = tr_rd<v_rd_off(D0, 2, 0)>(vb); X[5] = tr_rd<v_rd_off(D0, 2, 1)>(vb); X[6] = tr_rd<v_rd_off(D0, 3, 0)>(vb); X[7] = tr_rd<v_rd_off(D0, 3, 1)>(vb); } while (0)
#define PKV(L, H) (bf16x8){L[0], L[1], L[2], L[3], H[0], H[1], H[2], H[3]}
#define PV4(OD, X) do { OD = __builtin_amdgcn_mfma_f32_32x32x16_bf16(pa0, PKV(X[0], X[1]), OD, 0, 0, 0); OD = __builtin_amdgcn_mfma_f32_32x32x16_bf16(pa1, PKV(X[2], X[3]), OD, 0, 0, 0); \
                         OD = __builtin_amdgcn_mfma_f32_32x32x16_bf16(pa2, PKV(X[4], X[5]), OD, 0, 0, 0); OD = __builtin_amdgcn_mfma_f32_32x32x16_bf16(pa3, PKV(X[6], X[7]), OD, 0, 0, 0); } while (0)
    VRD8(0, va); SB0();
    PV4(o[0], va); VRD8(1, va);
    { float a = fmaxf(fmaxf(C0[0], C0[1]), C1[0]), b = fmaxf(fmaxf(C0[2], C0[3]), C1[1]); a = fmaxf(fmaxf(a, C1[2]), C1[3]);
      _Pragma("unroll") for (int r = 4; r < 16; r += 4) { a = fmaxf(fmaxf(a, C0[r]), C0[r + 1]); b = fmaxf(fmaxf(b, C0[r + 2]), C0[r + 3]); a = fmaxf(fmaxf(a, C1[r]), C1[r + 1]); b = fmaxf(fmaxf(b, C1[r + 2]), C1[r + 3]); }
      float pmax = fmaxf(a, b); { auto rr = __builtin_amdgcn_permlane32_swap(__float_as_uint(pmax), __float_as_uint(pmax), false, false); pmax = fmaxf(__uint_as_float(rr[0]), __uint_as_float(rr[1])); }
      const bool keep = __all(pmax - m_reg <= THR); mn = keep ? m_reg : fmaxf(m_reg, pmax); alC = keep ? 1.f : __builtin_amdgcn_exp2f(m_reg - mn); m_reg = mn; PIN(mn); PIN(alC); }
    SB0();
    PV4(o[1], va); VRD8(2, va);
    { glds16s(gv, vo0, dv); _Pragma("unroll") for (int r = 0; r < 16; ++r) { C0[r] -= mn; C1[r] -= mn; } PIN(C0); PIN(C1); }
    SB0();
    PV4(o[2], va); VRD8(3, va);
    { _Pragma("unroll") for (int r = 0; r < 8; ++r) C0[r] = __builtin_amdgcn_exp2f(C0[r]); PIN(C0); }
    SB0();
    PV4(o[3], va);
    { glds16s(gv, vo1, dv + 1024); _Pragma("unroll") for (int r = 8; r < 16; ++r) C0[r] = __builtin_amdgcn_exp2f(C0[r]); PIN(C0); }
    SB0();
#undef VRD8
#undef PKV
#undef PV4
}
__device__ __forceinline__ void unit_il(const bf16_t* __restrict__ Q, const bf16_t* __restrict__ KN, const bf16_t* __restrict__ KR, const bf16_t* __restrict__ V, bf16_t* __restrict__ O,
                                          int h, int q0, int k0, int nkeys, LAS unsigned char* lds) {
    const int tid = otid(), wid = __builtin_amdgcn_readfirstlane(tid >> 6), lane = tid & 63, r32 = lane & 31, hi = lane >> 5;
    const unsigned lds0 = (unsigned)(uintptr_t)lds;
    LAS float* wsf = (LAS float*)(lds + L_WS) + wid * 64;
    unsigned kn_off[2], v_off[2], kr_off;
#pragma unroll
    for (int i = 0; i < 2; ++i) { const int row = 8 * wid + 4 * i + (lane >> 4), lc = (lane & 15) ^ (row & 15); kn_off[i] = (unsigned)(row * DM * 2 + h * QKN * 2 + lc * 16);
        const int s = 2 * (2 * wid + i) + (lane >> 5), kk = 8 * (s >> 2) + ((lane & 31) >> 2), k = (kk & ~0xC) | ((kk & 4) << 1) | ((kk & 8) >> 1), c = 32 * (s & 3) + 8 * (lane & 3);
        v_off[i] = (unsigned)(k * DM * 2 + h * VD * 2 + c * 2); }
    { const int row = 8 * wid + (lane >> 3), lc = (lane & 7) ^ ((row >> 1) & 7); kr_off = (unsigned)(row * QKR * 2 + lc * 16); }
    const char* KNg = (const char*)(KN + (size_t)k0 * DM); const char* KRg = (const char*)(KR + (size_t)k0 * QKR); const char* Vg = (const char*)(V + (size_t)k0 * DM);
    const unsigned dK = lds0 + L_KN + 2 * wid * 1024, dR = lds0 + L_KR + wid * 1024, dV = lds0 + L_V + 2 * wid * 1024;
#define DMA_K(t, sl) do { const char* _g = KNg + (size_t)(t) * (64 * DM * 2); const unsigned _d = (unsigned)__builtin_amdgcn_readfirstlane(dK + (sl) * KN_SLOT); \
        glds16s(_g, kn_off[0], _d); glds16s(_g, kn_off[1], _d + 1024); glds16s(KRg + (size_t)(t) * (64 * QKR * 2), kr_off, (unsigned)__builtin_amdgcn_readfirstlane(dR + (sl) * KR_SLOT)); } while (0)
#define DMA_V(t, sl) do { const char* _g = Vg + (size_t)(t) * (64 * DM * 2); const unsigned _d = (unsigned)__builtin_amdgcn_readfirstlane(dV + (sl) * V_SLOT); \
        glds16s(_g, v_off[0], _d); glds16s(_g, v_off[1], _d + 1024); } while (0)
    const int NT = nkeys / 64;
    DMA_K(0, 0); DMA_V(0, 0); DMA_K(1, 1);
    const bf16_t* Qw = Q + (size_t)(q0 + wid * 32 + r32) * NQ + h * QHD + hi * 8;
    bf16x8 qn[8], qp[4];
#pragma unroll
    for (int d0 = 0; d0 < 8; ++d0) qn[d0] = *(const bf16x8*)(Qw + d0 * 16);
#pragma unroll
    for (int d0 = 0; d0 < 4; ++d0) qp[d0] = *(const bf16x8*)(Qw + QKN + d0 * 16);
    float m_reg = -1e30f, l_reg = 0.f; f32x16 o[4];
#pragma unroll
    for (int d = 0; d < 4; ++d) o[d] = f32x16{};
    const int vb0 = (int)(lds0 + L_V) + v_rd_base(lane);
    f32x16 pA0, pA1, pB0, pB1; float alA, alB; bf16x8 pa0, pa1, pa2, pa3;
    int sa = 0, sb = 1, sc = 2;
#define ROT() do { const int _t = sa; sa = sb; sb = sc; sc = _t; } while (0)
#define RESC(a) do { if (__any((a) < 1.f)) { if (hi == 0) wsf[r32] = (a); asm volatile("s_waitcnt lgkmcnt(0)" ::: "memory"); \
        _Pragma("unroll") for (int d = 0; d < 4; ++d) _Pragma("unroll") for (int r = 0; r < 16; ++r) o[d][r] *= wsf[crow(r, hi)]; } } while (0)
    ATT_WAIT_BAR(0);
    { DMA_K((2 < NT ? 2 : NT - 1), sc); DMA_V(1, sb);
      qkt(pA0, pA1, lds + L_KN + sa * KN_SLOT, lds + L_KR + sa * KR_SLOT, qn, qp, r32, hi); partialSM(pA0, pA1, m_reg, alA);
      ATT_WAIT_BAR(5); ROT(); }
#define STEP(j, C0, C1, alC, P0, P1, alP) do { const int _kt = ((j) + 2 < NT) ? (j) + 2 : NT - 1, _vt = ((j) + 1 < NT) ? (j) + 1 : NT - 1; \
        const char* _gk = KNg + (size_t)_kt * (64 * DM * 2); const char* _gv = Vg + (size_t)_vt * (64 * DM * 2); \
        const unsigned _dk = (unsigned)__builtin_amdgcn_readfirstlane(dK + sc * KN_SLOT), _dr = (unsigned)__builtin_amdgcn_readfirstlane(dR + sc * KR_SLOT), _dv = (unsigned)__builtin_amdgcn_readfirstlane(dV + sb * V_SLOT); SB0(); \
        regionA(C0, C1, lds + L_KN + sa * KN_SLOT, lds + L_KR + sa * KR_SLOT, qn, qp, r32, hi, P0, P1, alP, l_reg, pa0, pa1, pa2, pa3, _gk, KRg + (size_t)_kt * (64 * QKR * 2), kn_off[0], kn_off[1], kr_off, _dk, _dr); \
        regionB(o, vb0 + sc * V_SLOT, pa0, pa1, pa2, pa3, C0, C1, m_reg, alC, _gv, v_off[0], v_off[1], _dv); RESC(alC); \
        ATT_WAIT_BAR(5); ROT(); } while (0)
#pragma unroll 1
    for (int j = 1; j + 1 < NT; j += 2) { STEP(j, pB0, pB1, alB, pA0, pA1, alA); STEP(j + 1, pA0, pA1, alA, pB0, pB1, alB); }
    STEP(NT - 1, pB0, pB1, alB, pA0, pA1, alA);
    finishSM(pB0, pB1, alB, l_reg, pa0, pa1, pa2, pa3); __builtin_amdgcn_sched_barrier(0);
    pv_d0(o, vb0 + sc * V_SLOT, pa0, pa1, pa2, pa3);
    if (hi == 0) wsf[32 + r32] = l_reg;
    ATT_WAIT_BAR(0);
    { LAS bf16_t* stg = (LAS bf16_t*)(lds + wid * 8192);
#pragma unroll
      for (int r = 0; r < 16; ++r) { const int orow = crow(r, hi); const float rl = __builtin_amdgcn_rcpf(wsf[32 + orow]);
#pragma unroll
          for (int d0 = 0; d0 < 4; ++d0) stg[orow * 128 + d0 * 32 + r32] = (bf16_t)(cvt_pk_bf16(o[d0][r] * rl, 0.f) & 0xffffu); }
      asm volatile("s_waitcnt lgkmcnt(0)" ::: "memory");
      bf16_t* Ow = O + (size_t)(q0 + wid * 32) * DM + h * VD;
#pragma unroll
      for (int i = 0; i < 8; ++i) { const int row = i * 4 + (lane >> 4), ch = lane & 15; const u32x4 v = *(const LAS u32x4*)(stg + row * 128 + ch * 8); *(u32x4*)(Ow + (size_t)row * DM + ch * 8) = v; } }
    ATT_WAIT_BAR(0);
#undef DMA_K
#undef DMA_V
#undef ROT
#undef RESC
#undef STEP
}

}

constexpr size_t MiB = 1u << 20;
constexpr size_t al(size_t x) { return (x + 255) / 256 * 256; }
constexpr size_t WS_CTL = 0, CTL_BYTES = 1 * MiB;
constexpr size_t WS_MOD = WS_CTL + CTL_BYTES, MOD_BYTES = (size_t)DEPTH * 2 * 6 * DM * 4;
constexpr size_t ZERO_BYTES = al(WS_MOD + MOD_BYTES);
constexpr size_t WS_TAB = ZERO_BYTES;
constexpr size_t WS_SSQ = al(WS_TAB + 128 * 16 * 2 * 4), WS_SSKV = al(WS_SSQ + (size_t)R * 8 * 4);
constexpr size_t WS_WIN = al(WS_SSKV + (size_t)R * 8 * 4);
constexpr size_t WS_WINB = WS_WIN + (size_t)2 * EVEN_IN * DM * 2;
constexpr size_t WS_POOLT = WS_WINB + (size_t)2 * DM * 1024 * 2;
constexpr size_t WS_WOUT = WS_POOLT + (size_t)2 * 4 * 256 * 256 * 2;
constexpr size_t WS_WDQKV = WS_WOUT + (size_t)2 * DM * DM * 2;
constexpr size_t WS_WUQ = WS_WDQKV + (size_t)2 * NDQKV * DM * 2;
constexpr size_t WS_WUKV = WS_WUQ + (size_t)2 * NQ * QLORA * 2;
constexpr size_t WS_WO = WS_WUKV + (size_t)2 * NKV * KVLORA * 2;
constexpr size_t WS_WGU = WS_WO + (size_t)2 * DM * DM * 2;
constexpr size_t WS_WDN = WS_WGU + (size_t)4 * 2 * FF * DM * 2;
constexpr size_t WS_X = al(WS_WDN + (size_t)4 * DM * FF * 2);
constexpr size_t WS_H = WS_X + (size_t)R * DM * 4;
constexpr size_t WS_Z = WS_H + (size_t)R * DM * 2;
constexpr size_t WS_CAT = WS_Z + (size_t)R * EVEN_IN * 2;
constexpr size_t WS_ACT = WS_CAT + (size_t)R * DM * 2;
constexpr size_t WS_Q = WS_ACT + (size_t)R * FF * 2;
constexpr size_t WS_KN = WS_Q + (size_t)R * NQ * 2;
constexpr size_t WS_V = WS_KN + (size_t)R * DM * 2;
constexpr size_t WS_KR = WS_V + (size_t)R * DM * 2;
constexpr size_t WS_QA = al(WS_KR + (size_t)R * QKR * 2);
constexpr size_t WS_CKV = WS_QA + (size_t)R * QLORA * 2;
constexpr size_t WS_SLAB = al(WS_CKV + (size_t)R * KVLORA * 2);
constexpr size_t WS_END = WS_SLAB + (size_t)11 * 256 * DM * 4;

constexpr int RING_BYTES = 131072, MISC_OFF = RING_BYTES + 320, LDS_BYTES = 147456;
constexpr int NWAVES = 8;

#define XB_TMO      128
#define XB_XCNT(j)  (256  + 64 * (j))
#define XB_XSUB(j)  (1280 + 64 * (j))
#define XB_XGEN(j)  (2304 + 64 * (j))
#define XB_TOP      3328
#define XB_TOPGEN   3392
#define XCD_BAR_WORDS 3456
#define XB_SPIN_CAP (1u << 18)
__device__ __forceinline__ unsigned xb_ld(unsigned* p)              { return __hip_atomic_load(p, __ATOMIC_RELAXED, __HIP_MEMORY_SCOPE_AGENT); }
__device__ __forceinline__ unsigned xb_add(unsigned* p, unsigned v) { return __hip_atomic_fetch_add(p, v, __ATOMIC_RELAXED, __HIP_MEMORY_SCOPE_AGENT); }
__device__ __forceinline__ unsigned xb_xcc_id() { return (unsigned)__builtin_amdgcn_s_getreg((3 << 11) | 20) & 0xFu; }
#define XB_SPIN(cond, bar) do { unsigned _sp = 0; while (cond) { __builtin_amdgcn_s_sleep(1); \
    if ((++_sp & 255u) == 0u) { if (xb_ld(&(bar)[XB_TMO])) break; if (_sp > XB_SPIN_CAP) { atomicAdd(&(bar)[XB_TMO], 1u); break; } } } } while (0)
struct XcdBarrier { unsigned* bar; unsigned x; volatile LAS unsigned* st; };
__device__ __forceinline__ XcdBarrier xcd_barrier_post(unsigned* bar, volatile LAS unsigned* st) {
    XcdBarrier b; b.bar = bar; b.x = xb_xcc_id(); b.st = st;
    if (threadIdx.x == 0) (void)xb_add(&bar[XB_XCNT(b.x)], 1u);
    return b;
}
__device__ __forceinline__ void xcd_barrier_complete(unsigned* bar, unsigned x, unsigned& nloc, unsigned& nx) {
    const unsigned G = gridDim.x * gridDim.y * gridDim.z;
    unsigned sum, cnt, mine, sp = 0u;
    for (;;) {
        sum = 0u; cnt = 0u; mine = 0u;
#pragma unroll
        for (unsigned j = 0; j < 16; ++j) { const unsigned c = xb_ld(&bar[XB_XCNT(j)]); sum += c; cnt += (c > 0u) ? 1u : 0u; mine = (j == x) ? c : mine; }
        if (sum == G) break;
        __builtin_amdgcn_s_sleep(1);
        if ((++sp & 255u) == 0u) { if (xb_ld(&bar[XB_TMO])) break; if (sp > XB_SPIN_CAP) { atomicAdd(&bar[XB_TMO], 1u); break; } }
    }
    nloc = mine > 0u ? mine : 1u; nx = cnt > 0u ? cnt : 1u;
}
__device__ __attribute__((noinline)) void xcd_barrier_ni(unsigned* bar_, unsigned x_, volatile LAS unsigned* st_) {
    XcdBarrier b; b.bar = bar_; b.x = x_; b.st = st_;
    asm volatile("s_waitcnt vmcnt(0)" ::: "memory");
    __syncthreads();
    if (threadIdx.x == 0) {
        unsigned* bar = b.bar;
        __builtin_amdgcn_s_waitcnt(0);
        unsigned nloc = b.st[0], nx = b.st[1];
        if (nloc == 0u) { xcd_barrier_complete(bar, b.x, nloc, nx); b.st[0] = nloc; b.st[1] = nx; }
        const unsigned old = xb_add(&bar[XB_XSUB(b.x)], 1u);
        const unsigned gen = old / nloc;
        if (old + 1u == (gen + 1u) * nloc) {
            __builtin_amdgcn_fence(__ATOMIC_RELEASE, "agent");
            asm volatile("s_waitcnt vmcnt(0)" ::: "memory");
            const unsigned og = xb_add(&bar[XB_TOP], 1u);
            const unsigned tg = og / nx;
            if (og + 1u == (tg + 1u) * nx) xb_add(&bar[XB_TOPGEN], 1u);
            else XB_SPIN(xb_ld(&bar[XB_TOPGEN]) == tg, bar);
            __builtin_amdgcn_fence(__ATOMIC_ACQUIRE, "agent");
            xb_add(&bar[XB_XGEN(b.x)], 1u);
            asm volatile("s_waitcnt vmcnt(0)" ::: "memory");
        } else {
            XB_SPIN(xb_ld(&bar[XB_XGEN(b.x)]) == gen, bar);
            __builtin_amdgcn_fence(__ATOMIC_ACQUIRE, "agent");
            asm volatile("s_waitcnt vmcnt(0)" ::: "memory");
        }
    }
    __syncthreads();
}

struct Args { const float* in[24]; float* out; unsigned char* ws; int ph_lo, ph_hi; };

__device__ __forceinline__ void transpose_item(const float* W, int ldw, int k0, int n0, bf16_t* WT, int ldt, int drow, bool perm, const float* kscale, LAS float* scr, int lane) {
    float tv[32];
    const float* wp = W + (size_t)(k0 + (lane >> 5)) * ldw + n0 + (lane & 31);
#pragma unroll
    for (int i = 0; i < 32; ++i) tv[i] = __builtin_nontemporal_load(wp + (size_t)(2 * i) * ldw);
    if (kscale) {
#pragma unroll
        for (int i = 0; i < 32; ++i) tv[i] *= kscale[k0 + 2 * i + (lane >> 5)]; }
#pragma unroll
    for (int i = 0; i < 32; ++i) scr[(2 * i + (lane >> 5)) * 33 + (lane & 31)] = tv[i];
    asm volatile("s_waitcnt lgkmcnt(0)" ::: "memory");
    const int c = lane & 7;
#pragma unroll
    for (int j = 0; j < 4; ++j) { const int nn = (lane >> 3) + 8 * j; const LAS float* s = scr + (8 * c) * 33 + nn;
        u32x4 o; o.x = cvt_pk_bf16(s[0 * 33], s[1 * 33]); o.y = cvt_pk_bf16(s[2 * 33], s[3 * 33]); o.z = cvt_pk_bf16(s[4 * 33], s[5 * 33]); o.w = cvt_pk_bf16(s[6 * 33], s[7 * 33]);
        const int dn = perm ? (2 * (nn & 15) + (nn >> 4)) : nn;
        *(u32x4*)(WT + (size_t)(drow + dn) * ldt + k0 + 8 * c) = o; }
    asm volatile("s_waitcnt lgkmcnt(0)" ::: "memory");
}
struct TJob { const float* W; int ldw, K, col0, ncols; bf16_t* WT; int ldt, kind, drow0; const float* kscale; };
__device__ __forceinline__ long tjob_items(const TJob& j) { return (long)(j.K / 64) * (j.ncols / 32); }
__device__ __forceinline__ void tjob_run(const TJob& j, long item, LAS float* scr, int lane) {
    const int nblk = j.ncols / 32, kb = (int)(item / nblk), nb = (int)(item % nblk), n0 = j.col0 + 32 * nb, rel = 32 * nb;
    int drow; bool perm = false;
    if (j.kind == 1) drow = 256 * (rel / 128) + (rel % 128);
    else if (j.kind == 2) drow = 256 * (rel / 128) + 128 + (rel % 128);
    else { drow = j.drow0 + rel; if (j.kind == 3) perm = (rel % QHD) >= QKN; if (j.kind == 4) perm = true; }
    transpose_item(j.W, j.ldw, 64 * kb, n0, j.WT, j.ldt, drow, perm, j.kscale, scr, lane);
}
constexpr int NTJOBS = 2 * (2 + 4) + 2 * 6 + 4 * 3;
__device__ __forceinline__ TJob get_tjob(unsigned char* ws, int id) {
    TJob j{}; j.kscale = nullptr; j.kind = 0; j.drow0 = 0; j.col0 = 0;
    if (id < 12) { const int l = id / 6, s = id % 6;
        if (s == 0) { j.W = INP(8) + (size_t)l * DM * EVEN_IN; j.ldw = EVEN_IN; j.K = DM; j.col0 = 1024; j.ncols = 3072; j.WT = (bf16_t*)(ws + WS_WIN) + (size_t)l * EVEN_IN * DM; j.ldt = DM; j.drow0 = 1024; }
        else if (s == 1) { j.W = INP(12) + (size_t)l * DM * DM; j.ldw = DM; j.K = DM; j.ncols = DM; j.WT = (bf16_t*)(ws + WS_WOUT) + (size_t)l * DM * DM; j.ldt = DM; }
        else { const int g = s - 2; j.W = INP(9) + (size_t)(l * 4 + g) * 65536; j.ldw = 256; j.K = 256; j.ncols = 256; j.WT = (bf16_t*)(ws + WS_POOLT) + (size_t)(l * 4 + g) * 65536; j.ldt = 256; }
    } else if (id < 24) { const int l = (id - 12) / 6, s = (id - 12) % 6;
        bf16_t* wd = (bf16_t*)(ws + WS_WDQKV) + (size_t)l * NDQKV * DM;
        if (s == 0) { j.W = INP(13) + (size_t)l * DM * QLORA; j.ldw = QLORA; j.K = DM; j.ncols = QLORA; j.WT = wd; j.ldt = DM; }
        else if (s == 1) { j.W = INP(16) + (size_t)l * DM * 576; j.ldw = 576; j.K = DM; j.ncols = KVLORA; j.WT = wd; j.ldt = DM; j.drow0 = 512; }
        else if (s == 2) { j.W = INP(16) + (size_t)l * DM * 576; j.ldw = 576; j.K = DM; j.col0 = 512; j.ncols = 64; j.WT = wd; j.ldt = DM; j.drow0 = 1024; j.kind = 4; }
        else if (s == 3) { j.W = INP(15) + (size_t)l * QLORA * NQ; j.ldw = NQ; j.K = QLORA; j.ncols = NQ; j.WT = (bf16_t*)(ws + WS_WUQ) + (size_t)l * NQ * QLORA; j.ldt = QLORA; j.kind = 3; j.kscale = INP(14) + l * QLORA; }
        else if (s == 4) { j.W = INP(18) + (size_t)l * KVLORA * NKV; j.ldw = NKV; j.K = KVLORA; j.ncols = NKV; j.WT = (bf16_t*)(ws + WS_WUKV) + (size_t)l * NKV * KVLORA; j.ldt = KVLORA; j.kscale = INP(17) + l * KVLORA; }
        else { j.W = INP(19) + (size_t)l * DM * DM; j.ldw = DM; j.K = DM; j.ncols = DM; j.WT = (bf16_t*)(ws + WS_WO) + (size_t)l * DM * DM; j.ldt = DM; }
    } else { const int l = (id - 24) / 3, s = (id - 24) % 3;
        if (s == 0) { j.W = INP(20) + (size_t)l * DM * FF; j.ldw = FF; j.K = DM; j.ncols = FF; j.WT = (bf16_t*)(ws + WS_WGU) + (size_t)l * 2 * FF * DM; j.ldt = DM; j.kind = 1; }
        else if (s == 1) { j.W = INP(21) + (size_t)l * DM * FF; j.ldw = FF; j.K = DM; j.ncols = FF; j.WT = (bf16_t*)(ws + WS_WGU) + (size_t)l * 2 * FF * DM; j.ldt = DM; j.kind = 2; }
        else { j.W = INP(22) + (size_t)l * FF * DM; j.ldw = DM; j.K = FF; j.ncols = DM; j.WT = (bf16_t*)(ws + WS_WDN) + (size_t)l * DM * FF; j.ldt = FF; }
    }
    return j;
}

__device__ __forceinline__ void prologue(unsigned char* ws, LAS unsigned char* lds, int gw, int NGW, int wave, int lane, int njobs) {
    {
        float* MOD = (float*)(ws + WS_MOD);
        const float* c0 = INP(1); const float* c1 = INP(3);
        LAS float* red = (LAS float*)lds;
        const int bxp = gw / NWAVES, Gp = NGW / NWAVES, tidp = wave * 64 + lane;
        for (int task = bxp; task < 4 * 64; task += Gp) {
            const int l = task / 64, cg = task % 64, col = cg * 192 + 3 * lane;
            const float* Wp = INP(4) + ((size_t)l * DM + wave * 256) * (6 * DM) + col;
            float s0[3] = {0.f, 0.f, 0.f}, s1[3] = {0.f, 0.f, 0.f};
#pragma unroll 1
            for (int kb = 0; kb < 256; kb += 64) {
                const float x0 = c0[wave * 256 + kb + lane], x1 = c1[wave * 256 + kb + lane];
                const float sv0 = x0 / (1.f + __expf(-x0)), sv1 = x1 / (1.f + __expf(-x1));
#pragma unroll 8
                for (int k = 0; k < 64; ++k) { const float* wp = Wp + (size_t)(kb + k) * (6 * DM);
                    const float w0 = __builtin_nontemporal_load(wp), w1 = __builtin_nontemporal_load(wp + 1), w2 = __builtin_nontemporal_load(wp + 2);
                    const float a0 = __builtin_bit_cast(float, __builtin_amdgcn_readlane(__builtin_bit_cast(int, sv0), k)), a1 = __builtin_bit_cast(float, __builtin_amdgcn_readlane(__builtin_bit_cast(int, sv1), k));
                    s0[0] += w0 * a0; s0[1] += w1 * a0; s0[2] += w2 * a0; s1[0] += w0 * a1; s1[1] += w1 * a1; s1[2] += w2 * a1; }
            }
#pragma unroll
            for (int e = 0; e < 3; ++e) { red[(wave * 2 + 0) * 192 + 3 * lane + e] = s0[e]; red[(wave * 2 + 1) * 192 + 3 * lane + e] = s1[e]; }
            __syncthreads();
            if (tidp < 384) { const int s = tidp / 192, cc = tidp % 192; float acc = INP(5)[(size_t)l * 6 * DM + cg * 192 + cc];
#pragma unroll
              for (int w = 0; w < NWAVES; ++w) acc += red[(w * 2 + s) * 192 + cc];
              MOD[((size_t)l * 2 + s) * 6 * DM + cg * 192 + cc] = acc; }
            __syncthreads();
        }
    }
    {
        LAS float* scr = (LAS float*)(lds + wave * 16384);
        long base = 0;
        for (int id = 0; id < njobs; ++id) {
            const TJob j = get_tjob(ws, id); const long n = tjob_items(j);
            long first = ((long)gw - base % NGW + NGW) % NGW;
            for (long it = first; it < n; it += NGW) tjob_run(j, it, scr, lane);
            base += n;
        }
    }
    {
        bf16_t* WB = (bf16_t*)(ws + WS_WINB);
        const long n8 = (long)2 * DM * 1024 / 8;
        for (long i = (long)gw * 64 + lane; i < n8; i += (long)NGW * 64) { const long e = i * 8; const int l = (int)(e / ((long)DM * 1024)); const long rem = e % ((long)DM * 1024); const int k = (int)(rem / 1024), m = (int)(rem % 1024);
            const float* s = INP(8) + ((size_t)l * DM + k) * EVEN_IN + m; const f32x4 v0 = *(const f32x4*)s, v1 = *(const f32x4*)(s + 4);
            *(u32x4*)(WB + e) = pack8(v0, v1); }
    }
    {
        float* TAB = (float*)(ws + WS_TAB);
        for (int i = gw * 64 + lane; i < 128 * 16; i += NGW * 64) { const int pos = i >> 4, f = i & 15; const float inv = powf(10000.f, -(float)f / 16.f); const float ang = (float)pos * inv; TAB[2 * i] = cosf(ang); TAB[2 * i + 1] = sinf(ang); }
        const long nz = (long)2 * (NDQKV - 1088) * DM / 8;
        for (long i = (long)gw * 64 + lane; i < nz; i += (long)NGW * 64) { const long e = i * 8; const int l = (int)(e / ((long)(NDQKV - 1088) * DM)); const long rem = e % ((long)(NDQKV - 1088) * DM);
            *(u32x4*)((bf16_t*)(ws + WS_WDQKV) + (size_t)l * NDQKV * DM + (size_t)1088 * DM + rem) = (u32x4){0u, 0u, 0u, 0u}; }
    }
}

constexpr int DEF_PER_LAYER = 3 * 5632;
__device__ __forceinline__ void deferred_convert(unsigned char* ws, LAS unsigned char* lds, int L, int r_begin, int r_cap, int rank, int quota, int wave, int lane) {
    LAS float* scr = (LAS float*)(lds + wave * 16384);
    for (int k = wave; k < quota; k += NWAVES) {
        const int r = r_begin + rank * quota + k; if (r >= r_cap) break;
        const int s = r / 5632;
        const TJob j = get_tjob(ws, 24 + 3 * L + s); tjob_run(j, r - s * 5632, scr, lane);
    }
}

__device__ __forceinline__ void norm_mod_phase(const float* xl, const float* xc, const float* g, const float* modl, const float* modc, int which, bf16_t* H, int gw, int NGW, int lane, int nrows) {
#pragma unroll 1
    for (int pass = 0; pass < 2; ++pass) {
        const int rlo = pass ? SEQ : 0, rhi = pass ? nrows : (nrows < SEQ ? nrows : SEQ);
        if (rlo >= rhi) continue;
        const float* mod = pass ? modc : modl; const float* xb = pass ? xc : xl;
        const float* sh = mod + (which ? 3 : 0) * DM; const float* sc = sh + DM;
        f32x4 A[8], B[8];
#pragma unroll
        for (int j = 0; j < 8; ++j) { const int c = 256 * j + 4 * lane; A[j] = *(const f32x4*)(g + c); B[j] = *(const f32x4*)(sc + c); }
        __builtin_amdgcn_sched_barrier(0);
#pragma unroll
        for (int j = 0; j < 8; ++j) { const int c = 256 * j + 4 * lane; A[j] = A[j] * (B[j] + 1.f); B[j] = *(const f32x4*)(sh + c); }
        for (int row = rlo + gw; row < rhi; row += NGW) {
            const f32x4* xr = (const f32x4*)(xb + (size_t)row * DM) + lane; f32x4 v[8]; float ss = 0.f;
#pragma unroll
            for (int j = 0; j < 8; ++j) v[j] = __builtin_nontemporal_load(xr + 64 * j);
            asm volatile("" : "+v"(v[0]), "+v"(v[1]), "+v"(v[2]), "+v"(v[3]), "+v"(v[4]), "+v"(v[5]), "+v"(v[6]), "+v"(v[7]));
#pragma unroll
            for (int j = 0; j < 8; ++j) ss += (v[j][0] * v[j][0] + v[j][1] * v[j][1]) + (v[j][2] * v[j][2] + v[j][3] * v[j][3]);
            const float rstd = __builtin_amdgcn_rsqf(wave_sum(ss) * (1.f / DM) + EPS);
            u32x2* o = (u32x2*)(H + (size_t)row * DM) + lane;
#pragma unroll
            for (int j = 0; j < 8; ++j) { const f32x4 y = v[j] * rstd * A[j] + B[j]; u32x2 w; w.x = cvt_pk_bf16(y[0], y[1]); w.y = cvt_pk_bf16(y[2], y[3]); o[64 * j] = w; }
        }
    }
}
__device__ __forceinline__ void norm_mod_phase16(const bf16_t* X, const float* g, const float* mod, int which, bf16_t* H, int gw, int NGW, int lane) {
    const float* sh = mod + (which ? 3 : 0) * DM; const float* sc = sh + DM;
    f32x4 A[4][2], B[4][2];
#pragma unroll
    for (int j = 0; j < 4; ++j)
#pragma unroll
        for (int h = 0; h < 2; ++h) { const int c = 512 * j + 8 * lane + 4 * h; A[j][h] = *(const f32x4*)(g + c); B[j][h] = *(const f32x4*)(sc + c); }
    __builtin_amdgcn_sched_barrier(0);
#pragma unroll
    for (int j = 0; j < 4; ++j)
#pragma unroll
        for (int h = 0; h < 2; ++h) { const int c = 512 * j + 8 * lane + 4 * h; A[j][h] = A[j][h] * (B[j][h] + 1.f); B[j][h] = *(const f32x4*)(sh + c); }
    for (int row = gw; row < SEQ; row += 2 * NGW) {
        const int row2 = row + NGW; const bool has2 = row2 < SEQ; const int r2 = has2 ? row2 : row;
        const u32x4* xr = (const u32x4*)(X + (size_t)row * DM) + lane; const u32x4* xs = (const u32x4*)(X + (size_t)r2 * DM) + lane;
        u32x4 ra[4], rb[4];
#pragma unroll
        for (int j = 0; j < 4; ++j) ra[j] = xr[64 * j];
#pragma unroll
        for (int j = 0; j < 4; ++j) rb[j] = xs[64 * j];
        f32x4 v[4][2], w[4][2]; float ss = 0.f, st = 0.f;
#pragma unroll
        for (int j = 0; j < 4; ++j) { xunpack8(ra[j], v[j][0], v[j][1]);
#pragma unroll
            for (int h = 0; h < 2; ++h) ss += (v[j][h][0] * v[j][h][0] + v[j][h][1] * v[j][h][1]) + (v[j][h][2] * v[j][h][2] + v[j][h][3] * v[j][h][3]); }
#pragma unroll
        for (int j = 0; j < 4; ++j) { xunpack8(rb[j], w[j][0], w[j][1]);
#pragma unroll
            for (int h = 0; h < 2; ++h) st += (w[j][h][0] * w[j][h][0] + w[j][h][1] * w[j][h][1]) + (w[j][h][2] * w[j][h][2] + w[j][h][3] * w[j][h][3]); }
        const float rstd = __builtin_amdgcn_rsqf(wave_sum(ss) * (1.f / DM) + EPS), rstd2 = __builtin_amdgcn_rsqf(wave_sum(st) * (1.f / DM) + EPS);
        u32x4* o = (u32x4*)(H + (size_t)row * DM) + lane;
#pragma unroll
        for (int j = 0; j < 4; ++j) o[64 * j] = pack8(v[j][0] * rstd * A[j][0] + B[j][0], v[j][1] * rstd * A[j][1] + B[j][1]);
        if (has2) { u32x4* o2 = (u32x4*)(H + (size_t)row2 * DM) + lane;
#pragma unroll
            for (int j = 0; j < 4; ++j) o2[64 * j] = pack8(w[j][0] * rstd2 * A[j][0] + B[j][0], w[j][1] * rstd2 * A[j][1] + B[j][1]); }
    }
}
__device__ __forceinline__ void final_norm_phase(const bf16_t* X, const float* g, float* out, int gw, int NGW, int lane) {
    f32x4 G[4][2];
#pragma unroll
    for (int j = 0; j < 4; ++j)
#pragma unroll
        for (int h = 0; h < 2; ++h) G[j][h] = *(const f32x4*)(g + 512 * j + 8 * lane + 4 * h);
    for (int row = gw; row < SEQ; row += NGW) {
        const u32x4* xr = (const u32x4*)(X + (size_t)row * DM) + lane; f32x4 v[4][2]; float ss = 0.f;
#pragma unroll
        for (int j = 0; j < 4; ++j) { xunpack8(xr[64 * j], v[j][0], v[j][1]);
#pragma unroll
            for (int h = 0; h < 2; ++h) ss += (v[j][h][0] * v[j][h][0] + v[j][h][1] * v[j][h][1]) + (v[j][h][2] * v[j][h][2] + v[j][h][3] * v[j][h][3]); }
        const float rstd = __builtin_amdgcn_rsqf(wave_sum(ss) * (1.f / DM) + EPS);
        float* o = out + (size_t)row * DM + 8 * lane;
#pragma unroll
        for (int j = 0; j < 4; ++j) { *(f32x4*)(o + 512 * j) = v[j][0] * rstd * G[j][0]; *(f32x4*)(o + 512 * j + 4) = v[j][1] * rstd * G[j][1]; }
    }
}
template <int S>
__device__ __forceinline__ void ctx_norm_phase(const float* __restrict__ x32, const bf16_t* x16, bf16_t* Xc, const bf16_t* __restrict__ slab, const float* __restrict__ gate, const float* __restrict__ g, const float* __restrict__ modc, int which, bf16_t* __restrict__ Hc, LAS float* red, int bx, int G, int tid) {
    const int col = 4 * tid, lane = tid & 63, wave = tid >> 6;
    const float* sh = modc + (which ? 3 : 0) * DM; const float* sc = sh + DM;
    for (int r = bx; r < CTXL; r += G) {
        f32x4 v; u32x2 sw[S > 0 ? S : 1];
        if (x32) v = *(const f32x4*)(x32 + (size_t)r * DM + col);
        else { const u32x2 w = *(const u32x2*)(x16 + (size_t)r * DM + col); const f32x2 p = xun(w.x), q = xun(w.y); v = (f32x4){p[0], p[1], q[0], q[1]}; }
#pragma unroll
        for (int s = 0; s < S; ++s) sw[s] = *(const u32x2*)(slab + ((size_t)s * 256 + r) * DM + col);
        const f32x4 gv = *(const f32x4*)(g + col), scv = *(const f32x4*)(sc + col), shv = *(const f32x4*)(sh + col);
        if (S > 0) { const f32x4 gt = *(const f32x4*)(gate + col); f32x4 a = {0.f, 0.f, 0.f, 0.f};
#pragma unroll
            for (int s = 0; s < S; ++s) { const f32x2 p = xun(sw[s].x), q = xun(sw[s].y); a += (f32x4){p[0], p[1], q[0], q[1]}; }
            v += gt * a;
            u32x2 w; w.x = xpk(v[0], v[1]); w.y = xpk(v[2], v[3]); *(u32x2*)(Xc + (size_t)r * DM + col) = w;
            const f32x2 p = xun(w.x), q = xun(w.y); v = (f32x4){p[0], p[1], q[0], q[1]}; }
        float ss = wave_sum((v[0] * v[0] + v[1] * v[1]) + (v[2] * v[2] + v[3] * v[3]));
        if (lane == 0) red[wave] = ss;
        __syncthreads();
        float tot = 0.f;
#pragma unroll
        for (int w = 0; w < NWAVES; ++w) tot += red[w];
        __syncthreads();
        const float rstd = __builtin_amdgcn_rsqf(tot * (1.f / DM) + EPS);
        const f32x4 A = gv * (scv + 1.f), y = v * rstd * A + shv;
        u32x2 w; w.x = cvt_pk_bf16(y[0], y[1]); w.y = cvt_pk_bf16(y[2], y[3]); *(u32x2*)(Hc + (size_t)r * DM + col) = w;
    }
}
__device__ __forceinline__ void ld8f(const bf16_t* p, float (&f)[8]) { const u32x4 w = *(const u32x4*)p; f[0] = bf_lo(w.x); f[1] = bf_hi(w.x); f[2] = bf_lo(w.y); f[3] = bf_hi(w.y); f[4] = bf_lo(w.z); f[5] = bf_hi(w.z); f[6] = bf_lo(w.w); f[7] = bf_hi(w.w); }
__device__ __forceinline__ void ld8s(const bf16_t* ZS, int q, int c, float (&f)[8]) {
    f32x4 a = {0.f, 0.f, 0.f, 0.f}, b = a;
#pragma unroll
    for (int s = 0; s < 4; ++s) { f32x4 x, y; xunpack8(*(const u32x4*)(ZS + ((size_t)s * 256 + q) * EVEN_IN + c), x, y); a += x; b += y; }
    f[0] = a[0]; f[1] = a[1]; f[2] = a[2]; f[3] = a[3]; f[4] = b[0]; f[5] = b[1]; f[6] = b[2]; f[7] = b[3];
}
__device__ __forceinline__ void ld4s_raw(const bf16_t* __restrict__ ZS, int q, int c, u32x4 (&r)[4]) {
#pragma unroll
    for (int s = 0; s < 4; ++s) r[s] = *(const u32x4*)(ZS + ((size_t)s * 256 + q) * EVEN_IN + c);
}
__device__ __forceinline__ void sum4s(const u32x4 (&r)[4], float (&f)[8]) {
    f32x4 a = {0.f, 0.f, 0.f, 0.f}, b = a;
#pragma unroll
    for (int s = 0; s < 4; ++s) { f32x4 x, y; xunpack8(r[s], x, y); a += x; b += y; }
    f[0] = a[0]; f[1] = a[1]; f[2] = a[2]; f[3] = a[3]; f[4] = b[0]; f[5] = b[1]; f[6] = b[2]; f[7] = b[3];
}
__device__ __forceinline__ void acc8m(float (&s)[8], const u32x4 w, float m) {
    s[0] += m * bf_lo(w.x); s[1] += m * bf_hi(w.x); s[2] += m * bf_lo(w.y); s[3] += m * bf_hi(w.y); s[4] += m * bf_lo(w.z); s[5] += m * bf_hi(w.z); s[6] += m * bf_lo(w.w); s[7] += m * bf_hi(w.w);
}
__device__ __forceinline__ void up8(const u32x4 w, float (&f)[8]) { f[0] = bf_lo(w.x); f[1] = bf_hi(w.x); f[2] = bf_lo(w.y); f[3] = bf_hi(w.y); f[4] = bf_lo(w.z); f[5] = bf_hi(w.z); f[6] = bf_lo(w.w); f[7] = bf_hi(w.w); }
__device__ __forceinline__ void mixer_ctx_token(const bf16_t* __restrict__ ZS, const float* __restrict__ convw, bf16_t* __restrict__ CAT, int tl, int ch) {
    constexpr int n = CTXL; const int t = SEQ + tl;
    float o[8], f[8];
    if (ch < 128) {
        const int c = 8 * ch, hw = 1 << (c >> 8); const int lo = (tl - hw) < 0 ? 0 : (tl - hw), hi = (tl + hw) > n ? n : (tl + hw);
        float s[8] = {0.f, 0.f, 0.f, 0.f, 0.f, 0.f, 0.f, 0.f};
#pragma unroll 1
        for (int qb = tl - hw; qb < tl + hw; qb += 4) {
            u32x4 rw[4][4];
#pragma unroll
            for (int j = 0; j < 4; ++j) { const int q = qb + j, qc = q < 0 ? 0 : (q > n - 1 ? n - 1 : q); ld4s_raw(ZS, qc, c, rw[j]); }
#pragma unroll
            for (int j = 0; j < 4; ++j) { const int q = qb + j; const float m = (q >= 0 && q < n && q < tl + hw) ? 1.f : 0.f; float fa[8]; sum4s(rw[j], fa);
#pragma unroll
                for (int e = 0; e < 8; ++e) s[e] += m * fa[e]; }
        }
        { u32x4 rw[4]; ld4s_raw(ZS, tl, c, rw); sum4s(rw, f); }
        const float ic = 1.f / (float)(hi - lo);
#pragma unroll
        for (int e = 0; e < 8; ++e) o[e] = s[e] * ic - f[e];
        *(u32x4*)(CAT + (size_t)t * DM + c) = pack8((f32x4){o[0], o[1], o[2], o[3]}, (f32x4){o[4], o[5], o[6], o[7]});
    } else {
        const int c = 8 * (ch - 128); float cv[8] = {0.f, 0.f, 0.f, 0.f, 0.f, 0.f, 0.f, 0.f};
        u32x4 rg[3][4], rv[3][4], rf[4];
#pragma unroll
        for (int k = 0; k < 3; ++k) { const int q = tl + k - 1, qc = q < 0 ? 0 : (q > n - 1 ? n - 1 : q); ld4s_raw(ZS, qc, 2048 + c, rg[k]); ld4s_raw(ZS, qc, 3072 + c, rv[k]); }
        ld4s_raw(ZS, tl, 1024 + c, rf);
#pragma unroll
        for (int k = 0; k < 3; ++k) { const int q = tl + k - 1; const float m = (q >= 0 && q < n) ? 1.f : 0.f; float g[8], v[8]; sum4s(rg[k], g); sum4s(rv[k], v);
            const f32x4 w0 = *(const f32x4*)(convw + k * 1024 + c), w1 = *(const f32x4*)(convw + k * 1024 + c + 4);
#pragma unroll
            for (int e = 0; e < 4; ++e) { cv[e] += m * g[e] * v[e] * w0[e]; cv[4 + e] += m * g[4 + e] * v[4 + e] * w1[e]; } }
        sum4s(rf, f);
#pragma unroll
        for (int e = 0; e < 8; ++e) o[e] = f[e] * cv[e];
        *(u32x4*)(CAT + (size_t)t * DM + 1024 + c) = pack8((f32x4){o[0], o[1], o[2], o[3]}, (f32x4){o[4], o[5], o[6], o[7]});
    }
}
__device__ __forceinline__ void mixer_run16(const bf16_t* __restrict__ Z, const float* __restrict__ convw, bf16_t* __restrict__ CAT, int t0, int ch) {
    if (ch < 128) {
        const int c = 8 * ch, hw = 1 << (c >> 8);
        const bf16_t* Zc = Z + c;
        float s[8] = {0.f, 0.f, 0.f, 0.f, 0.f, 0.f, 0.f, 0.f};
#pragma unroll 1
        for (int qb = t0 - hw; qb < t0 + hw; qb += 4) {
            u32x4 w[4];
#pragma unroll
            for (int j = 0; j < 4; ++j) { const int q = qb + j, qc = q < 0 ? 0 : (q > SEQ - 1 ? SEQ - 1 : q); w[j] = *(const u32x4*)(Zc + (size_t)qc * EVEN_IN); }
#pragma unroll
            for (int j = 0; j < 4; ++j) { const int q = qb + j; acc8m(s, w[j], (q >= 0 && q < SEQ && q < t0 + hw) ? 1.f : 0.f); }
        }
#pragma unroll 1
        for (int i0 = 0; i0 < 16; i0 += 4) {
            u32x4 wc[4], wp[4], wm[4];
#pragma unroll
            for (int i = 0; i < 4; ++i) { const int t = t0 + i0 + i, tp = (t + hw) > SEQ - 1 ? SEQ - 1 : (t + hw), tm = (t - hw) < 0 ? 0 : (t - hw);
                wc[i] = *(const u32x4*)(Zc + (size_t)t * EVEN_IN); wp[i] = *(const u32x4*)(Zc + (size_t)tp * EVEN_IN); wm[i] = *(const u32x4*)(Zc + (size_t)tm * EVEN_IN); }
#pragma unroll
            for (int i = 0; i < 4; ++i) { const int t = t0 + i0 + i; const int lo = (t - hw) < 0 ? 0 : (t - hw), hi = (t + hw) > SEQ ? SEQ : (t + hw);
                const float ic = 1.f / (float)(hi - lo); float f[8], o[8]; up8(wc[i], f);
#pragma unroll
                for (int e = 0; e < 8; ++e) o[e] = s[e] * ic - f[e];
                *(u32x4*)(CAT + (size_t)t * DM + c) = pack8((f32x4){o[0], o[1], o[2], o[3]}, (f32x4){o[4], o[5], o[6], o[7]});
                acc8m(s, wp[i], (t + hw < SEQ) ? 1.f : 0.f); acc8m(s, wm[i], (t - hw >= 0) ? -1.f : 0.f); }
        }
    } else {
        const int c = 8 * (ch - 128); const bf16_t* Zb = Z + 1024 + c; const bf16_t* Zg = Z + 2048 + c; const bf16_t* Zv = Z + 3072 + c;
        float up[8], uc[8], w0[8], w1[8], w2[8];
#pragma unroll
        for (int e = 0; e < 8; ++e) { w0[e] = convw[c + e]; w1[e] = convw[1024 + c + e]; w2[e] = convw[2048 + c + e]; }
        { const int tq = t0 > 0 ? t0 - 1 : 0; const float m = t0 > 0 ? 1.f : 0.f;
          const u32x4 a = *(const u32x4*)(Zg + (size_t)tq * EVEN_IN), b = *(const u32x4*)(Zv + (size_t)tq * EVEN_IN), a2 = *(const u32x4*)(Zg + (size_t)t0 * EVEN_IN), b2 = *(const u32x4*)(Zv + (size_t)t0 * EVEN_IN);
          float x[8], y[8]; up8(a, x); up8(b, y);
#pragma unroll
          for (int e = 0; e < 8; ++e) up[e] = m * x[e] * y[e];
          up8(a2, x); up8(b2, y);
#pragma unroll
          for (int e = 0; e < 8; ++e) uc[e] = x[e] * y[e]; }
#pragma unroll 1
        for (int i0 = 0; i0 < 16; i0 += 4) {
            u32x4 g[4], v[4], fb[4];
#pragma unroll
            for (int i = 0; i < 4; ++i) { const int t = t0 + i0 + i, tn = (t + 1) > SEQ - 1 ? SEQ - 1 : (t + 1);
                g[i] = *(const u32x4*)(Zg + (size_t)tn * EVEN_IN); v[i] = *(const u32x4*)(Zv + (size_t)tn * EVEN_IN); fb[i] = *(const u32x4*)(Zb + (size_t)t * EVEN_IN); }
#pragma unroll
            for (int i = 0; i < 4; ++i) { const int t = t0 + i0 + i; const float m = (t + 1 < SEQ) ? 1.f : 0.f; float x[8], y[8], f[8], o[8]; up8(g[i], x); up8(v[i], y); up8(fb[i], f);
#pragma unroll
                for (int e = 0; e < 8; ++e) { const float un = m * x[e] * y[e]; o[e] = f[e] * (up[e] * w0[e] + uc[e] * w1[e] + un * w2[e]); up[e] = uc[e]; uc[e] = un; }
                *(u32x4*)(CAT + (size_t)t * DM + 1024 + c) = pack8((f32x4){o[0], o[1], o[2], o[3]}, (f32x4){o[4], o[5], o[6], o[7]}); }
        }
    }
}
__device__ __forceinline__ void mixer_phase(const bf16_t* Z, const bf16_t* ZS, const float* convw, bf16_t* CAT, int wg, int nwg, int tid) {
    const int ch = tid & 255, tsub = tid >> 8;
    for (int blk = wg; blk < SEQ / 32; blk += nwg) {
        mixer_run16(Z, convw, CAT, blk * 32 + 16 * tsub, ch);
        if (tsub == 0) mixer_ctx_token(ZS, convw, CAT, blk, ch);
    }
}

template <class Epi, class Sched>
__device__ __forceinline__ void run_gemm(LAS unsigned char* lds, const pg8::Gemm g, const Sched& S, const Epi& E) {
#if MK_SIMPLE_GEMM
    pg8::gemm_simple<Epi, Sched>(g, S, E);
#else
    pg8::gemm_phase<Epi, Sched, true, true>(lds, g, S, E);
#endif
}
constexpr int N_PHASES = 1 + 8 * DEPTH + 1;

__global__ void __launch_bounds__(NWAVES * 64, 2) mk_fwd(Args args) {
    extern __shared__ __attribute__((aligned(16))) unsigned char lds_raw[];
    LAS unsigned char* lds = (LAS unsigned char*)lds_raw;
    volatile LAS unsigned* MISC = (volatile LAS unsigned*)(lds + MISC_OFF);
    const int G = gridDim.x, NGW = G * NWAVES;
    for (int u = threadIdx.x; u < (LDS_BYTES - RING_BYTES) / 4; u += NWAVES * 64) ((LAS unsigned*)(lds + RING_BYTES))[u] = 0u;
    __syncthreads();
#if MK_ONE_LAUNCH
    XcdBarrier bar = xcd_barrier_post((unsigned*)(KARG(unsigned char*, 200) + WS_CTL) + 4096, MISC + 8);
#define GRID_BAR() xcd_barrier_ni(bar.bar, bar.x, bar.st)
#else
#define GRID_BAR() do {} while (0)
#endif
#if MK_ONE_LAUNCH
    constexpr int lo = 0, hi = N_PHASES;
#else
    const int lo = KARG(int, 208), hi = KARG(int, 212);
#endif
#define IN(k) (lo <= (k) && (k) < hi)
#ifndef PH_MASK
#define PH_MASK 0xffffffffu
#endif
#define PH_ON(b) ((PH_MASK >> (b)) & 1u)
#define SEAM(k) do { if ((k) + 1 < hi) GRID_BAR(); } while (0)
#define WSP() unsigned char* ws = KARG(unsigned char*, 200); const int tid = otid(), lane = tid & 63, wave = __builtin_amdgcn_readfirstlane(tid >> 6), bx = obid(), gw = bx * NWAVES + wave; (void)lane; (void)gw
#define MODL(l) ((const float*)(ws + WS_MOD) + (size_t)((l) * 2 + 0) * 6 * DM)
#define MODC(l) ((const float*)(ws + WS_MOD) + (size_t)((l) * 2 + 1) * 6 * DM)

    if (PH_ON(0) && IN(0)) { WSP(); prologue(ws, lds, gw, NGW, wave, lane, (G == 256) ? 26 : NTJOBS); SEAM(0); }

#pragma unroll 1
    for (int l = 0; l < DEPTH; ++l) {
        const int pb = 1 + 8 * l, i2 = l >> 1; const bool lastl = (l == DEPTH - 1);
        if (IN(pb + 0)) {
            WSP();
            const int nf = ((l & 1) == 0 && PH_ON(2) && G > 64) ? 32 : 0;
            if (PH_ON(1) && bx >= nf) { bf16_t* X = (bf16_t*)(ws + WS_X); const int gwn = gw - nf * NWAVES, NGWn = NGW - nf * NWAVES, bxn = bx - nf, Gn = G - nf;
              if (l == 0) norm_mod_phase(INP(0), INP(0), INP(6) + l * DM, MODL(l), MODC(l), 0, (bf16_t*)(ws + WS_H), gwn, NGWn, lane, SEQ);
              else norm_mod_phase16(X, INP(6) + l * DM, MODL(l), 0, (bf16_t*)(ws + WS_H), gwn, NGWn, lane);
              if (l == 0) ctx_norm_phase<0>(INP(2), X + (size_t)SEQ * DM, X + (size_t)SEQ * DM, (const bf16_t*)(ws + WS_SLAB), nullptr, INP(6) + l * DM, MODC(l), 0, (bf16_t*)(ws + WS_H) + (size_t)SEQ * DM, (LAS float*)(lds + MISC_OFF + 64), bxn, Gn, tid);
              else ctx_norm_phase<11>(nullptr, X + (size_t)SEQ * DM, X + (size_t)SEQ * DM, (const bf16_t*)(ws + WS_SLAB), MODC(l - 1) + 5 * DM, INP(6) + l * DM, MODC(l), 0, (bf16_t*)(ws + WS_H) + (size_t)SEQ * DM, (LAS float*)(lds + MISC_OFF + 64), bxn, Gn, tid); }
            if (PH_ON(2) && (l & 1) == 0) {
                pg8::Gemm g{(const bf16_t*)(ws + WS_POOLT) + (size_t)i2 * 4 * 65536, (const bf16_t*)(ws + WS_WINB) + (size_t)i2 * DM * 1024, 256, 1024, 4};
                pg8::FoldOrder S{bx}; EpiBf16 E{(bf16_t*)(ws + WS_WIN) + (size_t)i2 * EVEN_IN * DM, DM, INP(10) + i2 * 1024};
                pg8::gemm_simple<EpiBf16, pg8::FoldOrder>(g, S, E);
            }
            SEAM(pb + 0);
        }
        if ((l & 1) == 0) {
            if (PH_ON(3) && IN(pb + 1)) { WSP(); pg8::Gemm g{(const bf16_t*)(ws + WS_H), (const bf16_t*)(ws + WS_WIN) + (size_t)i2 * EVEN_IN * DM, DM, DM, DM / 64};
                pg8::LatCtxOrder S; S.so.init(SEQ / 256, EVEN_IN / 256, G, bx, DM / 64); S.ntn = EVEN_IN / 256; S.nsl = 4 * (EVEN_IN / 256); S.kchunk = DM / 4;
                EpiWithSlab<EpiBf16> E{{(bf16_t*)(ws + WS_Z), EVEN_IN, nullptr}, (bf16_t*)(ws + WS_SLAB), EVEN_IN};
                run_gemm(lds, g, S, E);
                if (G == 256 && bx >= 64) { if (l == 0) deferred_convert(ws, lds, 0, 11264, 14336, bx - 64, 16, wave, lane); else deferred_convert(ws, lds, 2, 10752, 13824, bx - 64, 16, wave, lane); }
                SEAM(pb + 1); }
            if (PH_ON(4) && IN(pb + 2)) { WSP(); mixer_phase((const bf16_t*)(ws + WS_Z), (const bf16_t*)(ws + WS_SLAB), INP(11) + (size_t)i2 * 3 * 1024, (bf16_t*)(ws + WS_CAT), bx, G, tid); SEAM(pb + 2); }
            if (PH_ON(5) && IN(pb + 3)) { WSP(); bf16_t* X = (bf16_t*)(ws + WS_X); const float* xl = (l == 0) ? INP(0) : nullptr;
                pg8::Gemm g{(const bf16_t*)(ws + WS_CAT), (const bf16_t*)(ws + WS_WOUT) + (size_t)i2 * DM * DM, DM, DM, DM / 64};
                pg8::LatCtxOrder S; S.so.init(SEQ / 256, DM / 256, G, bx, DM / 64); S.ntn = DM / 256; S.nsl = 8 * (DM / 256); S.kchunk = DM / 8;
                EpiWithSlab<EpiResid> E{{xl, X, X, MODL(l) + 2 * DM}, (bf16_t*)(ws + WS_SLAB), DM}; run_gemm(lds, g, S, E);
                if (G == 256 && bx >= 64) { if (l == 0) deferred_convert(ws, lds, 0, 14336, 16896, bx - 64, 14, wave, lane); else deferred_convert(ws, lds, 2, 13824, 16896, bx - 64, 16, wave, lane); }
                SEAM(pb + 3); }
        } else {
            if (PH_ON(6) && IN(pb + 1)) { WSP(); pg8::Gemm g{(const bf16_t*)(ws + WS_H), (const bf16_t*)(ws + WS_WDQKV) + (size_t)i2 * NDQKV * DM, DM, DM, DM / 64}; pg8::StaticOrder S; S.init(NPANEL, NDQKV / 256, G, bx, DM / 64);
                EpiDQKV E{(bf16_t*)(ws + WS_QA), (bf16_t*)(ws + WS_CKV), (bf16_t*)(ws + WS_KR), (float*)(ws + WS_SSQ), (float*)(ws + WS_SSKV), (const float*)(ws + WS_TAB)}; run_gemm(lds, g, S, E);
                if (G == 256 && bx >= 165) deferred_convert(ws, lds, l, 10752, 16896, bx - 165, 68, wave, lane);
                SEAM(pb + 1); }
            if (IN(pb + 2)) {
                if (PH_ON(7)) { WSP(); pg8::Gemm g{(const bf16_t*)(ws + WS_QA), (const bf16_t*)(ws + WS_WUQ) + (size_t)i2 * NQ * QLORA, QLORA, QLORA, QLORA / 64}; pg8::StaticOrder S; S.init(lastl ? SEQ / 256 : NPANEL, NQ / 256, G, bx, QLORA / 64);
                  EpiUQ E{(bf16_t*)(ws + WS_Q), (const float*)(ws + WS_SSQ), (const float*)(ws + WS_TAB)}; run_gemm(lds, g, S, E); }
                if (PH_ON(8)) { WSP(); pg8::Gemm g{(const bf16_t*)(ws + WS_CKV), (const bf16_t*)(ws + WS_WUKV) + (size_t)i2 * NKV * KVLORA, KVLORA, KVLORA, KVLORA / 64}; pg8::StaticOrder S; S.init(NPANEL, NKV / 256, G, G - 1 - bx, KVLORA / 64);
                  EpiUKV E{(bf16_t*)(ws + WS_KN), (bf16_t*)(ws + WS_V), (const float*)(ws + WS_SSKV)}; run_gemm(lds, g, S, E); }
                SEAM(pb + 2); }
            if (PH_ON(9) && IN(pb + 3)) {
                WSP(); LAS float* wsf = (LAS float*)(lds) + wave * 64; (void)wsf;
                const bf16_t* Qb = (const bf16_t*)(ws + WS_Q); const bf16_t* KN = (const bf16_t*)(ws + WS_KN); const bf16_t* KR = (const bf16_t*)(ws + WS_KR); const bf16_t* Vb = (const bf16_t*)(ws + WS_V); bf16_t* CAT = (bf16_t*)(ws + WS_CAT);
                const int nunits = 2 * 256 + (lastl ? 0 : NHEAD);
#pragma unroll 1
                for (int uid = bx; uid < nunits; uid += G) {
#if MK_SIMPLE_ATTN
                    if (uid < 512) att::unit_simple(Qb, KN, KR, Vb, CAT, (uid & 7) + 8 * (uid >> 8), ((uid >> 3) & 31) * 256, 0, R, wsf);
                    else att::unit_simple(Qb, KN, KR, Vb, CAT, uid - 512, SEQ, SEQ, CTXL, wsf);
#else
                    if (uid < 512) att::unit_il(Qb, KN, KR, Vb, CAT, (uid & 7) + 8 * (uid >> 8), ((uid >> 3) & 31) * 256, 0, R, lds);
                    else att::unit_il(Qb, KN, KR, Vb, CAT, uid - 512, SEQ, SEQ, CTXL, lds);
#endif
                }
                SEAM(pb + 3); }
            if (PH_ON(10) && IN(pb + 4)) { WSP(); bf16_t* X = (bf16_t*)(ws + WS_X); pg8::Gemm g{(const bf16_t*)(ws + WS_CAT), (const bf16_t*)(ws + WS_WO) + (size_t)i2 * DM * DM, DM, DM, DM / 64};
                pg8::LatCtxOrder S; S.so.init(SEQ / 256, DM / 256, G, bx, DM / 64); S.ntn = DM / 256; S.nsl = lastl ? 0 : 8 * (DM / 256); S.kchunk = DM / 8;
                EpiWithSlab<EpiResid> E{{nullptr, X, X, MODL(l) + 2 * DM}, (bf16_t*)(ws + WS_SLAB), DM}; run_gemm(lds, g, S, E); SEAM(pb + 4); }
        }
        const int fb = pb + ((l & 1) ? 5 : 4);
        if (PH_ON(11) && IN(fb)) { WSP(); bf16_t* X = (bf16_t*)(ws + WS_X); norm_mod_phase16(X, INP(7) + l * DM, MODL(l), 1, (bf16_t*)(ws + WS_H), gw, NGW, lane);
            if (!lastl) ctx_norm_phase<8>((l == 0) ? INP(2) : nullptr, X + (size_t)SEQ * DM, X + (size_t)SEQ * DM, (const bf16_t*)(ws + WS_SLAB), MODC(l) + 2 * DM, INP(7) + l * DM, MODC(l), 1,
                                          (bf16_t*)(ws + WS_H) + (size_t)SEQ * DM, (LAS float*)(lds + MISC_OFF + 64), bx, G, tid);
            SEAM(fb); }
        if (PH_ON(12) && IN(fb + 1)) { WSP(); pg8::Gemm g{(const bf16_t*)(ws + WS_H), (const bf16_t*)(ws + WS_WGU) + (size_t)l * 2 * FF * DM, DM, DM, DM / 64}; pg8::StaticOrder S; S.init(lastl ? SEQ / 256 : NPANEL, 2 * FF / 256, G, bx, DM / 64); EpiSwiGLU E{(bf16_t*)(ws + WS_ACT)};
            run_gemm(lds, g, S, E);
            if (G == 256 && !lastl && bx >= 172) deferred_convert(ws, lds, l + 1, 0, 6720, bx - 172, 80, wave, lane);
            SEAM(fb + 1); }
        if (PH_ON(13) && IN(fb + 2)) { WSP(); bf16_t* X = (bf16_t*)(ws + WS_X); pg8::Gemm g{(const bf16_t*)(ws + WS_ACT), (const bf16_t*)(ws + WS_WDN) + (size_t)l * DM * FF, FF, FF, FF / 64};
            pg8::LatCtxOrder S; S.so.init(SEQ / 256, DM / 256, G, bx, FF / 64); S.ntn = DM / 256; S.nsl = lastl ? 0 : 11 * (DM / 256); S.kchunk = FF / 11;
            EpiWithSlab<EpiResid> E{{nullptr, X, X, MODL(l) + 5 * DM}, (bf16_t*)(ws + WS_SLAB), DM}; run_gemm(lds, g, S, E);
            if (G == 256 && !lastl && bx >= 88) deferred_convert(ws, lds, l + 1, 6720, 10752, bx - 88, 24, wave, lane);
            SEAM(fb + 2); }
    }
    if (PH_ON(14) && IN(N_PHASES - 1)) { WSP(); final_norm_phase((const bf16_t*)(ws + WS_X), INP(23), KARG(float*, 192), gw, NGW, lane); }
#undef IN
#undef SEAM
}

extern "C" void kernel_launch(void* const* d_in, const int* in_sizes, int n_in, void* d_out, int out_size, void* d_ws, size_t ws_size, hipStream_t stream) {
    static int grid = 0;
    if (grid == 0) {
        if (n_in != 24 || in_sizes[0] != SEQ * DM || out_size != SEQ * DM || ws_size < WS_END) { fprintf(stderr, "kernel_launch: unexpected shapes (n_in %d, in0 %d, out %d, ws %zu < %zu)\n", n_in, n_in > 0 ? in_sizes[0] : -1, out_size, ws_size, (size_t)WS_END); grid = -1; return; }
        int dev = 0, cus = 0, per_cu = 0;
        if (hipGetDevice(&dev) != hipSuccess || hipDeviceGetAttribute(&cus, hipDeviceAttributeMultiprocessorCount, dev) != hipSuccess) { grid = -1; return; }
        if (hipFuncSetAttribute((const void*)mk_fwd, hipFuncAttributeMaxDynamicSharedMemorySize, LDS_BYTES) != hipSuccess) { fprintf(stderr, "kernel_launch: hipFuncSetAttribute failed\n"); grid = -1; return; }
        if (hipOccupancyMaxActiveBlocksPerMultiprocessor(&per_cu, (const void*)mk_fwd, NWAVES * 64, LDS_BYTES) != hipSuccess || per_cu < 1) fprintf(stderr, "kernel_launch: occupancy query says %d\n", per_cu);
        (void)hipGetLastError();
        grid = cus;
    }
    if (grid < 0) return;
    (void)hipMemsetAsync((char*)d_ws, 0, 32768, stream);
    Args a{};
    for (int i = 0; i < 24; ++i) a.in[i] = (const float*)d_in[i];
    a.out = (float*)d_out; a.ws = (unsigned char*)d_ws;
#if MK_ONE_LAUNCH
    a.ph_lo = 0; a.ph_hi = N_PHASES;
    hipLaunchKernelGGL(mk_fwd, dim3(grid), dim3(NWAVES * 64), LDS_BYTES, stream, a);
#else
    for (int k = 0; k < N_PHASES; ++k) {
        if (k >= 1 && k < N_PHASES - 1) { const int l = (k - 1) / 8, s = (k - 1) % 8; if ((l & 1) == 0 && s == 7) continue; }
        a.ph_lo = k; a.ph_hi = k + 1;
        hipLaunchKernelGGL(mk_fwd, dim3(grid), dim3(NWAVES * 64), LDS_BYTES, stream, a);
    }
#endif
    const hipError_t le = hipPeekAtLastError();
    if (le != hipSuccess) fprintf(stderr, "kernel_launch: launch failed: %s\n", hipGetErrorName(le));
}
```

```cpp
#include <hip/hip_runtime.h>
#include <cstdio>
#include <cstdint>

#ifndef MK_ONE_LAUNCH
#define MK_ONE_LAUNCH 1
#endif
#ifndef MK_SIMPLE_ATTN
#define MK_SIMPLE_ATTN 0
#endif
#ifndef MK_SIMPLE_GEMM
#define MK_SIMPLE_GEMM 0
#endif

#define LAS __attribute__((address_space(3)))
#define GAS __attribute__((address_space(1)))
typedef unsigned short bf16_t;
typedef short bf16x8 __attribute__((ext_vector_type(8)));
typedef float f32x4 __attribute__((ext_vector_type(4)));
typedef float f32x2 __attribute__((ext_vector_type(2)));
typedef float f32x16 __attribute__((ext_vector_type(16)));
typedef unsigned u32x4 __attribute__((ext_vector_type(4)));
typedef unsigned u32x2 __attribute__((ext_vector_type(2)));

constexpr int DM = 2048, SEQ = 8192, CTXL = 256, R = SEQ + CTXL, NPANEL = R / 256, DEPTH = 4;
constexpr int EVEN_IN = 4096, FF = 5632, QLORA = 512, KVLORA = 512, NHEAD = 16, QKN = 128, QKR = 64, VD = 128, QHD = QKN + QKR;
constexpr int NQ = NHEAD * QHD  , NKV = NHEAD * (QKN + VD)  , NDQKV = 1280  ;
constexpr float EPS = 1e-6f;
constexpr float QSCALE = 0.07216878364870322f * 1.4426950408889634f;

__device__ __forceinline__ unsigned cvt_pk_bf16(float lo, float hi) { unsigned r; asm volatile("v_cvt_pk_bf16_f32 %0, %1, %2" : "=v"(r) : "v"(lo), "v"(hi)); return r; }
__device__ __forceinline__ float bf_lo(unsigned w) { return __uint_as_float(w << 16); }
__device__ __forceinline__ float bf_hi(unsigned w) { return __uint_as_float(w & 0xffff0000u); }
template <int K> __device__ __forceinline__ float xor_add(float v) {
    if constexpr (K < 32) return v + __builtin_bit_cast(float, __builtin_amdgcn_ds_swizzle(__builtin_bit_cast(int, v), (K << 10) | 0x1F));
    else { auto rr = __builtin_amdgcn_permlane32_swap(__float_as_uint(v), __float_as_uint(v), false, false); return __uint_as_float(rr[0]) + __uint_as_float(rr[1]); }
}
__device__ __forceinline__ float wave_sum(float v) { v = xor_add<1>(v); v = xor_add<2>(v); v = xor_add<4>(v); v = xor_add<8>(v); v = xor_add<16>(v); return xor_add<32>(v); }

__device__ __forceinline__ int otid() { int t = threadIdx.x; asm volatile("" : "+v"(t)); return t; }
__device__ __forceinline__ int obid() { int b = blockIdx.x; asm volatile("" : "+s"(b)); return b; }
template <class T> __device__ __forceinline__ T karg_ld(int off) { const __attribute__((address_space(4))) char* k = (const __attribute__((address_space(4))) char*)__builtin_amdgcn_kernarg_segment_ptr(); asm volatile("" : "+s"(k)); return *(const __attribute__((address_space(4))) T*)(k + off); }
#define KARG(type, off) karg_ld<type>(off)
#define INP(k) KARG(const float*, 8 * (k))
namespace pg8 {
constexpr int BM = 256, BK = 64, HALF = 128, HTB = HALF * BK * 2, STAGE_BYTES = 8 * HTB, NXCD = 8, WGM = 8;
__host__ __device__ __forceinline__ int lds_byte(int r, int c) { const int st = (r >> 4) * 2 + (c >> 5), rr = r & 15, cc = c & 31, ob = rr * 64 + cc * 2; return st * 1024 + (ob ^ (((ob >> 9) & 1) << 5)); }
__host__ __device__ __forceinline__ void stage_rc(int b, int& Rr, int& C) { const int st = b / 1024, sb = b % 1024, swz = sb ^ (((sb >> 9) & 1) << 5); Rr = (st >> 1) * 16 + swz / 64; C = (st & 1) * 32 + (swz % 64) / 2; }
__host__ __device__ __forceinline__ int perm32(int rho) { const int n = rho >> 4, i = rho & 15; return 8 * (i >> 2) + 4 * n + (i & 3); }

struct Unit { int pm, pn, ka, kb, nt, aux; };
struct Gemm { const bf16_t* A; const bf16_t* Bt; int lda, ldb, nt; };

struct StaticOrder {
    int nM, nN, nwg, G, c, nt;
    __device__ void init(int nM_, int nN_, int G_, int c_, int nt_) { nM = nM_; nN = nN_; nwg = nM * nN; G = G_; c = c_; nt = nt_; }
    __device__ __forceinline__ bool next(int i, Unit& u) const {
        const long L = (long)i * G + c; if (L >= nwg) return false;
        int wgid = (int)L; { const int q = nwg / NXCD, r = nwg % NXCD, xcd = wgid % NXCD, off = wgid / NXCD; wgid = (xcd < r ? xcd * (q + 1) : r * (q + 1) + (xcd - r) * q) + off; }
        const int nig = WGM * nN, gid = wgid / nig, fm = gid * WGM, gsz = (nM - fm) < WGM ? (nM - fm) : WGM;
        u.pm = fm + ((wgid % nig) % gsz); u.pn = (wgid % nig) / gsz; u.ka = 0; u.kb = 0; u.nt = nt; u.aux = 0; return true;
    }
};
struct FoldOrder {
    int c;
    __device__ bool next(int i, Unit& u) const { if (i > 0 || c >= 32) return false; u.pm = c & 3; u.pn = c >> 2; u.ka = 0; u.kb = 256 * (c & 3); u.nt = 4; u.aux = 0; return true; }
};

struct LatCtxOrder {
    StaticOrder so; int ntn, nsl, kchunk;
    __device__ __forceinline__ bool next(int i, Unit& u) const {
        Unit a; a.pm = 0; a.pn = 0; a.ka = 0; a.kb = 0; a.nt = so.nt; a.aux = 0;
        const bool ok1 = so.next(i, a);
        const int nL = so.c < so.nwg ? (so.nwg - so.c + so.G - 1) / so.G : 0, s = so.c + (i - nL) * so.G;
        const bool ok2 = !ok1 && s >= 0 && s < nsl;
        const int sl = s / ntn, ko = sl * kchunk;
        u.pm = ok1 ? a.pm : 32; u.pn = ok1 ? a.pn : s - sl * ntn; u.aux = ok1 ? 0 : sl; u.ka = ok1 ? 0 : ko; u.kb = ok1 ? 0 : ko; u.nt = ok1 ? so.nt : kchunk / 64;
        return ok1 || ok2;
    }
};
__device__ __forceinline__ void pg8_glds(const char* sbase, unsigned voff, unsigned lds_dst) {
    asm volatile("s_mov_b32 m0, %2\n\ts_nop 0\n\tglobal_load_lds_dwordx4 %1, %0" :: "s"(sbase), "v"(voff), "s"(lds_dst) : "memory", "m0"); }
template <class Epi, class Sched>
__device__ __forceinline__ void gemm_simple(const Gemm g, const Sched& S, const Epi& E) {
    const int tid = otid(), wid = __builtin_amdgcn_readfirstlane(tid >> 6), lane = tid & 63, wr = wid >> 2, wc = wid & 3, fr = lane & 15, fq = lane >> 4;
    Unit u;
    for (int i = 0; S.next(i, u); ++i) {
        f32x4 acc[2][2][4][2];
#pragma unroll
        for (int a = 0; a < 2; ++a)
#pragma unroll
            for (int b = 0; b < 2; ++b)
#pragma unroll
                for (int m = 0; m < 4; ++m)
#pragma unroll
                    for (int n = 0; n < 2; ++n) acc[a][b][m][n] = (f32x4){0.f, 0.f, 0.f, 0.f};
        const bf16_t* A = g.A + (size_t)u.pm * 256 * g.lda + u.ka + (size_t)(64 * wr + fr) * g.lda + fq * 8;
        int rb[2];
#pragma unroll
        for (int n = 0; n < 2; ++n) { const int rho = 16 * n + fr; rb[n] = Epi::PERM ? perm32(rho) : rho; }
        const bf16_t* B = g.Bt + (size_t)u.pn * 256 * g.ldb + u.kb + (size_t)(32 * wc) * g.ldb + fq * 8;
        bf16x8 a[2][4], b[2][2], an[2][4], bn[2][2];
        const int kend = u.nt * 64;
#define GS_LOAD(DA, DB, KK) do { _Pragma("unroll") for (int ai = 0; ai < 2; ++ai) _Pragma("unroll") for (int m = 0; m < 4; ++m) DA[ai][m] = *(const bf16x8*)(A + (size_t)(128 * ai + 16 * m) * g.lda + (KK)); \
            _Pragma("unroll") for (int bj = 0; bj < 2; ++bj) _Pragma("unroll") for (int n = 0; n < 2; ++n) DB[bj][n] = *(const bf16x8*)(B + (size_t)(128 * bj + rb[n]) * g.ldb + (KK)); } while (0)
        GS_LOAD(a, b, 0);
#pragma unroll 1
        for (int kk = 0; kk < kend; kk += 32) {
            const int kn = (kk + 32 < kend) ? kk + 32 : kk;
            GS_LOAD(an, bn, kn);
#pragma unroll
            for (int ai = 0; ai < 2; ++ai)
#pragma unroll
                for (int bj = 0; bj < 2; ++bj)
#pragma unroll
                    for (int m = 0; m < 4; ++m)
#pragma unroll
                        for (int n = 0; n < 2; ++n) acc[ai][bj][m][n] = __builtin_amdgcn_mfma_f32_16x16x32_bf16(b[bj][n], a[ai][m], acc[ai][bj][m][n], 0, 0, 0);
#pragma unroll
            for (int ai = 0; ai < 2; ++ai)
#pragma unroll
                for (int m = 0; m < 4; ++m) a[ai][m] = an[ai][m];
#pragma unroll
            for (int bj = 0; bj < 2; ++bj)
#pragma unroll
                for (int n = 0; n < 2; ++n) b[bj][n] = bn[bj][n];
        }
#undef GS_LOAD
        E(acc, u, wr, wc, fr, fq);
    }
}

template <class Epi, class Sched, bool ALIGN_EPI = true, bool SP2 = true>
__device__ __forceinline__ void gemm_phase(LAS unsigned char* lds, const Gemm g, const Sched& S, const Epi& E) {
    const int tid = otid(), wid = __builtin_amdgcn_readfirstlane(tid >> 6), lane = tid & 63, wr = wid >> 2, wc = wid & 3, fr = lane & 15, fq = lane >> 4;
    unsigned voffA[2], voffB[2];
#pragma unroll
    for (int i = 0; i < 2; ++i) { int Rr, C; stage_rc(tid * 16 + i * 8192, Rr, C); const int Rb = Epi::PERM ? ((Rr & ~31) + perm32(Rr & 31)) : Rr;
        voffA[i] = (unsigned)(Rr * g.lda + C) * 2u; voffB[i] = (unsigned)(Rb * g.ldb + C) * 2u; }
    const size_t kstep = (size_t)(BK * 2);
    const size_t hstepA = (size_t)HALF * g.lda * 2, hstepB = (size_t)HALF * g.ldb * 2;
    const size_t tstepA = 2 * hstepA, tstepB = 2 * hstepB;
    const unsigned ldsw = (unsigned)wid * 1024u, lds0 = (unsigned)(uintptr_t)lds;
    const int aoff = lds_byte(wr * 64 + fr, fq * 8), boff = lds_byte(wc * 32 + fr, fq * 8);
    LAS unsigned char* ldsA = lds + aoff; LAS unsigned char* ldsB = lds + 4 * HTB + boff;
    asm volatile("" : "+v"(ldsA), "+v"(ldsB));
#define PG8_SA(b, h) (((b) * 2 + (h)) * HTB)
#define PG8_SB(b, h) ((4 + (b) * 2 + (h)) * HTB)
#define PG8_STAGE(bufoff, gbase, voff) do { _Pragma("unroll") for (int _i = 0; _i < 2; ++_i) \
        pg8_glds((const char*)(gbase), (voff)[_i], (unsigned)__builtin_amdgcn_readfirstlane((int)(lds0 + (unsigned)(bufoff) + ldsw + (unsigned)(_i * 8192)))); } while (0)
#define PG8_LDA(dst, b, h) do { _Pragma("unroll") for (int m = 0; m < 4; ++m) _Pragma("unroll") for (int k = 0; k < 2; ++k) dst[m][k] = *(const LAS bf16x8*)(ldsA + PG8_SA(b, h) + m * 2048 + k * 1024); } while (0)
#define PG8_LDB(dst, b, h) do { _Pragma("unroll") for (int n = 0; n < 2; ++n) _Pragma("unroll") for (int k = 0; k < 2; ++k) dst[n][k] = *(const LAS bf16x8*)(ldsB + ((b) * 2 + (h)) * HTB + n * 2048 + k * 1024); } while (0)
#define PG8_MMA(ai, bj, At, Bt) do { __builtin_amdgcn_s_setprio(1); _Pragma("unroll") for (int m = 0; m < 4; ++m) _Pragma("unroll") for (int n = 0; n < 2; ++n) _Pragma("unroll") for (int k = 0; k < 2; ++k) \
        acc[ai][bj][m][n] = __builtin_amdgcn_mfma_f32_16x16x32_bf16(Bt[n][k], At[m][k], acc[ai][bj][m][n], 0, 0, 0); __builtin_amdgcn_s_setprio(0); } while (0)
#define PG8_WAIT_V(n) asm volatile("s_waitcnt vmcnt(" #n ")" ::: "memory")
#define PG8_WAIT_L(n) asm volatile("s_waitcnt lgkmcnt(" #n ")" ::: "memory")
#define PG8_WAIT_L0() __builtin_amdgcn_s_waitcnt(0xC07F)
#define PG8_BAR __builtin_amdgcn_s_barrier()
#define PG8_SCHED __builtin_amdgcn_sched_barrier(0)
    Unit cur, nxt; int ui = 0;
    if (!S.next(0, cur)) return;
    f32x4 acc[2][2][4][2];
#pragma unroll
    for (int a = 0; a < 2; ++a)
#pragma unroll
        for (int b = 0; b < 2; ++b)
#pragma unroll
            for (int m = 0; m < 4; ++m)
#pragma unroll
                for (int n = 0; n < 2; ++n) acc[a][b][m][n] = (f32x4){0.f, 0.f, 0.f, 0.f};
    bf16x8 At[4][2], B0[2][2], B1[2][2];
    const char* cA = (const char*)g.A + (size_t)cur.pm * tstepA + (size_t)cur.ka * 2; const char* cB = (const char*)g.Bt + (size_t)cur.pn * tstepB + (size_t)cur.kb * 2;
    if constexpr (SP2) {
        PG8_STAGE(PG8_SB(0, 0), cB, voffB); PG8_STAGE(PG8_SB(0, 1), cB + hstepB, voffB); PG8_STAGE(PG8_SA(0, 0), cA, voffA); PG8_STAGE(PG8_SA(0, 1), cA + hstepA, voffA);
        if (wr == 1) PG8_BAR;
        PG8_WAIT_V(2); PG8_BAR;
        PG8_STAGE(PG8_SB(1, 0), cB + kstep, voffB); PG8_STAGE(PG8_SA(1, 0), cA + kstep, voffA); PG8_STAGE(PG8_SB(1, 1), cB + hstepB + kstep, voffB);
        PG8_WAIT_V(6); PG8_BAR;
    } else {
        PG8_STAGE(PG8_SB(0, 0), cB, voffB); PG8_STAGE(PG8_SA(0, 0), cA, voffA); PG8_STAGE(PG8_SB(0, 1), cB + hstepB, voffB); PG8_STAGE(PG8_SA(0, 1), cA + hstepA, voffA);
        if (wr == 1) PG8_BAR;
        PG8_WAIT_V(4); PG8_BAR;
        PG8_STAGE(PG8_SB(1, 0), cB + kstep, voffB); PG8_STAGE(PG8_SA(1, 0), cA + kstep, voffA); PG8_STAGE(PG8_SB(1, 1), cB + hstepB + kstep, voffB);
        PG8_WAIT_V(6); PG8_BAR;
    }
    for (;;) {
        const bool has_next = S.next(ui + 1, nxt);
        const char* nA = has_next ? (const char*)g.A + (size_t)nxt.pm * tstepA + (size_t)nxt.ka * 2 : cA; const char* nB = has_next ? (const char*)g.Bt + (size_t)nxt.pn * tstepB + (size_t)nxt.kb * 2 : cB;
        const int nt = cur.nt;
        for (int t = 0; t < nt; t += 2) {
            const bool last = (t == nt - 2);
            const char* a1 = cA + (size_t)(t + 1) * kstep;
            const char* a2 = last ? nA : cA + (size_t)(t + 2) * kstep; const char* b2 = last ? nB : cB + (size_t)(t + 2) * kstep;
            const char* a3 = a2 + kstep; const char* b3 = b2 + kstep;
            if constexpr (SP2) {
            PG8_LDB(B0, 0, 0); PG8_LDB(B1, 0, 1); PG8_SCHED; PG8_LDA(At, 0, 0); PG8_STAGE(PG8_SA(1, 1), a1 + hstepA, voffA);
            PG8_WAIT_V(8); PG8_WAIT_L0(); PG8_BAR; PG8_MMA(0, 0, At, B0); PG8_MMA(0, 1, At, B1); PG8_BAR; PG8_SCHED;
            PG8_LDA(At, 0, 1); PG8_STAGE(PG8_SB(0, 0), b2, voffB); PG8_STAGE(PG8_SB(0, 1), b2 + hstepB, voffB); PG8_STAGE(PG8_SA(0, 0), a2, voffA);
            PG8_WAIT_V(8); PG8_WAIT_L0(); PG8_BAR; PG8_MMA(1, 0, At, B0); PG8_MMA(1, 1, At, B1); PG8_BAR; PG8_SCHED;
            PG8_LDB(B0, 1, 0); PG8_LDB(B1, 1, 1); PG8_SCHED; PG8_LDA(At, 1, 0); PG8_STAGE(PG8_SA(0, 1), a2 + hstepA, voffA);
            PG8_WAIT_V(8); PG8_WAIT_L0(); PG8_BAR; PG8_MMA(0, 0, At, B0); PG8_MMA(0, 1, At, B1); PG8_BAR; PG8_SCHED;
            PG8_LDA(At, 1, 1); PG8_STAGE(PG8_SB(1, 0), b3, voffB); PG8_STAGE(PG8_SB(1, 1), b3 + hstepB, voffB); PG8_STAGE(PG8_SA(1, 0), a3, voffA);
            PG8_WAIT_V(8); PG8_WAIT_L0(); PG8_BAR; PG8_MMA(1, 0, At, B0); PG8_MMA(1, 1, At, B1); PG8_BAR; PG8_SCHED;
            } else {
            PG8_LDB(B0, 0, 0); PG8_SCHED; PG8_LDA(At, 0, 0); PG8_STAGE(PG8_SA(1, 1), a1 + hstepA, voffA);
            PG8_WAIT_L(8); PG8_BAR; PG8_WAIT_L(0); PG8_MMA(0, 0, At, B0); PG8_BAR; PG8_SCHED;
            PG8_LDB(B1, 0, 1); PG8_STAGE(PG8_SB(0, 0), b2, voffB);
            PG8_BAR; PG8_WAIT_L(0); PG8_MMA(0, 1, At, B1); PG8_BAR;
            PG8_LDA(At, 0, 1); PG8_STAGE(PG8_SA(0, 0), a2, voffA);
            PG8_BAR; PG8_WAIT_L(0); PG8_MMA(1, 0, At, B0); PG8_BAR; PG8_SCHED;
            PG8_STAGE(PG8_SB(0, 1), b2 + hstepB, voffB);
            PG8_WAIT_V(6); PG8_BAR; PG8_MMA(1, 1, At, B1); PG8_BAR;
            PG8_LDB(B0, 1, 0); PG8_SCHED; PG8_LDA(At, 1, 0); PG8_STAGE(PG8_SA(0, 1), a2 + hstepA, voffA);
            PG8_WAIT_L(8); PG8_BAR; PG8_WAIT_L(0); PG8_MMA(0, 0, At, B0); PG8_BAR; PG8_SCHED;
            PG8_LDB(B1, 1, 1); PG8_STAGE(PG8_SB(1, 0), b3, voffB);
            PG8_BAR; PG8_WAIT_L(0); PG8_MMA(0, 1, At, B1); PG8_BAR;
            PG8_LDA(At, 1, 1); PG8_STAGE(PG8_SA(1, 0), a3, voffA);
            PG8_BAR; PG8_WAIT_L(0); PG8_MMA(1, 0, At, B0); PG8_BAR; PG8_SCHED;
            PG8_STAGE(PG8_SB(1, 1), b3 + hstepB, voffB);
            PG8_WAIT_V(6); PG8_BAR; PG8_MMA(1, 1, At, B1); PG8_BAR;
            }
        }
        if constexpr (ALIGN_EPI) { if (wr == 0) PG8_BAR; }
        E(acc, cur, wr, wc, fr, fq);
        if (!has_next) break;
#pragma unroll
        for (int a = 0; a < 2; ++a)
#pragma unroll
            for (int b = 0; b < 2; ++b)
#pragma unroll
                for (int m = 0; m < 4; ++m)
#pragma unroll
                    for (int n = 0; n < 2; ++n) acc[a][b][m][n] = (f32x4){0.f, 0.f, 0.f, 0.f};
        cur = nxt; cA = nA; cB = nB; ++ui;
        if constexpr (ALIGN_EPI) { if (wr == 1) PG8_BAR; }
    }
    PG8_WAIT_V(0);
    if constexpr (!ALIGN_EPI) { if (wr == 0) PG8_BAR; }
    PG8_BAR;
#undef PG8_SA
#undef PG8_SB
#undef PG8_STAGE
#undef PG8_LDA
#undef PG8_LDB
#undef PG8_MMA
#undef PG8_WAIT_V
#undef PG8_WAIT_L
#undef PG8_WAIT_L0
#undef PG8_BAR
#undef PG8_SCHED
}
}

typedef f32x4 Acc[2][2][4][2];
__device__ __forceinline__ u32x4 pack8(f32x4 v0, f32x4 v1) { u32x4 w; w.x = cvt_pk_bf16(v0[0], v0[1]); w.y = cvt_pk_bf16(v0[2], v0[3]); w.z = cvt_pk_bf16(v1[0], v1[1]); w.w = cvt_pk_bf16(v1[2], v1[3]); return w; }

struct EpiBf16 {
    static constexpr bool PERM = true;
    bf16_t* O; int ldc; const float* rs;
    __device__ __forceinline__ void operator()(const Acc& acc, const pg8::Unit& u, int wr, int wc, int fr, int fq) const {
        const int row0 = u.pm * 256 + wr * 64 + fr, col0 = u.pn * 256 + wc * 32 + 8 * fq;
        float sv[2][4];
#pragma unroll
        for (int ai = 0; ai < 2; ++ai)
#pragma unroll
            for (int m = 0; m < 4; ++m) sv[ai][m] = rs ? rs[row0 + ai * 128 + m * 16] : 1.f;
#pragma unroll
        for (int ai = 0; ai < 2; ++ai)
#pragma unroll
            for (int m = 0; m < 4; ++m) { const int row = row0 + ai * 128 + m * 16; const float s = sv[ai][m]; bf16_t* rowp = O + (size_t)row * ldc + col0;
#pragma unroll
                for (int bj = 0; bj < 2; ++bj) *(u32x4*)(rowp + bj * 128) = pack8(acc[ai][bj][m][0] * s, acc[ai][bj][m][1] * s); }
    }
};
typedef _Float16 h2_t __attribute__((ext_vector_type(2)));
__device__ __forceinline__ unsigned xpk(float lo, float hi) { const f32x2 v = {lo, hi}; const h2_t h = __builtin_convertvector(v, h2_t); return __builtin_bit_cast(unsigned, h); }
__device__ __forceinline__ f32x2 xun(unsigned w) { return __builtin_convertvector(__builtin_bit_cast(h2_t, w), f32x2); }
__device__ __forceinline__ u32x4 xpack8(f32x4 a, f32x4 b) { u32x4 w; w.x = xpk(a[0], a[1]); w.y = xpk(a[2], a[3]); w.z = xpk(b[0], b[1]); w.w = xpk(b[2], b[3]); return w; }
__device__ __forceinline__ void xunpack8(const u32x4 w, f32x4& a, f32x4& b) { const f32x2 p = xun(w.x), q = xun(w.y), r = xun(w.z), s = xun(w.w); a = (f32x4){p[0], p[1], q[0], q[1]}; b = (f32x4){r[0], r[1], s[0], s[1]}; }
__device__ __forceinline__ void unpack8(const u32x4 w, f32x4& a, f32x4& b) { a = (f32x4){bf_lo(w.x), bf_hi(w.x), bf_lo(w.y), bf_hi(w.y)}; b = (f32x4){bf_lo(w.z), bf_hi(w.z), bf_lo(w.w), bf_hi(w.w)}; }
struct EpiResid {
    static constexpr bool PERM = true;
    const float* base32; const bf16_t* base16; bf16_t* out; const float* gate;
    __device__ __forceinline__ void operator()(const Acc& acc, const pg8::Unit& u, int wr, int wc, int fr, int fq) const {
        const int row0 = u.pm * 256 + wr * 64 + fr, col0 = u.pn * 256 + wc * 32 + 8 * fq;
        f32x4 gv[2][2];
#pragma unroll
        for (int bj = 0; bj < 2; ++bj)
#pragma unroll
            for (int n = 0; n < 2; ++n) gv[bj][n] = *(const f32x4*)(gate + col0 + bj * 128 + n * 4);
#pragma unroll
        for (int ai = 0; ai < 2; ++ai) {
            if (base32) {
#pragma unroll
                for (int mh = 0; mh < 4; mh += 2) { f32x4 xf[2][2][2];
#pragma unroll
                    for (int m = 0; m < 2; ++m)
#pragma unroll
                        for (int bj = 0; bj < 2; ++bj) { const float* p = base32 + (size_t)(row0 + ai * 128 + (mh + m) * 16) * DM + col0 + bj * 128; xf[m][bj][0] = __builtin_nontemporal_load((const f32x4*)p); xf[m][bj][1] = __builtin_nontemporal_load((const f32x4*)(p + 4)); }
#pragma unroll
                    for (int m = 0; m < 2; ++m) { const size_t off = (size_t)(row0 + ai * 128 + (mh + m) * 16) * DM + col0;
#pragma unroll
                        for (int bj = 0; bj < 2; ++bj) *(u32x4*)(out + off + bj * 128) = xpack8(xf[m][bj][0] + gv[bj][0] * acc[ai][bj][mh + m][0], xf[m][bj][1] + gv[bj][1] * acc[ai][bj][mh + m][1]); }
                    asm volatile("" ::: "memory"); }
            } else {
                u32x4 xb[4][2];
#pragma unroll
                for (int m = 0; m < 4; ++m)
#pragma unroll
                    for (int bj = 0; bj < 2; ++bj) xb[m][bj] = *(const u32x4*)(base16 + (size_t)(row0 + ai * 128 + m * 16) * DM + col0 + bj * 128);
#pragma unroll
                for (int m = 0; m < 4; ++m) { const size_t off = (size_t)(row0 + ai * 128 + m * 16) * DM + col0;
#pragma unroll
                    for (int bj = 0; bj < 2; ++bj) { f32x4 b0, b1; xunpack8(xb[m][bj], b0, b1);
                        *(u32x4*)(out + off + bj * 128) = xpack8(b0 + gv[bj][0] * acc[ai][bj][m][0], b1 + gv[bj][1] * acc[ai][bj][m][1]); } }
                asm volatile("" ::: "memory");
            }
        }
    }
};
__device__ __forceinline__ float silu_f(float x) { return x * __builtin_amdgcn_rcpf(1.f + __builtin_amdgcn_exp2f(-1.4426950408889634f * x)); }
struct EpiSwiGLU {
    static constexpr bool PERM = true;
    bf16_t* O;
    __device__ __forceinline__ void operator()(const Acc& acc, const pg8::Unit& u, int wr, int wc, int fr, int fq) const {
        const int row0 = u.pm * 256 + wr * 64 + fr, col0 = u.pn * 128 + wc * 32 + 8 * fq;
#pragma unroll
        for (int ai = 0; ai < 2; ++ai)
#pragma unroll
            for (int m = 0; m < 4; ++m) { f32x4 o0, o1;
#pragma unroll
                for (int e = 0; e < 4; ++e) { o0[e] = silu_f(acc[ai][0][m][0][e]) * acc[ai][1][m][0][e]; o1[e] = silu_f(acc[ai][0][m][1][e]) * acc[ai][1][m][1][e]; }
                *(u32x4*)(O + (size_t)(row0 + ai * 128 + m * 16) * FF + col0) = pack8(o0, o1); }
    }
};
__device__ __forceinline__ void rope8(f32x4& v0, f32x4& v1, const f32x4 cs0, const f32x4 cs1) {
    const float a0 = v0[0] * cs0[0] - v0[1] * cs0[1], b0 = v0[1] * cs0[0] + v0[0] * cs0[1];
    const float a1 = v0[2] * cs0[2] - v0[3] * cs0[3], b1 = v0[3] * cs0[2] + v0[2] * cs0[3];
    const float a2 = v1[0] * cs1[0] - v1[1] * cs1[1], b2 = v1[1] * cs1[0] + v1[0] * cs1[1];
    const float a3 = v1[2] * cs1[2] - v1[3] * cs1[3], b3 = v1[3] * cs1[2] + v1[2] * cs1[3];
    v0 = (f32x4){a0, b0, a1, b1}; v1 = (f32x4){a2, b2, a3, b3};
}
struct EpiDQKV {
    static constexpr bool PERM = true;
    bf16_t* QA; bf16_t* CKV; bf16_t* KR; float* SSQ; float* SSKV; const float* TAB;
    __device__ __forceinline__ void operator()(const Acc& acc, const pg8::Unit& u, int wr, int wc, int fr, int fq) const {
        const int row0 = u.pm * 256 + wr * 64 + fr;
        if (u.pn < 4) {
            bf16_t* O = (u.pn < 2) ? QA : CKV; float* SS = (u.pn < 2) ? SSQ : SSKV; const int ct = u.pn & 1, col0 = ct * 256 + wc * 32 + 8 * fq;
#pragma unroll
            for (int ai = 0; ai < 2; ++ai)
#pragma unroll
                for (int m = 0; m < 4; ++m) { const int row = row0 + ai * 128 + m * 16; float s = 0.f;
#pragma unroll
                    for (int bj = 0; bj < 2; ++bj) { const f32x4 v0 = acc[ai][bj][m][0], v1 = acc[ai][bj][m][1];
                        s += (v0[0] * v0[0] + v0[1] * v0[1]) + (v0[2] * v0[2] + v0[3] * v0[3]) + (v1[0] * v1[0] + v1[1] * v1[1]) + (v1[2] * v1[2] + v1[3] * v1[3]);
                        *(u32x4*)(O + (size_t)row * 512 + col0 + bj * 128) = pack8(v0, v1); }
                    s = xor_add<16>(s); s = xor_add<32>(s);
                    if (fq == 0) SS[(size_t)row * 8 + ct * 4 + wc] = s; }
        } else if (wc < 2) {
            const int col0 = wc * 32 + 8 * fq;
#pragma unroll
            for (int ai = 0; ai < 2; ++ai) { f32x4 t0[4], t1[4];
#pragma unroll
                for (int m = 0; m < 4; ++m) { const int row = row0 + ai * 128 + m * 16, rr = row < SEQ ? row : 0, pos = wc ? (rr & 63) : (rr >> 6); const f32x4* t = (const f32x4*)(TAB + (size_t)(pos * 16 + 4 * fq) * 2); t0[m] = t[0]; t1[m] = t[1]; }
#pragma unroll
                for (int m = 0; m < 4; ++m) { const int row = row0 + ai * 128 + m * 16; f32x4 v0 = acc[ai][0][m][0], v1 = acc[ai][0][m][1];
                    if (row < SEQ) rope8(v0, v1, t0[m], t1[m]);
                    *(u32x4*)(KR + (size_t)row * 64 + col0) = pack8(v0, v1); }
                asm volatile("" ::: "memory"); }
        }
    }
};
__device__ __forceinline__ float row_rstd8(const float* ss, int row, float inv_n) {
    const f32x4 a = *(const f32x4*)(ss + (size_t)row * 8), b = *(const f32x4*)(ss + (size_t)row * 8 + 4);
    return __builtin_amdgcn_rsqf(((a[0] + a[1]) + (a[2] + a[3]) + (b[0] + b[1]) + (b[2] + b[3])) * inv_n + EPS);
}
struct EpiUQ {
    static constexpr bool PERM = true;
    bf16_t* Q; const float* SSQ; const float* TAB;
    __device__ __forceinline__ void operator()(const Acc& acc, const pg8::Unit& u, int wr, int wc, int fr, int fq) const {
        const int row0 = u.pm * 256 + wr * 64 + fr;
        int c0[2], ropei[2];
#pragma unroll
        for (int bj = 0; bj < 2; ++bj) { c0[bj] = u.pn * 256 + bj * 128 + wc * 32 + 8 * fq; const int d0 = c0[bj] % QHD; ropei[bj] = (d0 >= QKN) ? ((d0 - QKN) >> 1) : -1; }
#pragma unroll
        for (int ai = 0; ai < 2; ++ai) {
            f32x4 sa[4], sb[4], t0[4], t1[4];
            const int ri = ropei[0] >= 0 ? ropei[0] : ropei[1];
#pragma unroll
            for (int m = 0; m < 4; ++m) { const int row = row0 + ai * 128 + m * 16; sa[m] = *(const f32x4*)(SSQ + (size_t)row * 8); sb[m] = *(const f32x4*)(SSQ + (size_t)row * 8 + 4); }
            if (ri >= 0) {
#pragma unroll
                for (int m = 0; m < 4; ++m) { const int row = row0 + ai * 128 + m * 16, rr = row < SEQ ? row : 0, pos = (ri >> 4) ? (rr & 63) : (rr >> 6); const f32x4* t = (const f32x4*)(TAB + (size_t)(pos * 16 + (ri & 15)) * 2); t0[m] = t[0]; t1[m] = t[1]; } }
#pragma unroll
            for (int m = 0; m < 4; ++m) { const int row = row0 + ai * 128 + m * 16;
                const float rs = __builtin_amdgcn_rsqf(((sa[m][0] + sa[m][1]) + (sa[m][2] + sa[m][3]) + (sb[m][0] + sb[m][1]) + (sb[m][2] + sb[m][3])) * (1.f / QLORA) + EPS);
#pragma unroll
                for (int bj = 0; bj < 2; ++bj) { f32x4 v0 = acc[ai][bj][m][0] * rs, v1 = acc[ai][bj][m][1] * rs;
                    if (ropei[bj] >= 0 && row < SEQ) rope8(v0, v1, t0[m], t1[m]);
                    *(u32x4*)(Q + (size_t)row * NQ + c0[bj]) = pack8(v0 * QSCALE, v1 * QSCALE); } }
            asm volatile("" ::: "memory");
        }
    }
};
struct EpiUKV {
    static constexpr bool PERM = true;
    bf16_t* KN; bf16_t* V; const float* SSKV;
    __device__ __forceinline__ void operator()(const Acc& acc, const pg8::Unit& u, int wr, int wc, int fr, int fq) const {
        const int row0 = u.pm * 256 + wr * 64 + fr, col0 = u.pn * 128 + wc * 32 + 8 * fq;
#pragma unroll
        for (int ai = 0; ai < 2; ++ai) {
            f32x4 sa[4], sb[4];
#pragma unroll
            for (int m = 0; m < 4; ++m) { const int row = row0 + ai * 128 + m * 16; sa[m] = *(const f32x4*)(SSKV + (size_t)row * 8); sb[m] = *(const f32x4*)(SSKV + (size_t)row * 8 + 4); }
#pragma unroll
            for (int m = 0; m < 4; ++m) { const int row = row0 + ai * 128 + m * 16;
                const float rs = __builtin_amdgcn_rsqf(((sa[m][0] + sa[m][1]) + (sa[m][2] + sa[m][3]) + (sb[m][0] + sb[m][1]) + (sb[m][2] + sb[m][3])) * (1.f / KVLORA) + EPS);
                *(u32x4*)(KN + (size_t)row * DM + col0) = pack8(acc[ai][0][m][0] * rs, acc[ai][0][m][1] * rs);
                *(u32x4*)(V + (size_t)row * DM + col0) = pack8(acc[ai][1][m][0] * rs, acc[ai][1][m][1] * rs); }
            asm volatile("" ::: "memory");
        }
    }
};

template <class Main> struct EpiWithSlab {
    static constexpr bool PERM = Main::PERM;
    static_assert(Main::PERM, "slab layout assumes 8 consecutive columns per lane");
    Main main; bf16_t* slab; int ldc;
    __device__ __forceinline__ void operator()(const Acc& acc, const pg8::Unit& u, int wr, int wc, int fr, int fq) const {
        if (u.pm != 32) { main(acc, u, wr, wc, fr, fq); return; }
        bf16_t* sp = slab + (size_t)u.aux * 256 * ldc + (size_t)(wr * 64 + fr) * ldc + u.pn * 256 + wc * 32 + 8 * fq;
#pragma unroll
        for (int ai = 0; ai < 2; ++ai)
#pragma unroll
            for (int m = 0; m < 4; ++m) { bf16_t* rp = sp + (size_t)(ai * 128 + m * 16) * ldc;
#pragma unroll
                for (int bj = 0; bj < 2; ++bj) *(u32x4*)(rp + bj * 128) = xpack8(acc[ai][bj][m][0], acc[ai][bj][m][1]); }
    }
};

namespace att {
__device__ __forceinline__ int crow(int r, int hi) { return (r & 3) + 8 * (r >> 2) + 4 * hi; }
constexpr float THR = 8.f;
__device__ __forceinline__ void partialSM(f32x16& p0, f32x16& p1, float& m_reg, float& alpha) {
    float pmax = p0[0];
#pragma unroll
    for (int r = 1; r < 16; ++r) pmax = fmaxf(pmax, p0[r]);
#pragma unroll
    for (int r = 0; r < 16; ++r) pmax = fmaxf(pmax, p1[r]);
    { auto rr = __builtin_amdgcn_permlane32_swap(__float_as_uint(pmax), __float_as_uint(pmax), false, false); pmax = fmaxf(__uint_as_float(rr[0]), __uint_as_float(rr[1])); }
    float mn;
    if (__builtin_expect(__all(pmax - m_reg <= THR), 1)) { mn = m_reg; alpha = 1.f; }
    else { mn = fmaxf(m_reg, pmax); alpha = __builtin_amdgcn_exp2f(m_reg - mn); m_reg = mn; }
#pragma unroll
    for (int r = 0; r < 16; ++r) { p0[r] = __builtin_amdgcn_exp2f(p0[r] - mn); p1[r] = p1[r] - mn; }
}
__device__ __forceinline__ void finishSM(const f32x16& p0, f32x16& p1, float alpha, float& l_reg, bf16x8& pa0, bf16x8& pa1, bf16x8& pa2, bf16x8& pa3) {
#pragma unroll
    for (int r = 0; r < 16; ++r) p1[r] = __builtin_amdgcn_exp2f(p1[r]);
    float ps = 0;
#pragma unroll
    for (int r = 0; r < 16; ++r) ps += p0[r];
#pragma unroll
    for (int r = 0; r < 16; ++r) ps += p1[r];
    { auto rr = __builtin_amdgcn_permlane32_swap(__float_as_uint(ps), __float_as_uint(ps), false, false); ps = __uint_as_float(rr[0]) + __uint_as_float(rr[1]); }
    l_reg = l_reg * alpha + ps;
#define PK4(P, BASE, OUT) do { unsigned a0 = cvt_pk_bf16(P[BASE + 0], P[BASE + 1]), a1 = cvt_pk_bf16(P[BASE + 2], P[BASE + 3]);   \
    unsigned b0 = cvt_pk_bf16(P[BASE + 4], P[BASE + 5]), b1 = cvt_pk_bf16(P[BASE + 6], P[BASE + 7]);                              \
    auto r0 = __builtin_amdgcn_permlane32_swap(a0, b0, false, false); auto r1 = __builtin_amdgcn_permlane32_swap(a1, b1, false, false); \
    u32x4 w = {r0[0], r1[0], r0[1], r1[1]}; OUT = *reinterpret_cast<bf16x8*>(&w); } while (0)
    PK4(p0, 0, pa0); PK4(p0, 8, pa1); PK4(p1, 0, pa2); PK4(p1, 8, pa3);
#undef PK4
}
__device__ __forceinline__ void unit_simple(const bf16_t* __restrict__ Q, const bf16_t* __restrict__ KN, const bf16_t* __restrict__ KR, const bf16_t* __restrict__ V, bf16_t* __restrict__ O,
                                            int h, int q0, int k0, int nkeys, LAS float* wsf) {
    const int tid = otid(), wid = tid >> 6, lane = tid & 63, r32 = lane & 31, hi = lane >> 5;
    const bf16_t* Qw = Q + (size_t)(q0 + wid * 32 + r32) * NQ + h * QHD + hi * 8;
    bf16x8 qn[8], qp[4];
#pragma unroll
    for (int d0 = 0; d0 < 8; ++d0) qn[d0] = *(const bf16x8*)(Qw + d0 * 16);
#pragma unroll
    for (int d0 = 0; d0 < 4; ++d0) qp[d0] = *(const bf16x8*)(Qw + QKN + d0 * 16);
    float m_reg = -1e30f, l_reg = 0.f; f32x16 o[4];
#pragma unroll
    for (int d = 0; d < 4; ++d) o[d] = f32x16{};
    for (int kt = 0; kt < nkeys; kt += 64) {
        f32x16 p0 = f32x16{}, p1 = f32x16{};
        const bf16_t* kn0 = KN + (size_t)(k0 + kt + r32) * DM + h * QKN + hi * 8; const bf16_t* kn1 = kn0 + (size_t)32 * DM;
#pragma unroll
        for (int d0 = 0; d0 < 8; ++d0) { const bf16x8 b0 = *(const bf16x8*)(kn0 + d0 * 16), b1 = *(const bf16x8*)(kn1 + d0 * 16);
            p0 = __builtin_amdgcn_mfma_f32_32x32x16_bf16(b0, qn[d0], p0, 0, 0, 0); p1 = __builtin_amdgcn_mfma_f32_32x32x16_bf16(b1, qn[d0], p1, 0, 0, 0); }
        const bf16_t* kr0 = KR + (size_t)(k0 + kt + r32) * QKR + hi * 8; const bf16_t* kr1 = kr0 + 32 * QKR;
#pragma unroll
        for (int d0 = 0; d0 < 4; ++d0) { const bf16x8 b0 = *(const bf16x8*)(kr0 + d0 * 16), b1 = *(const bf16x8*)(kr1 + d0 * 16);
            p0 = __builtin_amdgcn_mfma_f32_32x32x16_bf16(b0, qp[d0], p0, 0, 0, 0); p1 = __builtin_amdgcn_mfma_f32_32x32x16_bf16(b1, qp[d0], p1, 0, 0, 0); }
        float alpha; partialSM(p0, p1, m_reg, alpha);
        if (__any(alpha < 1.f)) { if (hi == 0) wsf[r32] = alpha; asm volatile("s_waitcnt lgkmcnt(0)" ::: "memory");
#pragma unroll
            for (int d = 0; d < 4; ++d)
#pragma unroll
                for (int r = 0; r < 16; ++r) o[d][r] *= wsf[crow(r, hi)];
            asm volatile("s_waitcnt lgkmcnt(0)" ::: "memory"); }
        bf16x8 pa[4]; finishSM(p0, p1, alpha, l_reg, pa[0], pa[1], pa[2], pa[3]);
#pragma unroll
        for (int ks = 0; ks < 4; ++ks) { const bf16_t* vb = V + (size_t)(k0 + kt + 16 * ks + 8 * hi) * DM + h * VD + r32;
#pragma unroll
            for (int d0 = 0; d0 < 4; ++d0) { bf16x8 bv;
#pragma unroll
                for (int j = 0; j < 8; ++j) bv[j] = (short)vb[(size_t)j * DM + d0 * 32];
                o[d0] = __builtin_amdgcn_mfma_f32_32x32x16_bf16(pa[ks], bv, o[d0], 0, 0, 0); } }
    }
    if (hi == 0) wsf[32 + r32] = l_reg; asm volatile("s_waitcnt lgkmcnt(0)" ::: "memory");
    bf16_t* Ow = O + (size_t)(q0 + wid * 32) * DM + h * VD + r32;
#pragma unroll
    for (int r = 0; r < 16; ++r) { const int orow = crow(r, hi); const float rl = __builtin_amdgcn_rcpf(wsf[32 + orow]);
#pragma unroll
        for (int d0 = 0; d0 < 4; ++d0) Ow[(size_t)orow * DM + d0 * 32] = (bf16_t)(cvt_pk_bf16(o[d0][r] * rl, 0.f) & 0xffffu); }
    asm volatile("s_waitcnt lgkmcnt(0)" ::: "memory");
}

constexpr int KN_SLOT = 16384, KR_SLOT = 8192, V_SLOT = 16384;
constexpr int L_KN = 0, L_KR = 3 * KN_SLOT, L_V = L_KR + 3 * KR_SLOT, L_WS = L_V + 3 * V_SLOT, ATT_LDS = L_WS + 8 * 256;
__device__ __forceinline__ void glds16(const void* gsrc, unsigned lds_dst) { unsigned keep;
    asm volatile("s_mov_b32 %0, m0\n\ts_mov_b32 m0, %2\n\ts_nop 0\n\tglobal_load_lds_dwordx4 %1, off\n\ts_mov_b32 m0, %0" : "=&s"(keep) : "v"(gsrc), "s"(lds_dst) : "memory"); }
__device__ __forceinline__ void glds16s(const char* sbase, unsigned voff, unsigned lds_dst) {
    asm volatile("s_mov_b32 m0, %2\n\ts_nop 0\n\tglobal_load_lds_dwordx4 %1, %0" :: "s"(sbase), "v"(voff), "s"(lds_dst) : "memory", "m0"); }
typedef short s16x4 __attribute__((ext_vector_type(4)));
__device__ __forceinline__ int v_rd_base(int lane) { return ((lane & 3) << 3) | (((lane >> 2) & 3) << 6) | (((lane >> 4) & 1) << 5) | (((lane >> 5) & 1) << 8); }
constexpr int v_rd_off(int d0, int ks, int half) { return d0 * 512 + ks * 4096 + half * 2048; }
template <int OFF> __device__ __forceinline__ s16x4 tr_read(int vb) { s16x4 r; asm volatile("ds_read_b64_tr_b16 %0, %1 offset:%2" : "=&v"(r) : "v"(vb), "i"(OFF) : "memory"); return r; }
template <int D0> __device__ __forceinline__ void pv_one(f32x16& od, int vb, bf16x8 pa0, bf16x8 pa1, bf16x8 pa2, bf16x8 pa3) {
    const s16x4 l0 = tr_read<v_rd_off(D0, 0, 0)>(vb), h0 = tr_read<v_rd_off(D0, 0, 1)>(vb), l1 = tr_read<v_rd_off(D0, 1, 0)>(vb), h1 = tr_read<v_rd_off(D0, 1, 1)>(vb);
    const s16x4 l2 = tr_read<v_rd_off(D0, 2, 0)>(vb), h2 = tr_read<v_rd_off(D0, 2, 1)>(vb), l3 = tr_read<v_rd_off(D0, 3, 0)>(vb), h3 = tr_read<v_rd_off(D0, 3, 1)>(vb);
    asm volatile("s_waitcnt lgkmcnt(0)" ::: "memory"); __builtin_amdgcn_sched_barrier(0);
#define PK(L, H) (bf16x8){L[0], L[1], L[2], L[3], H[0], H[1], H[2], H[3]}
    od = __builtin_amdgcn_mfma_f32_32x32x16_bf16(pa0, PK(l0, h0), od, 0, 0, 0);
    od = __builtin_amdgcn_mfma_f32_32x32x16_bf16(pa1, PK(l1, h1), od, 0, 0, 0);
    od = __builtin_amdgcn_mfma_f32_32x32x16_bf16(pa2, PK(l2, h2), od, 0, 0, 0);
    od = __builtin_amdgcn_mfma_f32_32x32x16_bf16(pa3, PK(l3, h3), od, 0, 0, 0);
#undef PK
}
__device__ __forceinline__ void pv_d0(f32x16* o, int vb, bf16x8 pa0, bf16x8 pa1, bf16x8 pa2, bf16x8 pa3) {
    pv_one<0>(o[0], vb, pa0, pa1, pa2, pa3); pv_one<1>(o[1], vb, pa0, pa1, pa2, pa3); pv_one<2>(o[2], vb, pa0, pa1, pa2, pa3); pv_one<3>(o[3], vb, pa0, pa1, pa2, pa3);
}
__device__ __forceinline__ void qkt(f32x16& p0, f32x16& p1, LAS unsigned char* kn, LAS unsigned char* kr, const bf16x8* qn, const bf16x8* qp, int r32, int hi) {
    p0 = f32x16{}; p1 = f32x16{};
#pragma unroll
    for (int d0 = 0; d0 < 8; ++d0) { const int cb = ((2 * d0 + hi) ^ (r32 & 15)) * 16;
        const bf16x8 b0 = *(const LAS bf16x8*)(kn + r32 * 256 + cb), b1 = *(const LAS bf16x8*)(kn + 8192 + r32 * 256 + cb);
        p0 = __builtin_amdgcn_mfma_f32_32x32x16_bf16(b0, qn[d0], p0, 0, 0, 0); p1 = __builtin_amdgcn_mfma_f32_32x32x16_bf16(b1, qn[d0], p1, 0, 0, 0); }
#pragma unroll
    for (int d0 = 0; d0 < 4; ++d0) { const int cb = ((2 * d0 + hi) ^ ((r32 >> 1) & 7)) * 16;
        const bf16x8 b0 = *(const LAS bf16x8*)(kr + r32 * 128 + cb), b1 = *(const LAS bf16x8*)(kr + 4096 + r32 * 128 + cb);
        p0 = __builtin_amdgcn_mfma_f32_32x32x16_bf16(b0, qp[d0], p0, 0, 0, 0); p1 = __builtin_amdgcn_mfma_f32_32x32x16_bf16(b1, qp[d0], p1, 0, 0, 0); }
}

typedef short v4i16_t __attribute__((ext_vector_type(4)));
template <int OFF> __device__ __forceinline__ s16x4 tr_rd(int vb) { return __builtin_bit_cast(s16x4, __builtin_amdgcn_ds_read_tr16_b64_v4i16((LAS v4i16_t*)(vb + OFF))); }
template <bool NOLDS> __device__ __forceinline__ void qkt_p(f32x16& p0, f32x16& p1, LAS unsigned char* kn, LAS unsigned char* kr, const bf16x8* qn, const bf16x8* qp, int r32, int hi) {
    const int swn = r32 & 15, swr = (r32 >> 1) & 7;
    LAS unsigned char* knr = kn + r32 * 256; LAS unsigned char* krr = kr + r32 * 128;
    bf16x8 k0[3], k1[3];
    p0 = f32x16{}; p1 = f32x16{};
#define KRD(D, I) do { if (NOLDS) { k0[I] = qn[(D) & 7]; k1[I] = qn[((D) + 1) & 7]; } else if ((D) < 8) { const int cb = ((2 * (D) + hi) ^ swn) * 16; k0[I] = *(const LAS bf16x8*)(knr + cb); k1[I] = *(const LAS bf16x8*)(knr + 8192 + cb); } \
                       else { const int cb = ((2 * ((D) - 8) + hi) ^ swr) * 16; k0[I] = *(const LAS bf16x8*)(krr + cb); k1[I] = *(const LAS bf16x8*)(krr + 4096 + cb); } } while (0)
    KRD(0, 0); KRD(1, 1); __builtin_amdgcn_sched_barrier(0);
#pragma unroll
    for (int D = 0; D < 12; ++D) {
        if (D + 2 < 12) KRD(D + 2, (D + 2) % 3);
        __builtin_amdgcn_sched_barrier(0);
        const bf16x8 q = D < 8 ? qn[D & 7] : qp[(D - 8) & 3];
        p0 = __builtin_amdgcn_mfma_f32_32x32x16_bf16(k0[D % 3], q, p0, 0, 0, 0); p1 = __builtin_amdgcn_mfma_f32_32x32x16_bf16(k1[D % 3], q, p1, 0, 0, 0);
        __builtin_amdgcn_sched_barrier(0);
    }
#undef KRD
}
template <bool NOLDS> __device__ __forceinline__ void pv_p(f32x16* o, int vb, bf16x8 pa0, bf16x8 pa1, bf16x8 pa2, bf16x8 pa3) {
    s16x4 va[8], vq[8];
#define VRD8(D0, X) do { if (NOLDS) { _Pragma("unroll") for (int _e = 0; _e < 8; ++_e) X[_e] = (s16x4){pa0[_e], pa1[_e], pa2[_e], pa3[_e]}; } else { X[0] = tr_rd<v_rd_off(D0, 0, 0)>(vb); X[1] = tr_rd<v_rd_off(D0, 0, 1)>(vb); X[2] = tr_rd<v_rd_off(D0, 1, 0)>(vb); X[3] = tr_rd<v_rd_off(D0, 1, 1)>(vb); \
                         X[4] = tr_rd<v_rd_off(D0, 2, 0)>(vb); X[5] = tr_rd<v_rd_off(D0, 2, 1)>(vb); X[6] = tr_rd<v_rd_off(D0, 3, 0)>(vb); X[7] = tr_rd<v_rd_off(D0, 3, 1)>(vb); } } while (0)
#define PKV(L, H) (bf16x8){L[0], L[1], L[2], L[3], H[0], H[1], H[2], H[3]}
#define PV4(OD, X) do { OD = __builtin_amdgcn_mfma_f32_32x32x16_bf16(pa0, PKV(X[0], X[1]), OD, 0, 0, 0); OD = __builtin_amdgcn_mfma_f32_32x32x16_bf16(pa1, PKV(X[2], X[3]), OD, 0, 0, 0); \
                         OD = __builtin_amdgcn_mfma_f32_32x32x16_bf16(pa2, PKV(X[4], X[5]), OD, 0, 0, 0); OD = __builtin_amdgcn_mfma_f32_32x32x16_bf16(pa3, PKV(X[6], X[7]), OD, 0, 0, 0); } while (0)
    VRD8(0, va); __builtin_amdgcn_sched_barrier(0);
    VRD8(1, vq); __builtin_amdgcn_sched_barrier(0); PV4(o[0], va); __builtin_amdgcn_sched_barrier(0);
    VRD8(2, va); __builtin_amdgcn_sched_barrier(0); PV4(o[1], vq); __builtin_amdgcn_sched_barrier(0);
    VRD8(3, vq); __builtin_amdgcn_sched_barrier(0); PV4(o[2], va); __builtin_amdgcn_sched_barrier(0);
    PV4(o[3], vq); __builtin_amdgcn_sched_barrier(0);
#undef VRD8
#undef PKV
#undef PV4
}
#define ATT_WAIT_BAR(N) asm volatile("s_waitcnt vmcnt(" #N ") lgkmcnt(0)\n\ts_barrier" ::: "memory")
__device__ __forceinline__ void unit_fast(const bf16_t* __restrict__ Q, const bf16_t* __restrict__ KN, const bf16_t* __restrict__ KR, const bf16_t* __restrict__ V, bf16_t* __restrict__ O,
                                          int h, int q0, int k0, int nkeys, LAS unsigned char* lds) {
    const int tid = otid(), wid = __builtin_amdgcn_readfirstlane(tid >> 6), lane = tid & 63, r32 = lane & 31, hi = lane >> 5;
    const unsigned lds0 = (unsigned)(uintptr_t)lds;
    LAS float* wsf = (LAS float*)(lds + L_WS) + wid * 64;
    unsigned kn_off[2], v_off[2], kr_off;
#pragma unroll
    for (int i = 0; i < 2; ++i) { const int row = 8 * wid + 4 * i + (lane >> 4), lc = (lane & 15) ^ (row & 15); kn_off[i] = (unsigned)(row * DM * 2 + h * QKN * 2 + lc * 16);
        const int s = 2 * (2 * wid + i) + (lane >> 5), kk = 8 * (s >> 2) + ((lane & 31) >> 2), k = (kk & ~0xC) | ((kk & 4) << 1) | ((kk & 8) >> 1), c = 32 * (s & 3) + 8 * (lane & 3);
        v_off[i] = (unsigned)(k * DM * 2 + h * VD * 2 + c * 2); }
    { const int row = 8 * wid + (lane >> 3), lc = (lane & 7) ^ ((row >> 1) & 7); kr_off = (unsigned)(row * QKR * 2 + lc * 16); }
    const char* KNg = (const char*)(KN + (size_t)k0 * DM); const char* KRg = (const char*)(KR + (size_t)k0 * QKR); const char* Vg = (const char*)(V + (size_t)k0 * DM);
    const unsigned dK = lds0 + L_KN + 2 * wid * 1024, dR = lds0 + L_KR + wid * 1024, dV = lds0 + L_V + 2 * wid * 1024;
#define DMA_K(t, sl) do { const char* _g = KNg + (size_t)(t) * (64 * DM * 2); const unsigned _d = (unsigned)__builtin_amdgcn_readfirstlane(dK + (sl) * KN_SLOT); \
        glds16(_g + kn_off[0], _d); glds16(_g + kn_off[1], _d + 1024); glds16(KRg + (size_t)(t) * (64 * QKR * 2) + kr_off, (unsigned)__builtin_amdgcn_readfirstlane(dR + (sl) * KR_SLOT)); } while (0)
#define DMA_V(t, sl) do { const char* _g = Vg + (size_t)(t) * (64 * DM * 2); const unsigned _d = (unsigned)__builtin_amdgcn_readfirstlane(dV + (sl) * V_SLOT); \
        glds16(_g + v_off[0], _d); glds16(_g + v_off[1], _d + 1024); } while (0)
    const int NT = nkeys / 64;
    DMA_K(0, 0); DMA_V(0, 0); DMA_K(1, 1);
    const bf16_t* Qw = Q + (size_t)(q0 + wid * 32 + r32) * NQ + h * QHD + hi * 8;
    bf16x8 qn[8], qp[4];
#pragma unroll
    for (int d0 = 0; d0 < 8; ++d0) qn[d0] = *(const bf16x8*)(Qw + d0 * 16);
#pragma unroll
    for (int d0 = 0; d0 < 4; ++d0) qp[d0] = *(const bf16x8*)(Qw + QKN + d0 * 16);
    float m_reg = -1e30f, l_reg = 0.f; f32x16 o[4];
#pragma unroll
    for (int d = 0; d < 4; ++d) o[d] = f32x16{};
    const int vb0 = (int)(lds0 + L_V) + v_rd_base(lane);
    f32x16 pA0, pA1, pB0, pB1; float alA, alB; bf16x8 pa0, pa1, pa2, pa3;
    int sa = 0, sb = 1, sc = 2;
#define ROT() do { const int _t = sa; sa = sb; sb = sc; sc = _t; } while (0)
#define RESC(a) do { if (__any((a) < 1.f)) { if (hi == 0) wsf[r32] = (a); asm volatile("s_waitcnt lgkmcnt(0)" ::: "memory"); \
        _Pragma("unroll") for (int d = 0; d < 4; ++d) _Pragma("unroll") for (int r = 0; r < 16; ++r) o[d][r] *= wsf[crow(r, hi)]; } } while (0)
    ATT_WAIT_BAR(0);
    { DMA_K((2 < NT ? 2 : NT - 1), sc); DMA_V(1, sb);
      qkt(pA0, pA1, lds + L_KN + sa * KN_SLOT, lds + L_KR + sa * KR_SLOT, qn, qp, r32, hi); partialSM(pA0, pA1, m_reg, alA);
      ATT_WAIT_BAR(5); ROT(); }
#define STEP(j, C0, C1, alC, P0, P1, alP) do { const int _kt = ((j) + 2 < NT) ? (j) + 2 : NT - 1, _vt = ((j) + 1 < NT) ? (j) + 1 : NT - 1; \
        DMA_K(_kt, sc); DMA_V(_vt, sb); __builtin_amdgcn_sched_barrier(0); \
        qkt_p<false>(C0, C1, lds + L_KN + sa * KN_SLOT, lds + L_KR + sa * KR_SLOT, qn, qp, r32, hi); \
        finishSM(P0, P1, alP, l_reg, pa0, pa1, pa2, pa3); __builtin_amdgcn_sched_barrier(0); \
        pv_p<false>(o, vb0 + sc * V_SLOT, pa0, pa1, pa2, pa3); \
        partialSM(C0, C1, m_reg, alC); RESC(alC); \
        ATT_WAIT_BAR(5); ROT(); } while (0)
#pragma unroll 1
    for (int j = 1; j + 1 < NT; j += 2) { STEP(j, pB0, pB1, alB, pA0, pA1, alA); STEP(j + 1, pA0, pA1, alA, pB0, pB1, alB); }
    STEP(NT - 1, pB0, pB1, alB, pA0, pA1, alA);
    finishSM(pB0, pB1, alB, l_reg, pa0, pa1, pa2, pa3); __builtin_amdgcn_sched_barrier(0);
    pv_d0(o, vb0 + sc * V_SLOT, pa0, pa1, pa2, pa3);
    if (hi == 0) wsf[32 + r32] = l_reg;
    ATT_WAIT_BAR(0);
    { LAS bf16_t* stg = (LAS bf16_t*)(lds + wid * 8192);
#pragma unroll
      for (int r = 0; r < 16; ++r) { const int orow = crow(r, hi); const float rl = __builtin_amdgcn_rcpf(wsf[32 + orow]);
#pragma unroll
          for (int d0 = 0; d0 < 4; ++d0) stg[orow * 128 + d0 * 32 + r32] = (bf16_t)(cvt_pk_bf16(o[d0][r] * rl, 0.f) & 0xffffu); }
      asm volatile("s_waitcnt lgkmcnt(0)" ::: "memory");
      bf16_t* Ow = O + (size_t)(q0 + wid * 32) * DM + h * VD;
#pragma unroll
      for (int i = 0; i < 8; ++i) { const int row = i * 4 + (lane >> 4), ch = lane & 15; const u32x4 v = *(const LAS u32x4*)(stg + row * 128 + ch * 8); *(u32x4*)(Ow + (size_t)row * DM + ch * 8) = v; } }
    ATT_WAIT_BAR(0);
#undef DMA_K
#undef DMA_V
#undef ROT
#undef RESC
#undef STEP
}


#define SB0() __builtin_amdgcn_sched_barrier(0)
#define PIN(x) asm volatile("" : "+v"(x))
#define PKQ(P, BASE, OUT) do { unsigned a0 = cvt_pk_bf16(P[BASE + 0], P[BASE + 1]), a1 = cvt_pk_bf16(P[BASE + 2], P[BASE + 3]);   \
    unsigned b0 = cvt_pk_bf16(P[BASE + 4], P[BASE + 5]), b1 = cvt_pk_bf16(P[BASE + 6], P[BASE + 7]);                              \
    auto r0 = __builtin_amdgcn_permlane32_swap(a0, b0, false, false); auto r1 = __builtin_amdgcn_permlane32_swap(a1, b1, false, false); \
    u32x4 w = {r0[0], r1[0], r0[1], r1[1]}; OUT = *reinterpret_cast<bf16x8*>(&w); } while (0)
__device__ __forceinline__ void regionA(f32x16& c0, f32x16& c1, LAS unsigned char* kn, LAS unsigned char* kr, const bf16x8* qn, const bf16x8* qp, int r32, int hi,
                                        f32x16& P0, f32x16& P1, float alP, float& l_reg, bf16x8& pa0, bf16x8& pa1, bf16x8& pa2, bf16x8& pa3,
                                        const char* gk, const char* gkr, unsigned ko0, unsigned ko1, unsigned kro, unsigned dk, unsigned dr) {
    const int swn = r32 & 15, swr = (r32 >> 1) & 7;
    LAS unsigned char* knr = kn + r32 * 256; LAS unsigned char* krr = kr + r32 * 128;
    bf16x8 ka0, ka1, kb0, kb1; float ps = 0.f, ps1 = 0.f, ps2 = 0.f, ps3 = 0.f;
    c0 = f32x16{}; c1 = f32x16{};
#define KRD(D, X0, X1) do { if ((D) < 8) { const int cb = ((2 * (D) + hi) ^ swn) * 16; X0 = *(const LAS bf16x8*)(knr + cb); X1 = *(const LAS bf16x8*)(knr + 8192 + cb); } \
                            else if ((D) < 12) { const int cb = ((2 * ((D) - 8) + hi) ^ swr) * 16; X0 = *(const LAS bf16x8*)(krr + cb); X1 = *(const LAS bf16x8*)(krr + 4096 + cb); } } while (0)
#define QOP(D) ((D) < 8 ? qn[(D) & 7] : qp[((D) - 8) & 3])
#define GAPA(D, X0, X1, WORK) do { \
        c0 = __builtin_amdgcn_mfma_f32_32x32x16_bf16(X0, QOP(D), c0, 0, 0, 0); c1 = __builtin_amdgcn_mfma_f32_32x32x16_bf16(X1, QOP(D), c1, 0, 0, 0); KRD((D) + 2, X0, X1); WORK; SB0(); } while (0)
    KRD(0, ka0, ka1); KRD(1, kb0, kb1); SB0();
    GAPA(0, ka0, ka1, { PKQ(P0, 0, pa0); PIN(pa0); });
    GAPA(1, kb0, kb1, { glds16s(gk, ko0, dk); PKQ(P0, 8, pa1); PIN(pa1); });
    GAPA(2, ka0, ka1, { _Pragma("unroll") for (int r = 0; r < 8; ++r) { ps += P0[r]; ps1 += P0[8 + r]; } PIN(ps); PIN(ps1); });
    GAPA(3, kb0, kb1, { _Pragma("unroll") for (int r = 0; r < 4; ++r) P1[r] = __builtin_amdgcn_exp2f(P1[r]); PIN(P1); });
    GAPA(4, ka0, ka1, { glds16s(gk, ko1, dk + 1024); _Pragma("unroll") for (int r = 4; r < 8; ++r) P1[r] = __builtin_amdgcn_exp2f(P1[r]); PIN(P1); });
    GAPA(5, kb0, kb1, { _Pragma("unroll") for (int r = 8; r < 12; ++r) P1[r] = __builtin_amdgcn_exp2f(P1[r]); PIN(P1); });
    GAPA(6, ka0, ka1, { _Pragma("unroll") for (int r = 12; r < 16; ++r) P1[r] = __builtin_amdgcn_exp2f(P1[r]); PIN(P1); });
    GAPA(7, kb0, kb1, { PKQ(P1, 0, pa2); PIN(pa2); });
    GAPA(8, ka0, ka1, { glds16s(gkr, kro, dr); PKQ(P1, 8, pa3); PIN(pa3); });
    GAPA(9, kb0, kb1, { _Pragma("unroll") for (int r = 0; r < 8; ++r) { ps2 += P1[r]; ps3 += P1[8 + r]; } PIN(ps2); PIN(ps3); });
    GAPA(10, ka0, ka1, { ps = (ps + ps1) + (ps2 + ps3); auto rr = __builtin_amdgcn_permlane32_swap(__float_as_uint(ps), __float_as_uint(ps), false, false); ps = __uint_as_float(rr[0]) + __uint_as_float(rr[1]); l_reg = l_reg * alP + ps; PIN(l_reg); });
    GAPA(11, kb0, kb1, { });
#undef KRD
#undef QOP
#undef GAPA
}
__device__ __forceinline__ void regionB(f32x16* o, int vb, bf16x8 pa0, bf16x8 pa1, bf16x8 pa2, bf16x8 pa3, f32x16& C0, f32x16& C1, float& m_reg, float& alC, const char* gv, unsigned vo0, unsigned vo1, unsigned dv) {
    s16x4 va[8]; float mn = 0.f;
#define VRD8(D0, X) do { X[0] = tr_rd<v_rd_off(D0, 0, 0)>(vb); X[1] = tr_rd<v_rd_off(D0, 0, 1)>(vb); X[2] = tr_rd<v_rd_off(D0, 1, 0)>(vb); X[3] = tr_rd<v_rd_off(D0, 1, 1)>(vb); \
                         X[4] = tr_rd<v_rd_off(D0, 2, 0)>(vb); X[5] = tr_rd<v_rd_off(D0, 2, 1)>(vb); X[6] = tr_rd<v_rd_off(D0, 3, 0)>(vb); X[7] = tr_rd<v_rd_off(D0, 3, 1)>(vb); } while (0)
#define PKV(L, H) (bf16x8){L[0], L[1], L[2], L[3], H[0], H[1], H[2], H[3]}
#define PV4(OD, X) do { OD = __builtin_amdgcn_mfma_f32_32x32x16_bf16(pa0, PKV(X[0], X[1]), OD, 0, 0, 0); OD = __builtin_amdgcn_mfma_f32_32x32x16_bf16(pa1, PKV(X[2], X[3]), OD, 0, 0, 0); \
                         OD = __builtin_amdgcn_mfma_f32_32x32x16_bf16(pa2, PKV(X[4], X[5]), OD, 0, 0, 0); OD = __builtin_amdgcn_mfma_f32_32x32x16_bf16(pa3, PKV(X[6], X[7]), OD, 0, 0, 0); } while (0)
    VRD8(0, va); SB0();
    PV4(o[0], va); VRD8(1, va);
    { float a = fmaxf(fmaxf(C0[0], C0[1]), C1[0]), b = fmaxf(fmaxf(C0[2], C0[3]), C1[1]); a = fmaxf(fmaxf(a, C1[2]), C1[3]);
      _Pragma("unroll") for (int r = 4; r < 16; r += 4) { a = fmaxf(fmaxf(a, C0[r]), C0[r + 1]); b = fmaxf(fmaxf(b, C0[r + 2]), C0[r + 3]); a = fmaxf(fmaxf(a, C1[r]), C1[r + 1]); b = fmaxf(fmaxf(b, C1[r + 2]), C1[r + 3]); }
      float pmax = fmaxf(a, b); { auto rr = __builtin_amdgcn_permlane32_swap(__float_as_uint(pmax), __float_as_uint(pmax), false, false); pmax = fmaxf(__uint_as_float(rr[0]), __uint_as_float(rr[1])); }
      const bool keep = __all(pmax - m_reg <= THR); mn = keep ? m_reg : fmaxf(m_reg, pmax); alC = keep ? 1.f : __builtin_amdgcn_exp2f(m_reg - mn); m_reg = mn; PIN(mn); PIN(alC); }
    SB0();
    PV4(o[1], va); VRD8(2, va);
    { glds16s(gv, vo0, dv); _Pragma("unroll") for (int r = 0; r < 16; ++r) { C0[r] -= mn; C1[r] -= mn; } PIN(C0); PIN(C1); }
    SB0();
    PV4(o[2], va); VRD8(3, va);
    { _Pragma("unroll") for (int r = 0; r < 8; ++r) C0[r] = __builtin_amdgcn_exp2f(C0[r]); PIN(C0); }
    SB0();
    PV4(o[3], va);
    { glds16s(gv, vo1, dv + 1024); _Pragma("unroll") for (int r = 8; r < 16; ++r) C0[r] = __builtin_amdgcn_exp2f(C0[r]); PIN(C0); }
    SB0();
#undef VRD8
#undef PKV
#undef PV4
}
__device__ __forceinline__ void unit_il(const bf16_t* __restrict__ Q, const bf16_t* __restrict__ KN, const bf16_t* __restrict__ KR, const bf16_t* __restrict__ V, bf16_t* __restrict__ O,
                                          int h, int q0, int k0, int nkeys, LAS unsigned char* lds) {
    const int tid = otid(), wid = __builtin_amdgcn_readfirstlane(tid >> 6), lane = tid & 63, r32 = lane & 31, hi = lane >> 5;
    const unsigned lds0 = (unsigned)(uintptr_t)lds;
    LAS float* wsf = (LAS float*)(lds + L_WS) + wid * 64;
    unsigned kn_off[2], v_off[2], kr_off;
#pragma unroll
    for (int i = 0; i < 2; ++i) { const int row = 8 * wid + 4 * i + (lane >> 4), lc = (lane & 15) ^ (row & 15); kn_off[i] = (unsigned)(row * DM * 2 + h * QKN * 2 + lc * 16);
        const int s = 2 * (2 * wid + i) + (lane >> 5), kk = 8 * (s >> 2) + ((lane & 31) >> 2), k = (kk & ~0xC) | ((kk & 4) << 1) | ((kk & 8) >> 1), c = 32 * (s & 3) + 8 * (lane & 3);
        v_off[i] = (unsigned)(k * DM * 2 + h * VD * 2 + c * 2); }
    { const int row = 8 * wid + (lane >> 3), lc = (lane & 7) ^ ((row >> 1) & 7); kr_off = (unsigned)(row * QKR * 2 + lc * 16); }
    const char* KNg = (const char*)(KN + (size_t)k0 * DM); const char* KRg = (const char*)(KR + (size_t)k0 * QKR); const char* Vg = (const char*)(V + (size_t)k0 * DM);
    const unsigned dK = lds0 + L_KN + 2 * wid * 1024, dR = lds0 + L_KR + wid * 1024, dV = lds0 + L_V + 2 * wid * 1024;
#define DMA_K(t, sl) do { const char* _g = KNg + (size_t)(t) * (64 * DM * 2); const unsigned _d = (unsigned)__builtin_amdgcn_readfirstlane(dK + (sl) * KN_SLOT); \
        glds16s(_g, kn_off[0], _d); glds16s(_g, kn_off[1], _d + 1024); glds16s(KRg + (size_t)(t) * (64 * QKR * 2), kr_off, (unsigned)__builtin_amdgcn_readfirstlane(dR + (sl) * KR_SLOT)); } while (0)
#define DMA_V(t, sl) do { const char* _g = Vg + (size_t)(t) * (64 * DM * 2); const unsigned _d = (unsigned)__builtin_amdgcn_readfirstlane(dV + (sl) * V_SLOT); \
        glds16s(_g, v_off[0], _d); glds16s(_g, v_off[1], _d + 1024); } while (0)
    const int NT = nkeys / 64;
    DMA_K(0, 0); DMA_V(0, 0); DMA_K(1, 1);
    const bf16_t* Qw = Q + (size_t)(q0 + wid * 32 + r32) * NQ + h * QHD + hi * 8;
    bf16x8 qn[8], qp[4];
#pragma unroll
    for (int d0 = 0; d0 < 8; ++d0) qn[d0] = *(const bf16x8*)(Qw + d0 * 16);
#pragma unroll
    for (int d0 = 0; d0 < 4; ++d0) qp[d0] = *(const bf16x8*)(Qw + QKN + d0 * 16);
    float m_reg = -1e30f, l_reg = 0.f; f32x16 o[4];
#pragma unroll
    for (int d = 0; d < 4; ++d) o[d] = f32x16{};
    const int vb0 = (int)(lds0 + L_V) + v_rd_base(lane);
    f32x16 pA0, pA1, pB0, pB1; float alA, alB; bf16x8 pa0, pa1, pa2, pa3;
    int sa = 0, sb = 1, sc = 2;
#define ROT() do { const int _t = sa; sa = sb; sb = sc; sc = _t; } while (0)
#define RESC(a) do { if (__any((a) < 1.f)) { if (hi == 0) wsf[r32] = (a); asm volatile("s_waitcnt lgkmcnt(0)" ::: "memory"); \
        _Pragma("unroll") for (int d = 0; d < 4; ++d) _Pragma("unroll") for (int r = 0; r < 16; ++r) o[d][r] *= wsf[crow(r, hi)]; } } while (0)
    ATT_WAIT_BAR(0);
    { DMA_K((2 < NT ? 2 : NT - 1), sc); DMA_V(1, sb);
      qkt(pA0, pA1, lds + L_KN + sa * KN_SLOT, lds + L_KR + sa * KR_SLOT, qn, qp, r32, hi); partialSM(pA0, pA1, m_reg, alA);
      ATT_WAIT_BAR(5); ROT(); }
#define STEP(j, C0, C1, alC, P0, P1, alP) do { const int _kt = ((j) + 2 < NT) ? (j) + 2 : NT - 1, _vt = ((j) + 1 < NT) ? (j) + 1 : NT - 1; \
        const char* _gk = KNg + (size_t)_kt * (64 * DM * 2); const char* _gv = Vg + (size_t)_vt * (64 * DM * 2); \
        const unsigned _dk = (unsigned)__builtin_amdgcn_readfirstlane(dK + sc * KN_SLOT), _dr = (unsigned)__builtin_amdgcn_readfirstlane(dR + sc * KR_SLOT), _dv = (unsigned)__builtin_amdgcn_readfirstlane(dV + sb * V_SLOT); SB0(); \
        regionA(C0, C1, lds + L_KN + sa * KN_SLOT, lds + L_KR + sa * KR_SLOT, qn, qp, r32, hi, P0, P1, alP, l_reg, pa0, pa1, pa2, pa3, _gk, KRg + (size_t)_kt * (64 * QKR * 2), kn_off[0], kn_off[1], kr_off, _dk, _dr); \
        regionB(o, vb0 + sc * V_SLOT, pa0, pa1, pa2, pa3, C0, C1, m_reg, alC, _gv, v_off[0], v_off[1], _dv); RESC(alC); \
        ATT_WAIT_BAR(5); ROT(); } while (0)
#pragma unroll 1
    for (int j = 1; j + 1 < NT; j += 2) { STEP(j, pB0, pB1, alB, pA0, pA1, alA); STEP(j + 1, pA0, pA1, alA, pB0, pB1, alB); }
    STEP(NT - 1, pB0, pB1, alB, pA0, pA1, alA);
    finishSM(pB0, pB1, alB, l_reg, pa0, pa1, pa2, pa3); __builtin_amdgcn_sched_barrier(0);
    pv_d0(o, vb0 + sc * V_SLOT, pa0, pa1, pa2, pa3);
    if (hi == 0) wsf[32 + r32] = l_reg;
    ATT_WAIT_BAR(0);
    { LAS bf16_t* stg = (LAS bf16_t*)(lds + wid * 8192);
#pragma unroll
      for (int r = 0; r < 16; ++r) { const int orow = crow(r, hi); const float rl = __builtin_amdgcn_rcpf(wsf[32 + orow]);
#pragma unroll
          for (int d0 = 0; d0 < 4; ++d0) stg[orow * 128 + d0 * 32 + r32] = (bf16_t)(cvt_pk_bf16(o[d0][r] * rl, 0.f) & 0xffffu); }
      asm volatile("s_waitcnt lgkmcnt(0)" ::: "memory");
      bf16_t* Ow = O + (size_t)(q0 + wid * 32) * DM + h * VD;
#pragma unroll
      for (int i = 0; i < 8; ++i) { const int row = i * 4 + (lane >> 4), ch = lane & 15; const u32x4 v = *(const LAS u32x4*)(stg + row * 128 + ch * 8); *(u32x4*)(Ow + (size_t)row * DM + ch * 8) = v; } }
    ATT_WAIT_BAR(0);
#undef DMA_K
#undef DMA_V
#undef ROT
#undef RESC
#undef STEP
}

}

constexpr size_t MiB = 1u << 20;
constexpr size_t al(size_t x) { return (x + 255) / 256 * 256; }
constexpr size_t WS_CTL = 0, CTL_BYTES = 1 * MiB;
constexpr size_t WS_MOD = WS_CTL + CTL_BYTES, MOD_BYTES = (size_t)DEPTH * 2 * 6 * DM * 4;
constexpr size_t ZERO_BYTES = al(WS_MOD + MOD_BYTES);
constexpr size_t WS_TAB = ZERO_BYTES;
constexpr size_t WS_SSQ = al(WS_TAB + 128 * 16 * 2 * 4), WS_SSKV = al(WS_SSQ + (size_t)R * 8 * 4);
constexpr size_t WS_WIN = al(WS_SSKV + (size_t)R * 8 * 4);
constexpr size_t WS_WINB = WS_WIN + (size_t)2 * EVEN_IN * DM * 2;
constexpr size_t WS_POOLT = WS_WINB + (size_t)2 * DM * 1024 * 2;
constexpr size_t WS_WOUT = WS_POOLT + (size_t)2 * 4 * 256 * 256 * 2;
constexpr size_t WS_WDQKV = WS_WOUT + (size_t)2 * DM * DM * 2;
constexpr size_t WS_WUQ = WS_WDQKV + (size_t)2 * NDQKV * DM * 2;
constexpr size_t WS_WUKV = WS_WUQ + (size_t)2 * NQ * QLORA * 2;
constexpr size_t WS_WO = WS_WUKV + (size_t)2 * NKV * KVLORA * 2;
constexpr size_t WS_WGU = WS_WO + (size_t)2 * DM * DM * 2;
constexpr size_t WS_WDN = WS_WGU + (size_t)4 * 2 * FF * DM * 2;
constexpr size_t WS_X = al(WS_WDN + (size_t)4 * DM * FF * 2);
constexpr size_t WS_H = WS_X + (size_t)R * DM * 4;
constexpr size_t WS_Z = WS_H + (size_t)R * DM * 2;
constexpr size_t WS_CAT = WS_Z + (size_t)R * EVEN_IN * 2;
constexpr size_t WS_ACT = WS_CAT + (size_t)R * DM * 2;
constexpr size_t WS_Q = WS_ACT + (size_t)R * FF * 2;
constexpr size_t WS_KN = WS_Q + (size_t)R * NQ * 2;
constexpr size_t WS_V = WS_KN + (size_t)R * DM * 2;
constexpr size_t WS_KR = WS_V + (size_t)R * DM * 2;
constexpr size_t WS_QA = al(WS_KR + (size_t)R * QKR * 2);
constexpr size_t WS_CKV = WS_QA + (size_t)R * QLORA * 2;
constexpr size_t WS_SLAB = al(WS_CKV + (size_t)R * KVLORA * 2);
constexpr size_t WS_END = WS_SLAB + (size_t)11 * 256 * DM * 4;

constexpr int RING_BYTES = 131072, MISC_OFF = RING_BYTES + 320, LDS_BYTES = 147456;
constexpr int NWAVES = 8;

#define XB_TMO      128
#define XB_XCNT(j)  (256  + 64 * (j))
#define XB_XSUB(j)  (1280 + 64 * (j))
#define XB_XGEN(j)  (2304 + 64 * (j))
#define XB_TOP      3328
#define XB_TOPGEN   3392
#define XCD_BAR_WORDS 3456
#define XB_SPIN_CAP (1u << 18)
__device__ __forceinline__ unsigned xb_ld(unsigned* p)              { return __hip_atomic_load(p, __ATOMIC_RELAXED, __HIP_MEMORY_SCOPE_AGENT); }
__device__ __forceinline__ unsigned xb_add(unsigned* p, unsigned v) { return __hip_atomic_fetch_add(p, v, __ATOMIC_RELAXED, __HIP_MEMORY_SCOPE_AGENT); }
__device__ __forceinline__ unsigned xb_xcc_id() { return (unsigned)__builtin_amdgcn_s_getreg((3 << 11) | 20) & 0xFu; }
#define XB_SPIN(cond, bar) do { unsigned _sp = 0; while (cond) { __builtin_amdgcn_s_sleep(1); \
    if ((++_sp & 255u) == 0u) { if (xb_ld(&(bar)[XB_TMO])) break; if (_sp > XB_SPIN_CAP) { atomicAdd(&(bar)[XB_TMO], 1u); break; } } } } while (0)
struct XcdBarrier { unsigned* bar; unsigned x; volatile LAS unsigned* st; };
__device__ __forceinline__ XcdBarrier xcd_barrier_post(unsigned* bar, volatile LAS unsigned* st) {
    XcdBarrier b; b.bar = bar; b.x = xb_xcc_id(); b.st = st;
    if (threadIdx.x == 0) (void)xb_add(&bar[XB_XCNT(b.x)], 1u);
    return b;
}
__device__ __forceinline__ void xcd_barrier_complete(unsigned* bar, unsigned x, unsigned& nloc, unsigned& nx) {
    const unsigned G = gridDim.x * gridDim.y * gridDim.z;
    unsigned sum, cnt, mine, sp = 0u;
    for (;;) {
        sum = 0u; cnt = 0u; mine = 0u;
#pragma unroll
        for (unsigned j = 0; j < 16; ++j) { const unsigned c = xb_ld(&bar[XB_XCNT(j)]); sum += c; cnt += (c > 0u) ? 1u : 0u; mine = (j == x) ? c : mine; }
        if (sum == G) break;
        __builtin_amdgcn_s_sleep(1);
        if ((++sp & 255u) == 0u) { if (xb_ld(&bar[XB_TMO])) break; if (sp > XB_SPIN_CAP) { atomicAdd(&bar[XB_TMO], 1u); break; } }
    }
    nloc = mine > 0u ? mine : 1u; nx = cnt > 0u ? cnt : 1u;
}
__device__ __attribute__((noinline)) void xcd_barrier_ni(unsigned* bar_, unsigned x_, volatile LAS unsigned* st_) {
    XcdBarrier b; b.bar = bar_; b.x = x_; b.st = st_;
    asm volatile("s_waitcnt vmcnt(0)" ::: "memory");
    __syncthreads();
    if (threadIdx.x == 0) {
        unsigned* bar = b.bar;
        __builtin_amdgcn_s_waitcnt(0);
        unsigned nloc = b.st[0], nx = b.st[1];
        if (nloc == 0u) { xcd_barrier_complete(bar, b.x, nloc, nx); b.st[0] = nloc; b.st[1] = nx; }
        const unsigned old = xb_add(&bar[XB_XSUB(b.x)], 1u);
        const unsigned gen = old / nloc;
        if (old + 1u == (gen + 1u) * nloc) {
            __builtin_amdgcn_fence(__ATOMIC_RELEASE, "agent");
            asm volatile("s_waitcnt vmcnt(0)" ::: "memory");
            const unsigned og = xb_add(&bar[XB_TOP], 1u);
            const unsigned tg = og / nx;
            if (og + 1u == (tg + 1u) * nx) xb_add(&bar[XB_TOPGEN], 1u);
            else XB_SPIN(xb_ld(&bar[XB_TOPGEN]) == tg, bar);
            __builtin_amdgcn_fence(__ATOMIC_ACQUIRE, "agent");
            xb_add(&bar[XB_XGEN(b.x)], 1u);
            asm volatile("s_waitcnt vmcnt(0)" ::: "memory");
        } else {
            XB_SPIN(xb_ld(&bar[XB_XGEN(b.x)]) == gen, bar);
            __builtin_amdgcn_fence(__ATOMIC_ACQUIRE, "agent");
            asm volatile("s_waitcnt vmcnt(0)" ::: "memory");
        }
    }
    __syncthreads();
}

struct Args { const float* in[24]; float* out; unsigned char* ws; int ph_lo, ph_hi; };

__device__ __forceinline__ void transpose_item(const float* W, int ldw, int k0, int n0, bf16_t* WT, int ldt, int drow, bool perm, const float* kscale, LAS float* scr, int lane) {
    float tv[32];
    const float* wp = W + (size_t)(k0 + (lane >> 5)) * ldw + n0 + (lane & 31);
#pragma unroll
    for (int i = 0; i < 32; ++i) tv[i] = __builtin_nontemporal_load(wp + (size_t)(2 * i) * ldw);
    if (kscale) {
#pragma unroll
        for (int i = 0; i < 32; ++i) tv[i] *= kscale[k0 + 2 * i + (lane >> 5)]; }
#pragma unroll
    for (int i = 0; i < 32; ++i) scr[(2 * i + (lane >> 5)) * 33 + (lane & 31)] = tv[i];
    asm volatile("s_waitcnt lgkmcnt(0)" ::: "memory");
    const int c = lane & 7;
#pragma unroll
    for (int j = 0; j < 4; ++j) { const int nn = (lane >> 3) + 8 * j; const LAS float* s = scr + (8 * c) * 33 + nn;
        u32x4 o; o.x = cvt_pk_bf16(s[0 * 33], s[1 * 33]); o.y = cvt_pk_bf16(s[2 * 33], s[3 * 33]); o.z = cvt_pk_bf16(s[4 * 33], s[5 * 33]); o.w = cvt_pk_bf16(s[6 * 33], s[7 * 33]);
        const int dn = perm ? (2 * (nn & 15) + (nn >> 4)) : nn;
        *(u32x4*)(WT + (size_t)(drow + dn) * ldt + k0 + 8 * c) = o; }
    asm volatile("s_waitcnt lgkmcnt(0)" ::: "memory");
}
struct TJob { const float* W; int ldw, K, col0, ncols; bf16_t* WT; int ldt, kind, drow0; const float* kscale; };
__device__ __forceinline__ long tjob_items(const TJob& j) { return (long)(j.K / 64) * (j.ncols / 32); }
__device__ __forceinline__ void tjob_run(const TJob& j, long item, LAS float* scr, int lane) {
    const int nblk = j.ncols / 32, kb = (int)(item / nblk), nb = (int)(item % nblk), n0 = j.col0 + 32 * nb, rel = 32 * nb;
    int drow; bool perm = false;
    if (j.kind == 1) drow = 256 * (rel / 128) + (rel % 128);
    else if (j.kind == 2) drow = 256 * (rel / 128) + 128 + (rel % 128);
    else { drow = j.drow0 + rel; if (j.kind == 3) perm = (rel % QHD) >= QKN; if (j.kind == 4) perm = true; }
    transpose_item(j.W, j.ldw, 64 * kb, n0, j.WT, j.ldt, drow, perm, j.kscale, scr, lane);
}
constexpr int NTJOBS = 2 * (2 + 4) + 2 * 6 + 4 * 3;
__device__ __forceinline__ TJob get_tjob(unsigned char* ws, int id) {
    TJob j{}; j.kscale = nullptr; j.kind = 0; j.drow0 = 0; j.col0 = 0;
    if (id < 12) { const int l = id / 6, s = id % 6;
        if (s == 0) { j.W = INP(8) + (size_t)l * DM * EVEN_IN; j.ldw = EVEN_IN; j.K = DM; j.col0 = 1024; j.ncols = 3072; j.WT = (bf16_t*)(ws + WS_WIN) + (size_t)l * EVEN_IN * DM; j.ldt = DM; j.drow0 = 1024; }
        else if (s == 1) { j.W = INP(12) + (size_t)l * DM * DM; j.ldw = DM; j.K = DM; j.ncols = DM; j.WT = (bf16_t*)(ws + WS_WOUT) + (size_t)l * DM * DM; j.ldt = DM; }
        else { const int g = s - 2; j.W = INP(9) + (size_t)(l * 4 + g) * 65536; j.ldw = 256; j.K = 256; j.ncols = 256; j.WT = (bf16_t*)(ws + WS_POOLT) + (size_t)(l * 4 + g) * 65536; j.ldt = 256; }
    } else if (id < 24) { const int l = (id - 12) / 6, s = (id - 12) % 6;
        bf16_t* wd = (bf16_t*)(ws + WS_WDQKV) + (size_t)l * NDQKV * DM;
        if (s == 0) { j.W = INP(13) + (size_t)l * DM * QLORA; j.ldw = QLORA; j.K = DM; j.ncols = QLORA; j.WT = wd; j.ldt = DM; }
        else if (s == 1) { j.W = INP(16) + (size_t)l * DM * 576; j.ldw = 576; j.K = DM; j.ncols = KVLORA; j.WT = wd; j.ldt = DM; j.drow0 = 512; }
        else if (s == 2) { j.W = INP(16) + (size_t)l * DM * 576; j.ldw = 576; j.K = DM; j.col0 = 512; j.ncols = 64; j.WT = wd; j.ldt = DM; j.drow0 = 1024; j.kind = 4; }
        else if (s == 3) { j.W = INP(15) + (size_t)l * QLORA * NQ; j.ldw = NQ; j.K = QLORA; j.ncols = NQ; j.WT = (bf16_t*)(ws + WS_WUQ) + (size_t)l * NQ * QLORA; j.ldt = QLORA; j.kind = 3; j.kscale = INP(14) + l * QLORA; }
        else if (s == 4) { j.W = INP(18) + (size_t)l * KVLORA * NKV; j.ldw = NKV; j.K = KVLORA; j.ncols = NKV; j.WT = (bf16_t*)(ws + WS_WUKV) + (size_t)l * NKV * KVLORA; j.ldt = KVLORA; j.kscale = INP(17) + l * KVLORA; }
        else { j.W = INP(19) + (size_t)l * DM * DM; j.ldw = DM; j.K = DM; j.ncols = DM; j.WT = (bf16_t*)(ws + WS_WO) + (size_t)l * DM * DM; j.ldt = DM; }
    } else { const int l = (id - 24) / 3, s = (id - 24) % 3;
        if (s == 0) { j.W = INP(20) + (size_t)l * DM * FF; j.ldw = FF; j.K = DM; j.ncols = FF; j.WT = (bf16_t*)(ws + WS_WGU) + (size_t)l * 2 * FF * DM; j.ldt = DM; j.kind = 1; }
        else if (s == 1) { j.W = INP(21) + (size_t)l * DM * FF; j.ldw = FF; j.K = DM; j.ncols = FF; j.WT = (bf16_t*)(ws + WS_WGU) + (size_t)l * 2 * FF * DM; j.ldt = DM; j.kind = 2; }
        else { j.W = INP(22) + (size_t)l * FF * DM; j.ldw = DM; j.K = FF; j.ncols = DM; j.WT = (bf16_t*)(ws + WS_WDN) + (size_t)l * DM * FF; j.ldt = FF; }
    }
    return j;
}

__device__ __forceinline__ void prologue(unsigned char* ws, LAS unsigned char* lds, int gw, int NGW, int wave, int lane, int njobs) {
    {
        float* MOD = (float*)(ws + WS_MOD);
        const float* c0 = INP(1); const float* c1 = INP(3);
        LAS float* red = (LAS float*)lds;
        const int bxp = gw / NWAVES, Gp = NGW / NWAVES, tidp = wave * 64 + lane;
        for (int task = bxp; task < 4 * 64; task += Gp) {
            const int l = task / 64, cg = task % 64, col = cg * 192 + 3 * lane;
            const float* Wp = INP(4) + ((size_t)l * DM + wave * 256) * (6 * DM) + col;
            float s0[3] = {0.f, 0.f, 0.f}, s1[3] = {0.f, 0.f, 0.f};
#pragma unroll 1
            for (int kb = 0; kb < 256; kb += 64) {
                const float x0 = c0[wave * 256 + kb + lane], x1 = c1[wave * 256 + kb + lane];
                const float sv0 = x0 / (1.f + __expf(-x0)), sv1 = x1 / (1.f + __expf(-x1));
#pragma unroll 8
                for (int k = 0; k < 64; ++k) { const float* wp = Wp + (size_t)(kb + k) * (6 * DM);
                    const float w0 = __builtin_nontemporal_load(wp), w1 = __builtin_nontemporal_load(wp + 1), w2 = __builtin_nontemporal_load(wp + 2);
                    const float a0 = __builtin_bit_cast(float, __builtin_amdgcn_readlane(__builtin_bit_cast(int, sv0), k)), a1 = __builtin_bit_cast(float, __builtin_amdgcn_readlane(__builtin_bit_cast(int, sv1), k));
                    s0[0] += w0 * a0; s0[1] += w1 * a0; s0[2] += w2 * a0; s1[0] += w0 * a1; s1[1] += w1 * a1; s1[2] += w2 * a1; }
            }
#pragma unroll
            for (int e = 0; e < 3; ++e) { red[(wave * 2 + 0) * 192 + 3 * lane + e] = s0[e]; red[(wave * 2 + 1) * 192 + 3 * lane + e] = s1[e]; }
            __syncthreads();
            if (tidp < 384) { const int s = tidp / 192, cc = tidp % 192; float acc = INP(5)[(size_t)l * 6 * DM + cg * 192 + cc];
#pragma unroll
              for (int w = 0; w < NWAVES; ++w) acc += red[(w * 2 + s) * 192 + cc];
              MOD[((size_t)l * 2 + s) * 6 * DM + cg * 192 + cc] = acc; }
            __syncthreads();
        }
    }
    {
        LAS float* scr = (LAS float*)(lds + wave * 16384);
        long base = 0;
        for (int id = 0; id < njobs; ++id) {
            const TJob j = get_tjob(ws, id); const long n = tjob_items(j);
            long first = ((long)gw - base % NGW + NGW) % NGW;
            for (long it = first; it < n; it += NGW) tjob_run(j, it, scr, lane);
            base += n;
        }
    }
    {
        bf16_t* WB = (bf16_t*)(ws + WS_WINB);
        const long n8 = (long)2 * DM * 1024 / 8;
        for (long i = (long)gw * 64 + lane; i < n8; i += (long)NGW * 64) { const long e = i * 8; const int l = (int)(e / ((long)DM * 1024)); const long rem = e % ((long)DM * 1024); const int k = (int)(rem / 1024), m = (int)(rem % 1024);
            const float* s = INP(8) + ((size_t)l * DM + k) * EVEN_IN + m; const f32x4 v0 = *(const f32x4*)s, v1 = *(const f32x4*)(s + 4);
            *(u32x4*)(WB + e) = pack8(v0, v1); }
    }
    {
        float* TAB = (float*)(ws + WS_TAB);
        for (int i = gw * 64 + lane; i < 128 * 16; i += NGW * 64) { const int pos = i >> 4, f = i & 15; const float inv = powf(10000.f, -(float)f / 16.f); const float ang = (float)pos * inv; TAB[2 * i] = cosf(ang); TAB[2 * i + 1] = sinf(ang); }
        const long nz = (long)2 * (NDQKV - 1088) * DM / 8;
        for (long i = (long)gw * 64 + lane; i < nz; i += (long)NGW * 64) { const long e = i * 8; const int l = (int)(e / ((long)(NDQKV - 1088) * DM)); const long rem = e % ((long)(NDQKV - 1088) * DM);
            *(u32x4*)((bf16_t*)(ws + WS_WDQKV) + (size_t)l * NDQKV * DM + (size_t)1088 * DM + rem) = (u32x4){0u, 0u, 0u, 0u}; }
    }
}

constexpr int DEF_PER_LAYER = 3 * 5632;
__device__ __forceinline__ void deferred_convert(unsigned char* ws, LAS unsigned char* lds, int L, int r_begin, int r_cap, int rank, int quota, int wave, int lane) {
    LAS float* scr = (LAS float*)(lds + wave * 16384);
    for (int k = wave; k < quota; k += NWAVES) {
        const int r = r_begin + rank * quota + k; if (r >= r_cap) break;
        const int s = r / 5632;
        const TJob j = get_tjob(ws, 24 + 3 * L + s); tjob_run(j, r - s * 5632, scr, lane);
    }
}

__device__ __forceinline__ void norm_mod_phase(const float* xl, const float* xc, const float* g, const float* modl, const float* modc, int which, bf16_t* H, int gw, int NGW, int lane, int nrows) {
#pragma unroll 1
    for (int pass = 0; pass < 2; ++pass) {
        const int rlo = pass ? SEQ : 0, rhi = pass ? nrows : (nrows < SEQ ? nrows : SEQ);
        if (rlo >= rhi) continue;
        const float* mod = pass ? modc : modl; const float* xb = pass ? xc : xl;
        const float* sh = mod + (which ? 3 : 0) * DM; const float* sc = sh + DM;
        f32x4 A[8], B[8];
#pragma unroll
        for (int j = 0; j < 8; ++j) { const int c = 256 * j + 4 * lane; A[j] = *(const f32x4*)(g + c); B[j] = *(const f32x4*)(sc + c); }
        __builtin_amdgcn_sched_barrier(0);
#pragma unroll
        for (int j = 0; j < 8; ++j) { const int c = 256 * j + 4 * lane; A[j] = A[j] * (B[j] + 1.f); B[j] = *(const f32x4*)(sh + c); }
        for (int row = rlo + gw; row < rhi; row += NGW) {
            const f32x4* xr = (const f32x4*)(xb + (size_t)row * DM) + lane; f32x4 v[8]; float ss = 0.f;
#pragma unroll
            for (int j = 0; j < 8; ++j) v[j] = __builtin_nontemporal_load(xr + 64 * j);
            asm volatile("" : "+v"(v[0]), "+v"(v[1]), "+v"(v[2]), "+v"(v[3]), "+v"(v[4]), "+v"(v[5]), "+v"(v[6]), "+v"(v[7]));
#pragma unroll
            for (int j = 0; j < 8; ++j) ss += (v[j][0] * v[j][0] + v[j][1] * v[j][1]) + (v[j][2] * v[j][2] + v[j][3] * v[j][3]);
            const float rstd = __builtin_amdgcn_rsqf(wave_sum(ss) * (1.f / DM) + EPS);
            u32x2* o = (u32x2*)(H + (size_t)row * DM) + lane;
#pragma unroll
            for (int j = 0; j < 8; ++j) { const f32x4 y = v[j] * rstd * A[j] + B[j]; u32x2 w; w.x = cvt_pk_bf16(y[0], y[1]); w.y = cvt_pk_bf16(y[2], y[3]); o[64 * j] = w; }
        }
    }
}
__device__ __forceinline__ void norm_mod_phase16(const bf16_t* X, const float* g, const float* mod, int which, bf16_t* H, int gw, int NGW, int lane) {
    const float* sh = mod + (which ? 3 : 0) * DM; const float* sc = sh + DM;
    f32x4 A[4][2], B[4][2];
#pragma unroll
    for (int j = 0; j < 4; ++j)
#pragma unroll
        for (int h = 0; h < 2; ++h) { const int c = 512 * j + 8 * lane + 4 * h; A[j][h] = *(const f32x4*)(g + c); B[j][h] = *(const f32x4*)(sc + c); }
    __builtin_amdgcn_sched_barrier(0);
#pragma unroll
    for (int j = 0; j < 4; ++j)
#pragma unroll
        for (int h = 0; h < 2; ++h) { const int c = 512 * j + 8 * lane + 4 * h; A[j][h] = A[j][h] * (B[j][h] + 1.f); B[j][h] = *(const f32x4*)(sh + c); }
    for (int row = gw; row < SEQ; row += 2 * NGW) {
        const int row2 = row + NGW; const bool has2 = row2 < SEQ; const int r2 = has2 ? row2 : row;
        const u32x4* xr = (const u32x4*)(X + (size_t)row * DM) + lane; const u32x4* xs = (const u32x4*)(X + (size_t)r2 * DM) + lane;
        u32x4 ra[4], rb[4];
#pragma unroll
        for (int j = 0; j < 4; ++j) ra[j] = xr[64 * j];
#pragma unroll
        for (int j = 0; j < 4; ++j) rb[j] = xs[64 * j];
        f32x4 v[4][2], w[4][2]; float ss = 0.f, st = 0.f;
#pragma unroll
        for (int j = 0; j < 4; ++j) { xunpack8(ra[j], v[j][0], v[j][1]);
#pragma unroll
            for (int h = 0; h < 2; ++h) ss += (v[j][h][0] * v[j][h][0] + v[j][h][1] * v[j][h][1]) + (v[j][h][2] * v[j][h][2] + v[j][h][3] * v[j][h][3]); }
#pragma unroll
        for (int j = 0; j < 4; ++j) { xunpack8(rb[j], w[j][0], w[j][1]);
#pragma unroll
            for (int h = 0; h < 2; ++h) st += (w[j][h][0] * w[j][h][0] + w[j][h][1] * w[j][h][1]) + (w[j][h][2] * w[j][h][2] + w[j][h][3] * w[j][h][3]); }
        const float rstd = __builtin_amdgcn_rsqf(wave_sum(ss) * (1.f / DM) + EPS), rstd2 = __builtin_amdgcn_rsqf(wave_sum(st) * (1.f / DM) + EPS);
        u32x4* o = (u32x4*)(H + (size_t)row * DM) + lane;
#pragma unroll
        for (int j = 0; j < 4; ++j) o[64 * j] = pack8(v[j][0] * rstd * A[j][0] + B[j][0], v[j][1] * rstd * A[j][1] + B[j][1]);
        if (has2) { u32x4* o2 = (u32x4*)(H + (size_t)row2 * DM) + lane;
#pragma unroll
            for (int j = 0; j < 4; ++j) o2[64 * j] = pack8(w[j][0] * rstd2 * A[j][0] + B[j][0], w[j][1] * rstd2 * A[j][1] + B[j][1]); }
    }
}
__device__ __forceinline__ void final_norm_phase(const bf16_t* X, const float* g, float* out, int gw, int NGW, int lane) {
    f32x4 G[4][2];
#pragma unroll
    for (int j = 0; j < 4; ++j)
#pragma unroll
        for (int h = 0; h < 2; ++h) G[j][h] = *(const f32x4*)(g + 512 * j + 8 * lane + 4 * h);
    for (int row = gw; row < SEQ; row += NGW) {
        const u32x4* xr = (const u32x4*)(X + (size_t)row * DM) + lane; f32x4 v[4][2]; float ss = 0.f;
#pragma unroll
        for (int j = 0; j < 4; ++j) { xunpack8(xr[64 * j], v[j][0], v[j][1]);
#pragma unroll
            for (int h = 0; h < 2; ++h) ss += (v[j][h][0] * v[j][h][0] + v[j][h][1] * v[j][h][1]) + (v[j][h][2] * v[j][h][2] + v[j][h][3] * v[j][h][3]); }
        const float rstd = __builtin_amdgcn_rsqf(wave_sum(ss) * (1.f / DM) + EPS);
        float* o = out + (size_t)row * DM + 8 * lane;
#pragma unroll
        for (int j = 0; j < 4; ++j) { *(f32x4*)(o + 512 * j) = v[j][0] * rstd * G[j][0]; *(f32x4*)(o + 512 * j + 4) = v[j][1] * rstd * G[j][1]; }
    }
}
template <int S>
__device__ __forceinline__ void ctx_norm_phase(const float* __restrict__ x32, const bf16_t* x16, bf16_t* Xc, const bf16_t* __restrict__ slab, const float* __restrict__ gate, const float* __restrict__ g, const float* __restrict__ modc, int which, bf16_t* __restrict__ Hc, LAS float* red, int bx, int G, int tid) {
    const int col = 4 * tid, lane = tid & 63, wave = tid >> 6;
    const float* sh = modc + (which ? 3 : 0) * DM; const float* sc = sh + DM;
    for (int r = bx; r < CTXL; r += G) {
        f32x4 v; u32x2 sw[S > 0 ? S : 1];
        if (x32) v = *(const f32x4*)(x32 + (size_t)r * DM + col);
        else { const u32x2 w = *(const u32x2*)(x16 + (size_t)r * DM + col); const f32x2 p = xun(w.x), q = xun(w.y); v = (f32x4){p[0], p[1], q[0], q[1]}; }
#pragma unroll
        for (int s = 0; s < S; ++s) sw[s] = *(const u32x2*)(slab + ((size_t)s * 256 + r) * DM + col);
        const f32x4 gv = *(const f32x4*)(g + col), scv = *(const f32x4*)(sc + col), shv = *(const f32x4*)(sh + col);
        if (S > 0) { const f32x4 gt = *(const f32x4*)(gate + col); f32x4 a = {0.f, 0.f, 0.f, 0.f};
#pragma unroll
            for (int s = 0; s < S; ++s) { const f32x2 p = xun(sw[s].x), q = xun(sw[s].y); a += (f32x4){p[0], p[1], q[0], q[1]}; }
            v += gt * a;
            u32x2 w; w.x = xpk(v[0], v[1]); w.y = xpk(v[2], v[3]); *(u32x2*)(Xc + (size_t)r * DM + col) = w;
            const f32x2 p = xun(w.x), q = xun(w.y); v = (f32x4){p[0], p[1], q[0], q[1]}; }
        float ss = wave_sum((v[0] * v[0] + v[1] * v[1]) + (v[2] * v[2] + v[3] * v[3]));
        if (lane == 0) red[wave] = ss;
        __syncthreads();
        float tot = 0.f;
#pragma unroll
        for (int w = 0; w < NWAVES; ++w) tot += red[w];
        __syncthreads();
        const float rstd = __builtin_amdgcn_rsqf(tot * (1.f / DM) + EPS);
        const f32x4 A = gv * (scv + 1.f), y = v * rstd * A + shv;
        u32x2 w; w.x = cvt_pk_bf16(y[0], y[1]); w.y = cvt_pk_bf16(y[2], y[3]); *(u32x2*)(Hc + (size_t)r * DM + col) = w;
    }
}
__device__ __forceinline__ void ld8f(const bf16_t* p, float (&f)[8]) { const u32x4 w = *(const u32x4*)p; f[0] = bf_lo(w.x); f[1] = bf_hi(w.x); f[2] = bf_lo(w.y); f[3] = bf_hi(w.y); f[4] = bf_lo(w.z); f[5] = bf_hi(w.z); f[6] = bf_lo(w.w); f[7] = bf_hi(w.w); }
__device__ __forceinline__ void ld8s(const bf16_t* ZS, int q, int c, float (&f)[8]) {
    f32x4 a = {0.f, 0.f, 0.f, 0.f}, b = a;
#pragma unroll
    for (int s = 0; s < 4; ++s) { f32x4 x, y; xunpack8(*(const u32x4*)(ZS + ((size_t)s * 256 + q) * EVEN_IN + c), x, y); a += x; b += y; }
    f[0] = a[0]; f[1] = a[1]; f[2] = a[2]; f[3] = a[3]; f[4] = b[0]; f[5] = b[1]; f[6] = b[2]; f[7] = b[3];
}
__device__ __forceinline__ void ld4s_raw(const bf16_t* __restrict__ ZS, int q, int c, u32x4 (&r)[4]) {
#pragma unroll
    for (int s = 0; s < 4; ++s) r[s] = *(const u32x4*)(ZS + ((size_t)s * 256 + q) * EVEN_IN + c);
}
__device__ __forceinline__ void sum4s(const u32x4 (&r)[4], float (&f)[8]) {
    f32x4 a = {0.f, 0.f, 0.f, 0.f}, b = a;
#pragma unroll
    for (int s = 0; s < 4; ++s) { f32x4 x, y; xunpack8(r[s], x, y); a += x; b += y; }
    f[0] = a[0]; f[1] = a[1]; f[2] = a[2]; f[3] = a[3]; f[4] = b[0]; f[5] = b[1]; f[6] = b[2]; f[7] = b[3];
}
__device__ __forceinline__ void acc8m(float (&s)[8], const u32x4 w, float m) {
    s[0] += m * bf_lo(w.x); s[1] += m * bf_hi(w.x); s[2] += m * bf_lo(w.y); s[3] += m * bf_hi(w.y); s[4] += m * bf_lo(w.z); s[5] += m * bf_hi(w.z); s[6] += m * bf_lo(w.w); s[7] += m * bf_hi(w.w);
}
__device__ __forceinline__ void up8(const u32x4 w, float (&f)[8]) { f[0] = bf_lo(w.x); f[1] = bf_hi(w.x); f[2] = bf_lo(w.y); f[3] = bf_hi(w.y); f[4] = bf_lo(w.z); f[5] = bf_hi(w.z); f[6] = bf_lo(w.w); f[7] = bf_hi(w.w); }
__device__ __forceinline__ void mixer_ctx_token(const bf16_t* __restrict__ ZS, const float* __restrict__ convw, bf16_t* __restrict__ CAT, int tl, int ch) {
    constexpr int n = CTXL; const int t = SEQ + tl;
    float o[8], f[8];
    if (ch < 128) {
        const int c = 8 * ch, hw = 1 << (c >> 8); const int lo = (tl - hw) < 0 ? 0 : (tl - hw), hi = (tl + hw) > n ? n : (tl + hw);
        float s[8] = {0.f, 0.f, 0.f, 0.f, 0.f, 0.f, 0.f, 0.f};
#pragma unroll 1
        for (int qb = tl - hw; qb < tl + hw; qb += 4) {
            u32x4 rw[4][4];
#pragma unroll
            for (int j = 0; j < 4; ++j) { const int q = qb + j, qc = q < 0 ? 0 : (q > n - 1 ? n - 1 : q); ld4s_raw(ZS, qc, c, rw[j]); }
#pragma unroll
            for (int j = 0; j < 4; ++j) { const int q = qb + j; const float m = (q >= 0 && q < n && q < tl + hw) ? 1.f : 0.f; float fa[8]; sum4s(rw[j], fa);
#pragma unroll
                for (int e = 0; e < 8; ++e) s[e] += m * fa[e]; }
        }
        { u32x4 rw[4]; ld4s_raw(ZS, tl, c, rw); sum4s(rw, f); }
        const float ic = 1.f / (float)(hi - lo);
#pragma unroll
        for (int e = 0; e < 8; ++e) o[e] = s[e] * ic - f[e];
        *(u32x4*)(CAT + (size_t)t * DM + c) = pack8((f32x4){o[0], o[1], o[2], o[3]}, (f32x4){o[4], o[5], o[6], o[7]});
    } else {
        const int c = 8 * (ch - 128); float cv[8] = {0.f, 0.f, 0.f, 0.f, 0.f, 0.f, 0.f, 0.f};
        u32x4 rg[3][4], rv[3][4], rf[4];
#pragma unroll
        for (int k = 0; k < 3; ++k) { const int q = tl + k - 1, qc = q < 0 ? 0 : (q > n - 1 ? n - 1 : q); ld4s_raw(ZS, qc, 2048 + c, rg[k]); ld4s_raw(ZS, qc, 3072 + c, rv[k]); }
        ld4s_raw(ZS, tl, 1024 + c, rf);
#pragma unroll
        for (int k = 0; k < 3; ++k) { const int q = tl + k - 1; const float m = (q >= 0 && q < n) ? 1.f : 0.f; float g[8], v[8]; sum4s(rg[k], g); sum4s(rv[k], v);
            const f32x4 w0 = *(const f32x4*)(convw + k * 1024 + c), w1 = *(const f32x4*)(convw + k * 1024 + c + 4);
#pragma unroll
            for (int e = 0; e < 4; ++e) { cv[e] += m * g[e] * v[e] * w0[e]; cv[4 + e] += m * g[4 + e] * v[4 + e] * w1[e]; } }
        sum4s(rf, f);
#pragma unroll
        for (int e = 0; e < 8; ++e) o[e] = f[e] * cv[e];
        *(u32x4*)(CAT + (size_t)t * DM + 1024 + c) = pack8((f32x4){o[0], o[1], o[2], o[3]}, (f32x4){o[4], o[5], o[6], o[7]});
    }
}
__device__ __forceinline__ void mixer_run16(const bf16_t* __restrict__ Z, const float* __restrict__ convw, bf16_t* __restrict__ CAT, int t0, int ch) {
    if (ch < 128) {
        const int c = 8 * ch, hw = 1 << (c >> 8);
        const bf16_t* Zc = Z + c;
        float s[8] = {0.f, 0.f, 0.f, 0.f, 0.f, 0.f, 0.f, 0.f};
#pragma unroll 1
        for (int qb = t0 - hw; qb < t0 + hw; qb += 4) {
            u32x4 w[4];
#pragma unroll
            for (int j = 0; j < 4; ++j) { const int q = qb + j, qc = q < 0 ? 0 : (q > SEQ - 1 ? SEQ - 1 : q); w[j] = *(const u32x4*)(Zc + (size_t)qc * EVEN_IN); }
#pragma unroll
            for (int j = 0; j < 4; ++j) { const int q = qb + j; acc8m(s, w[j], (q >= 0 && q < SEQ && q < t0 + hw) ? 1.f : 0.f); }
        }
#pragma unroll 1
        for (int i0 = 0; i0 < 16; i0 += 4) {
            u32x4 wc[4], wp[4], wm[4];
#pragma unroll
            for (int i = 0; i < 4; ++i) { const int t = t0 + i0 + i, tp = (t + hw) > SEQ - 1 ? SEQ - 1 : (t + hw), tm = (t - hw) < 0 ? 0 : (t - hw);
                wc[i] = *(const u32x4*)(Zc + (size_t)t * EVEN_IN); wp[i] = *(const u32x4*)(Zc + (size_t)tp * EVEN_IN); wm[i] = *(const u32x4*)(Zc + (size_t)tm * EVEN_IN); }
#pragma unroll
            for (int i = 0; i < 4; ++i) { const int t = t0 + i0 + i; const int lo = (t - hw) < 0 ? 0 : (t - hw), hi = (t + hw) > SEQ ? SEQ : (t + hw);
                const float ic = 1.f / (float)(hi - lo); float f[8], o[8]; up8(wc[i], f);
#pragma unroll
                for (int e = 0; e < 8; ++e) o[e] = s[e] * ic - f[e];
                *(u32x4*)(CAT + (size_t)t * DM + c) = pack8((f32x4){o[0], o[1], o[2], o[3]}, (f32x4){o[4], o[5], o[6], o[7]});
                acc8m(s, wp[i], (t + hw < SEQ) ? 1.f : 0.f); acc8m(s, wm[i], (t - hw >= 0) ? -1.f : 0.f); }
        }
    } else {
        const int c = 8 * (ch - 128); const bf16_t* Zb = Z + 1024 + c; const bf16_t* Zg = Z + 2048 + c; const bf16_t* Zv = Z + 3072 + c;
        float up[8], uc[8], w0[8], w1[8], w2[8];
#pragma unroll
        for (int e = 0; e < 8; ++e) { w0[e] = convw[c + e]; w1[e] = convw[1024 + c + e]; w2[e] = convw[2048 + c + e]; }
        { const int tq = t0 > 0 ? t0 - 1 : 0; const float m = t0 > 0 ? 1.f : 0.f;
          const u32x4 a = *(const u32x4*)(Zg + (size_t)tq * EVEN_IN), b = *(const u32x4*)(Zv + (size_t)tq * EVEN_IN), a2 = *(const u32x4*)(Zg + (size_t)t0 * EVEN_IN), b2 = *(const u32x4*)(Zv + (size_t)t0 * EVEN_IN);
          float x[8], y[8]; up8(a, x); up8(b, y);
#pragma unroll
          for (int e = 0; e < 8; ++e) up[e] = m * x[e] * y[e];
          up8(a2, x); up8(b2, y);
#pragma unroll
          for (int e = 0; e < 8; ++e) uc[e] = x[e] * y[e]; }
#pragma unroll 1
        for (int i0 = 0; i0 < 16; i0 += 4) {
            u32x4 g[4], v[4], fb[4];
#pragma unroll
            for (int i = 0; i < 4; ++i) { const int t = t0 + i0 + i, tn = (t + 1) > SEQ - 1 ? SEQ - 1 : (t + 1);
                g[i] = *(const u32x4*)(Zg + (size_t)tn * EVEN_IN); v[i] = *(const u32x4*)(Zv + (size_t)tn * EVEN_IN); fb[i] = *(const u32x4*)(Zb + (size_t)t * EVEN_IN); }
#pragma unroll
            for (int i = 0; i < 4; ++i) { const int t = t0 + i0 + i; const float m = (t + 1 < SEQ) ? 1.f : 0.f; float x[8], y[8], f[8], o[8]; up8(g[i], x); up8(v[i], y); up8(fb[i], f);
#pragma unroll
                for (int e = 0; e < 8; ++e) { const float un = m * x[e] * y[e]; o[e] = f[e] * (up[e] * w0[e] + uc[e] * w1[e] + un * w2[e]); up[e] = uc[e]; uc[e] = un; }
                *(u32x4*)(CAT + (size_t)t * DM + 1024 + c) = pack8((f32x4){o[0], o[1], o[2], o[3]}, (f32x4){o[4], o[5], o[6], o[7]}); }
        }
    }
}
__device__ __forceinline__ void mixer_phase(const bf16_t* Z, const bf16_t* ZS, const float* convw, bf16_t* CAT, int wg, int nwg, int tid) {
    const int ch = tid & 255, tsub = tid >> 8;
    for (int blk = wg; blk < SEQ / 32; blk += nwg) {
        mixer_run16(Z, convw, CAT, blk * 32 + 16 * tsub, ch);
        if (tsub == 0) mixer_ctx_token(ZS, convw, CAT, blk, ch);
    }
}

template <class Epi, class Sched>
__device__ __forceinline__ void run_gemm(LAS unsigned char* lds, const pg8::Gemm g, const Sched& S, const Epi& E) {
#if MK_SIMPLE_GEMM
    pg8::gemm_simple<Epi, Sched>(g, S, E);
#else
    pg8::gemm_phase<Epi, Sched, true, true>(lds, g, S, E);
#endif
}
constexpr int N_PHASES = 1 + 8 * DEPTH + 1;

__global__ void __launch_bounds__(NWAVES * 64, 2) mk_fwd(Args args) {
    extern __shared__ __attribute__((aligned(16))) unsigned char lds_raw[];
    LAS unsigned char* lds = (LAS unsigned char*)lds_raw;
    volatile LAS unsigned* MISC = (volatile LAS unsigned*)(lds + MISC_OFF);
    const int G = gridDim.x, NGW = G * NWAVES;
    for (int u = threadIdx.x; u < (LDS_BYTES - RING_BYTES) / 4; u += NWAVES * 64) ((LAS unsigned*)(lds + RING_BYTES))[u] = 0u;
    __syncthreads();
#if MK_ONE_LAUNCH
    XcdBarrier bar = xcd_barrier_post((unsigned*)(KARG(unsigned char*, 200) + WS_CTL) + 4096, MISC + 8);
#define GRID_BAR() xcd_barrier_ni(bar.bar, bar.x, bar.st)
#else
#define GRID_BAR() do {} while (0)
#endif
#if MK_ONE_LAUNCH
    constexpr int lo = 0, hi = N_PHASES;
#else
    const int lo = KARG(int, 208), hi = KARG(int, 212);
#endif
#define IN(k) (lo <= (k) && (k) < hi)
#ifndef PH_MASK
#define PH_MASK 0xffffffffu
#endif
#define PH_ON(b) ((PH_MASK >> (b)) & 1u)
#define SEAM(k) do { if ((k) + 1 < hi) GRID_BAR(); } while (0)
#define WSP() unsigned char* ws = KARG(unsigned char*, 200); const int tid = otid(), lane = tid & 63, wave = __builtin_amdgcn_readfirstlane(tid >> 6), bx = obid(), gw = bx * NWAVES + wave; (void)lane; (void)gw
#define MODL(l) ((const float*)(ws + WS_MOD) + (size_t)((l) * 2 + 0) * 6 * DM)
#define MODC(l) ((const float*)(ws + WS_MOD) + (size_t)((l) * 2 + 1) * 6 * DM)

    if (PH_ON(0) && IN(0)) { WSP(); prologue(ws, lds, gw, NGW, wave, lane, (G == 256) ? 26 : NTJOBS); SEAM(0); }

#pragma unroll 1
    for (int l = 0; l < DEPTH; ++l) {
        const int pb = 1 + 8 * l, i2 = l >> 1; const bool lastl = (l == DEPTH - 1);
        if (IN(pb + 0)) {
            WSP();
            const int nf = ((l & 1) == 0 && PH_ON(2) && G > 64) ? 32 : 0;
            if (PH_ON(1) && bx >= nf) { bf16_t* X = (bf16_t*)(ws + WS_X); const int gwn = gw - nf * NWAVES, NGWn = NGW - nf * NWAVES, bxn = bx - nf, Gn = G - nf;
              if (l == 0) norm_mod_phase(INP(0), INP(0), INP(6) + l * DM, MODL(l), MODC(l), 0, (bf16_t*)(ws + WS_H), gwn, NGWn, lane, SEQ);
              else norm_mod_phase16(X, INP(6) + l * DM, MODL(l), 0, (bf16_t*)(ws + WS_H), gwn, NGWn, lane);
              if (l == 0) ctx_norm_phase<0>(INP(2), X + (size_t)SEQ * DM, X + (size_t)SEQ * DM, (const bf16_t*)(ws + WS_SLAB), nullptr, INP(6) + l * DM, MODC(l), 0, (bf16_t*)(ws + WS_H) + (size_t)SEQ * DM, (LAS float*)(lds + MISC_OFF + 64), bxn, Gn, tid);
              else ctx_norm_phase<11>(nullptr, X + (size_t)SEQ * DM, X + (size_t)SEQ * DM, (const bf16_t*)(ws + WS_SLAB), MODC(l - 1) + 5 * DM, INP(6) + l * DM, MODC(l), 0, (bf16_t*)(ws + WS_H) + (size_t)SEQ * DM, (LAS float*)(lds + MISC_OFF + 64), bxn, Gn, tid); }
            if (PH_ON(2) && (l & 1) == 0) {
                pg8::Gemm g{(const bf16_t*)(ws + WS_POOLT) + (size_t)i2 * 4 * 65536, (const bf16_t*)(ws + WS_WINB) + (size_t)i2 * DM * 1024, 256, 1024, 4};
                pg8::FoldOrder S{bx}; EpiBf16 E{(bf16_t*)(ws + WS_WIN) + (size_t)i2 * EVEN_IN * DM, DM, INP(10) + i2 * 1024};
                pg8::gemm_simple<EpiBf16, pg8::FoldOrder>(g, S, E);
            }
            SEAM(pb + 0);
        }
        if ((l & 1) == 0) {
            if (PH_ON(3) && IN(pb + 1)) { WSP(); pg8::Gemm g{(const bf16_t*)(ws + WS_H), (const bf16_t*)(ws + WS_WIN) + (size_t)i2 * EVEN_IN * DM, DM, DM, DM / 64};
                pg8::LatCtxOrder S; S.so.init(SEQ / 256, EVEN_IN / 256, G, bx, DM / 64); S.ntn = EVEN_IN / 256; S.nsl = 4 * (EVEN_IN / 256); S.kchunk = DM / 4;
                EpiWithSlab<EpiBf16> E{{(bf16_t*)(ws + WS_Z), EVEN_IN, nullptr}, (bf16_t*)(ws + WS_SLAB), EVEN_IN};
                run_gemm(lds, g, S, E);
                if (G == 256 && bx >= 64) { if (l == 0) deferred_convert(ws, lds, 0, 11264, 14336, bx - 64, 16, wave, lane); else deferred_convert(ws, lds, 2, 10752, 13824, bx - 64, 16, wave, lane); }
                SEAM(pb + 1); }
            if (PH_ON(4) && IN(pb + 2)) { WSP(); mixer_phase((const bf16_t*)(ws + WS_Z), (const bf16_t*)(ws + WS_SLAB), INP(11) + (size_t)i2 * 3 * 1024, (bf16_t*)(ws + WS_CAT), bx, G, tid); SEAM(pb + 2); }
            if (PH_ON(5) && IN(pb + 3)) { WSP(); bf16_t* X = (bf16_t*)(ws + WS_X); const float* xl = (l == 0) ? INP(0) : nullptr;
                pg8::Gemm g{(const bf16_t*)(ws + WS_CAT), (const bf16_t*)(ws + WS_WOUT) + (size_t)i2 * DM * DM, DM, DM, DM / 64};
                pg8::LatCtxOrder S; S.so.init(SEQ / 256, DM / 256, G, bx, DM / 64); S.ntn = DM / 256; S.nsl = 8 * (DM / 256); S.kchunk = DM / 8;
                EpiWithSlab<EpiResid> E{{xl, X, X, MODL(l) + 2 * DM}, (bf16_t*)(ws + WS_SLAB), DM}; run_gemm(lds, g, S, E);
                if (G == 256 && bx >= 64) { if (l == 0) deferred_convert(ws, lds, 0, 14336, 16896, bx - 64, 14, wave, lane); else deferred_convert(ws, lds, 2, 13824, 16896, bx - 64, 16, wave, lane); }
                SEAM(pb + 3); }
        } else {
            if (PH_ON(6) && IN(pb + 1)) { WSP(); pg8::Gemm g{(const bf16_t*)(ws + WS_H), (const bf16_t*)(ws + WS_WDQKV) + (size_t)i2 * NDQKV * DM, DM, DM, DM / 64}; pg8::StaticOrder S; S.init(NPANEL, NDQKV / 256, G, bx, DM / 64);
                EpiDQKV E{(bf16_t*)(ws + WS_QA), (bf16_t*)(ws + WS_CKV), (bf16_t*)(ws + WS_KR), (float*)(ws + WS_SSQ), (float*)(ws + WS_SSKV), (const float*)(ws + WS_TAB)}; run_gemm(lds, g, S, E);
                if (G == 256 && bx >= 165) deferred_convert(ws, lds, l, 10752, 16896, bx - 165, 68, wave, lane);
                SEAM(pb + 1); }
            if (IN(pb + 2)) {
                if (PH_ON(7)) { WSP(); pg8::Gemm g{(const bf16_t*)(ws + WS_QA), (const bf16_t*)(ws + WS_WUQ) + (size_t)i2 * NQ * QLORA, QLORA, QLORA, QLORA / 64}; pg8::StaticOrder S; S.init(lastl ? SEQ / 256 : NPANEL, NQ / 256, G, bx, QLORA / 64);
                  EpiUQ E{(bf16_t*)(ws + WS_Q), (const float*)(ws + WS_SSQ), (const float*)(ws + WS_TAB)}; run_gemm(lds, g, S, E); }
                if (PH_ON(8)) { WSP(); pg8::Gemm g{(const bf16_t*)(ws + WS_CKV), (const bf16_t*)(ws + WS_WUKV) + (size_t)i2 * NKV * KVLORA, KVLORA, KVLORA, KVLORA / 64}; pg8::StaticOrder S; S.init(NPANEL, NKV / 256, G, G - 1 - bx, KVLORA / 64);
                  EpiUKV E{(bf16_t*)(ws + WS_KN), (bf16_t*)(ws + WS_V), (const float*)(ws + WS_SSKV)}; run_gemm(lds, g, S, E); }
                SEAM(pb + 2); }
            if (PH_ON(9) && IN(pb + 3)) {
                WSP(); LAS float* wsf = (LAS float*)(lds) + wave * 64; (void)wsf;
                const bf16_t* Qb = (const bf16_t*)(ws + WS_Q); const bf16_t* KN = (const bf16_t*)(ws + WS_KN); const bf16_t* KR = (const bf16_t*)(ws + WS_KR); const bf16_t* Vb = (const bf16_t*)(ws + WS_V); bf16_t* CAT = (bf16_t*)(ws + WS_CAT);
                const int nunits = 2 * 256 + (lastl ? 0 : NHEAD);
#pragma unroll 1
                for (int uid = bx; uid < nunits; uid += G) {
#if MK_SIMPLE_ATTN
                    if (uid < 512) att::unit_simple(Qb, KN, KR, Vb, CAT, (uid & 7) + 8 * (uid >> 8), ((uid >> 3) & 31) * 256, 0, R, wsf);
                    else att::unit_simple(Qb, KN, KR, Vb, CAT, uid - 512, SEQ, SEQ, CTXL, wsf);
#else
                    if (uid < 512) att::unit_il(Qb, KN, KR, Vb, CAT, (uid & 7) + 8 * (uid >> 8), ((uid >> 3) & 31) * 256, 0, R, lds);
                    else att::unit_il(Qb, KN, KR, Vb, CAT, uid - 512, SEQ, SEQ, CTXL, lds);
#endif
                }
                SEAM(pb + 3); }
            if (PH_ON(10) && IN(pb + 4)) { WSP(); bf16_t* X = (bf16_t*)(ws + WS_X); pg8::Gemm g{(const bf16_t*)(ws + WS_CAT), (const bf16_t*)(ws + WS_WO) + (size_t)i2 * DM * DM, DM, DM, DM / 64};
                pg8::LatCtxOrder S; S.so.init(SEQ / 256, DM / 256, G, bx, DM / 64); S.ntn = DM / 256; S.nsl = lastl ? 0 : 8 * (DM / 256); S.kchunk = DM / 8;
                EpiWithSlab<EpiResid> E{{nullptr, X, X, MODL(l) + 2 * DM}, (bf16_t*)(ws + WS_SLAB), DM}; run_gemm(lds, g, S, E); SEAM(pb + 4); }
        }
        const int fb = pb + ((l & 1) ? 5 : 4);
        if (PH_ON(11) && IN(fb)) { WSP(); bf16_t* X = (bf16_t*)(ws + WS_X); norm_mod_phase16(X, INP(7) + l * DM, MODL(l), 1, (bf16_t*)(ws + WS_H), gw, NGW, lane);
            if (!lastl) ctx_norm_phase<8>((l == 0) ? INP(2) : nullptr, X + (size_t)SEQ * DM, X + (size_t)SEQ * DM, (const bf16_t*)(ws + WS_SLAB), MODC(l) + 2 * DM, INP(7) + l * DM, MODC(l), 1,
                                          (bf16_t*)(ws + WS_H) + (size_t)SEQ * DM, (LAS float*)(lds + MISC_OFF + 64), bx, G, tid);
            SEAM(fb); }
        if (PH_ON(12) && IN(fb + 1)) { WSP(); pg8::Gemm g{(const bf16_t*)(ws + WS_H), (const bf16_t*)(ws + WS_WGU) + (size_t)l * 2 * FF * DM, DM, DM, DM / 64}; pg8::StaticOrder S; S.init(lastl ? SEQ / 256 : NPANEL, 2 * FF / 256, G, bx, DM / 64); EpiSwiGLU E{(bf16_t*)(ws + WS_ACT)};
            run_gemm(lds, g, S, E);
            if (G == 256 && !lastl && bx >= 172) deferred_convert(ws, lds, l + 1, 0, 6720, bx - 172, 80, wave, lane);
            SEAM(fb + 1); }
        if (PH_ON(13) && IN(fb + 2)) { WSP(); bf16_t* X = (bf16_t*)(ws + WS_X); pg8::Gemm g{(const bf16_t*)(ws + WS_ACT), (const bf16_t*)(ws + WS_WDN) + (size_t)l * DM * FF, FF, FF, FF / 64};
            pg8::LatCtxOrder S; S.so.init(SEQ / 256, DM / 256, G, bx, FF / 64); S.ntn = DM / 256; S.nsl = lastl ? 0 : 11 * (DM / 256); S.kchunk = FF / 11;
            EpiWithSlab<EpiResid> E{{nullptr, X, X, MODL(l) + 5 * DM}, (bf16_t*)(ws + WS_SLAB), DM}; run_gemm(lds, g, S, E);
            if (G == 256 && !lastl && bx >= 88) deferred_convert(ws, lds, l + 1, 6720, 10752, bx - 88, 24, wave, lane);
            SEAM(fb + 2); }
    }
    if (PH_ON(14) && IN(N_PHASES - 1)) { WSP(); final_norm_phase((const bf16_t*)(ws + WS_X), INP(23), KARG(float*, 192), gw, NGW, lane); }
#undef IN
#undef SEAM
}

extern "C" void kernel_launch(void* const* d_in, const int* in_sizes, int n_in, void* d_out, int out_size, void* d_ws, size_t ws_size, hipStream_t stream) {
    static int grid = 0;
    if (grid == 0) {
        if (n_in != 24 || in_sizes[0] != SEQ * DM || out_size != SEQ * DM || ws_size < WS_END) { fprintf(stderr, "kernel_launch: unexpected shapes (n_in %d, in0 %d, out %d, ws %zu < %zu)\n", n_in, n_in > 0 ? in_sizes[0] : -1, out_size, ws_size, (size_t)WS_END); grid = -1; return; }
        int dev = 0, cus = 0, per_cu = 0;
        if (hipGetDevice(&dev) != hipSuccess || hipDeviceGetAttribute(&cus, hipDeviceAttributeMultiprocessorCount, dev) != hipSuccess) { grid = -1; return; }
        if (hipFuncSetAttribute((const void*)mk_fwd, hipFuncAttributeMaxDynamicSharedMemorySize, LDS_BYTES) != hipSuccess) { fprintf(stderr, "kernel_launch: hipFuncSetAttribute failed\n"); grid = -1; return; }
        if (hipOccupancyMaxActiveBlocksPerMultiprocessor(&per_cu, (const void*)mk_fwd, NWAVES * 64, LDS_BYTES) != hipSuccess || per_cu < 1) fprintf(stderr, "kernel_launch: occupancy query says %d\n", per_cu);
        (void)hipGetLastError();
        grid = cus;
    }
    if (grid < 0) return;
    (void)hipMemsetAsync((char*)d_ws, 0, 32768, stream);
    Args a{};
    for (int i = 0; i < 24; ++i) a.in[i] = (const float*)d_in[i];
    a.out = (float*)d_out; a.ws = (unsigned char*)d_ws;
#if MK_ONE_LAUNCH
    a.ph_lo = 0; a.ph_hi = N_PHASES;
    hipLaunchKernelGGL(mk_fwd, dim3(grid), dim3(NWAVES * 64), LDS_BYTES, stream, a);
#else
    for (int k = 0; k < N_PHASES; ++k) {
        if (k >= 1 && k < N_PHASES - 1) { const int l = (k - 1) / 8, s = (k - 1) % 8; if ((l & 1) == 0 && s == 7) continue; }
        a.ph_lo = k; a.ph_hi = k + 1;
        hipLaunchKernelGGL(mk_fwd, dim3(grid), dim3(NWAVES * 64), LDS_BYTES, stream, a);
    }
#endif
    const hipError_t le = hipPeekAtLastError();
    if (le != hipSuccess) fprintf(stderr, "kernel_launch: launch failed: %s\n", hipGetErrorName(le));
}
```

```cpp
#include <hip/hip_runtime.h>
#include <cstdio>
#include <cstdint>

#ifndef MK_ONE_LAUNCH
#define MK_ONE_LAUNCH 1
#endif
#ifndef MK_SIMPLE_ATTN
#define MK_SIMPLE_ATTN 0
#endif
#ifndef MK_SIMPLE_GEMM
#define MK_SIMPLE_GEMM 0
#endif

#define LAS __attribute__((address_space(3)))
#define GAS __attribute__((address_space(1)))
typedef unsigned short bf16_t;
typedef short bf16x8 __attribute__((ext_vector_type(8)));
typedef float f32x4 __attribute__((ext_vector_type(4)));
typedef float f32x2 __attribute__((ext_vector_type(2)));
typedef float f32x16 __attribute__((ext_vector_type(16)));
typedef unsigned u32x4 __attribute__((ext_vector_type(4)));
typedef unsigned u32x2 __attribute__((ext_vector_type(2)));

constexpr int DM = 2048, SEQ = 8192, CTXL = 256, R = SEQ + CTXL, NPANEL = R / 256, DEPTH = 4;
constexpr int EVEN_IN = 4096, FF = 5632, QLORA = 512, KVLORA = 512, NHEAD = 16, QKN = 128, QKR = 64, VD = 128, QHD = QKN + QKR;
constexpr int NQ = NHEAD * QHD  , NKV = NHEAD * (QKN + VD)  , NDQKV = 1280  ;
constexpr float EPS = 1e-6f;
constexpr float QSCALE = 0.07216878364870322f * 1.4426950408889634f;

__device__ __forceinline__ unsigned cvt_pk_bf16(float lo, float hi) { unsigned r; asm volatile("v_cvt_pk_bf16_f32 %0, %1, %2" : "=v"(r) : "v"(lo), "v"(hi)); return r; }
__device__ __forceinline__ float bf_lo(unsigned w) { return __uint_as_float(w << 16); }
__device__ __forceinline__ float bf_hi(unsigned w) { return __uint_as_float(w & 0xffff0000u); }
template <int K> __device__ __forceinline__ float xor_add(float v) {
    if constexpr (K < 32) return v + __builtin_bit_cast(float, __builtin_amdgcn_ds_swizzle(__builtin_bit_cast(int, v), (K << 10) | 0x1F));
    else { auto rr = __builtin_amdgcn_permlane32_swap(__float_as_uint(v), __float_as_uint(v), false, false); return __uint_as_float(rr[0]) + __uint_as_float(rr[1]); }
}
__device__ __forceinline__ float wave_sum(float v) { v = xor_add<1>(v); v = xor_add<2>(v); v = xor_add<4>(v); v = xor_add<8>(v); v = xor_add<16>(v); return xor_add<32>(v); }

__device__ __forceinline__ int otid() { int t = threadIdx.x; asm volatile("" : "+v"(t)); return t; }
__device__ __forceinline__ int obid() { int b = blockIdx.x; asm volatile("" : "+s"(b)); return b; }
template <class T> __device__ __forceinline__ T karg_ld(int off) { const __attribute__((address_space(4))) char* k = (const __attribute__((address_space(4))) char*)__builtin_amdgcn_kernarg_segment_ptr(); asm volatile("" : "+s"(k)); return *(const __attribute__((address_space(4))) T*)(k + off); }
#define KARG(type, off) karg_ld<type>(off)
#define INP(k) KARG(const float*, 8 * (k))
namespace pg8 {
constexpr int BM = 256, BK = 64, HALF = 128, HTB = HALF * BK * 2, STAGE_BYTES = 8 * HTB, NXCD = 8, WGM = 8;
__host__ __device__ __forceinline__ int lds_byte(int r, int c) { const int st = (r >> 4) * 2 + (c >> 5), rr = r & 15, cc = c & 31, ob = rr * 64 + cc * 2; return st * 1024 + (ob ^ (((ob >> 9) & 1) << 5)); }
__host__ __device__ __forceinline__ void stage_rc(int b, int& Rr, int& C) { const int st = b / 1024, sb = b % 1024, swz = sb ^ (((sb >> 9) & 1) << 5); Rr = (st >> 1) * 16 + swz / 64; C = (st & 1) * 32 + (swz % 64) / 2; }
__host__ __device__ __forceinline__ int perm32(int rho) { const int n = rho >> 4, i = rho & 15; return 8 * (i >> 2) + 4 * n + (i & 3); }

struct Unit { int pm, pn, ka, kb, nt, aux; };
struct Gemm { const bf16_t* A; const bf16_t* Bt; int lda, ldb, nt; };

struct StaticOrder {
    int nM, nN, nwg, G, c, nt;
    __device__ void init(int nM_, int nN_, int G_, int c_, int nt_) { nM = nM_; nN = nN_; nwg = nM * nN; G = G_; c = c_; nt = nt_; }
    __device__ __forceinline__ bool next(int i, Unit& u) const {
        const long L = (long)i * G + c; if (L >= nwg) return false;
        int wgid = (int)L; { const int q = nwg / NXCD, r = nwg % NXCD, xcd = wgid % NXCD, off = wgid / NXCD; wgid = (xcd < r ? xcd * (q + 1) : r * (q + 1) + (xcd - r) * q) + off; }
        const int nig = WGM * nN, gid = wgid / nig, fm = gid * WGM, gsz = (nM - fm) < WGM ? (nM - fm) : WGM;
        u.pm = fm + ((wgid % nig) % gsz); u.pn = (wgid % nig) / gsz; u.ka = 0; u.kb = 0; u.nt = nt; u.aux = 0; return true;
    }
};
struct FoldOrder {
    int c;
    __device__ bool next(int i, Unit& u) const { if (i > 0 || c >= 32) return false; u.pm = c & 3; u.pn = c >> 2; u.ka = 0; u.kb = 256 * (c & 3); u.nt = 4; u.aux = 0; return true; }
};

struct LatCtxOrder {
    StaticOrder so; int ntn, nsl, kchunk;
    __device__ __forceinline__ bool next(int i, Unit& u) const {
        Unit a; a.pm = 0; a.pn = 0; a.ka = 0; a.kb = 0; a.nt = so.nt; a.aux = 0;
        const bool ok1 = so.next(i, a);
        const int nL = so.c < so.nwg ? (so.nwg - so.c + so.G - 1) / so.G : 0, s = so.c + (i - nL) * so.G;
        const bool ok2 = !ok1 && s >= 0 && s < nsl;
        const int sl = s / ntn, ko = sl * kchunk;
        u.pm = ok1 ? a.pm : 32; u.pn = ok1 ? a.pn : s - sl * ntn; u.aux = ok1 ? 0 : sl; u.ka = ok1 ? 0 : ko; u.kb = ok1 ? 0 : ko; u.nt = ok1 ? so.nt : kchunk / 64;
        return ok1 || ok2;
    }
};
typedef unsigned long long pg8_u64x2 __attribute__((ext_vector_type(2)));
__device__ __forceinline__ f32x4 zero4() { unsigned long long a, b; asm volatile("v_mov_b64 %0, 0" : "=v"(a)); asm volatile("v_mov_b64 %0, 0" : "=v"(b)); const pg8_u64x2 z = {a, b}; return __builtin_bit_cast(f32x4, z); }
__device__ __forceinline__ void pg8_glds(const char* sbase, unsigned voff, unsigned lds_dst) {
    asm volatile("s_mov_b32 m0, %2\n\ts_nop 0\n\tglobal_load_lds_dwordx4 %1, %0" :: "s"(sbase), "v"(voff), "s"(lds_dst) : "memory", "m0"); }
template <class Epi, class Sched>
__device__ __forceinline__ void gemm_simple(const Gemm g, const Sched& S, const Epi& E) {
    const int tid = otid(), wid = __builtin_amdgcn_readfirstlane(tid >> 6), lane = tid & 63, wr = wid >> 2, wc = wid & 3, fr = lane & 15, fq = lane >> 4;
    Unit u;
    for (int i = 0; S.next(i, u); ++i) {
        f32x4 acc[2][2][4][2];
#pragma unroll
        for (int a = 0; a < 2; ++a)
#pragma unroll
            for (int b = 0; b < 2; ++b)
#pragma unroll
                for (int m = 0; m < 4; ++m)
#pragma unroll
                    for (int n = 0; n < 2; ++n) acc[a][b][m][n] = (f32x4){0.f, 0.f, 0.f, 0.f};
        const bf16_t* A = g.A + (size_t)u.pm * 256 * g.lda + u.ka + (size_t)(64 * wr + fr) * g.lda + fq * 8;
        int rb[2];
#pragma unroll
        for (int n = 0; n < 2; ++n) { const int rho = 16 * n + fr; rb[n] = Epi::PERM ? perm32(rho) : rho; }
        const bf16_t* B = g.Bt + (size_t)u.pn * 256 * g.ldb + u.kb + (size_t)(32 * wc) * g.ldb + fq * 8;
        bf16x8 a[2][4], b[2][2], an[2][4], bn[2][2];
        const int kend = u.nt * 64;
#define GS_LOAD(DA, DB, KK) do { _Pragma("unroll") for (int ai = 0; ai < 2; ++ai) _Pragma("unroll") for (int m = 0; m < 4; ++m) DA[ai][m] = *(const bf16x8*)(A + (size_t)(128 * ai + 16 * m) * g.lda + (KK)); \
            _Pragma("unroll") for (int bj = 0; bj < 2; ++bj) _Pragma("unroll") for (int n = 0; n < 2; ++n) DB[bj][n] = *(const bf16x8*)(B + (size_t)(128 * bj + rb[n]) * g.ldb + (KK)); } while (0)
        GS_LOAD(a, b, 0);
#pragma unroll 1
        for (int kk = 0; kk < kend; kk += 32) {
            const int kn = (kk + 32 < kend) ? kk + 32 : kk;
            GS_LOAD(an, bn, kn);
#pragma unroll
            for (int ai = 0; ai < 2; ++ai)
#pragma unroll
                for (int bj = 0; bj < 2; ++bj)
#pragma unroll
                    for (int m = 0; m < 4; ++m)
#pragma unroll
                        for (int n = 0; n < 2; ++n) acc[ai][bj][m][n] = __builtin_amdgcn_mfma_f32_16x16x32_bf16(b[bj][n], a[ai][m], acc[ai][bj][m][n], 0, 0, 0);
#pragma unroll
            for (int ai = 0; ai < 2; ++ai)
#pragma unroll
                for (int m = 0; m < 4; ++m) a[ai][m] = an[ai][m];
#pragma unroll
            for (int bj = 0; bj < 2; ++bj)
#pragma unroll
                for (int n = 0; n < 2; ++n) b[bj][n] = bn[bj][n];
        }
#undef GS_LOAD
        E(acc, u, wr, wc, fr, fq);
    }
}

template <class Epi, class Sched, bool ALIGN_EPI = true, bool SP2 = true>
__device__ __forceinline__ void gemm_phase(LAS unsigned char* lds, const Gemm g, const Sched& S, const Epi& E) {
    const int tid = otid(), wid = __builtin_amdgcn_readfirstlane(tid >> 6), lane = tid & 63, wr = wid >> 2, wc = wid & 3, fr = lane & 15, fq = lane >> 4;
    unsigned voffA[2], voffB[2];
#pragma unroll
    for (int i = 0; i < 2; ++i) { int Rr, C; stage_rc(tid * 16 + i * 8192, Rr, C); const int Rb = Epi::PERM ? ((Rr & ~31) + perm32(Rr & 31)) : Rr;
        voffA[i] = (unsigned)(Rr * g.lda + C) * 2u; voffB[i] = (unsigned)(Rb * g.ldb + C) * 2u; }
    const size_t kstep = (size_t)(BK * 2);
    const size_t hstepA = (size_t)HALF * g.lda * 2, hstepB = (size_t)HALF * g.ldb * 2;
    const size_t tstepA = 2 * hstepA, tstepB = 2 * hstepB;
    const unsigned ldsw = (unsigned)wid * 1024u, lds0 = (unsigned)(uintptr_t)lds;
    const int aoff = lds_byte(wr * 64 + fr, fq * 8), boff = lds_byte(wc * 32 + fr, fq * 8);
#define PG8_SA(b, h) (((b) * 2 + (h)) * HTB)
#define PG8_SB(b, h) ((4 + (b) * 2 + (h)) * HTB)
#define PG8_STAGE(bufoff, gbase, voff) do { _Pragma("unroll") for (int _i = 0; _i < 2; ++_i) \
        pg8_glds((const char*)(gbase), (voff)[_i], (unsigned)__builtin_amdgcn_readfirstlane((int)(lds0 + (unsigned)(bufoff) + ldsw + (unsigned)(_i * 8192)))); } while (0)
#define PG8_LDA(dst, b, h) do { _Pragma("unroll") for (int m = 0; m < 4; ++m) _Pragma("unroll") for (int k = 0; k < 2; ++k) dst[m][k] = *(const LAS bf16x8*)(lds + PG8_SA(b, h) + aoff + m * 2048 + k * 1024); } while (0)
#define PG8_LDB(dst, b, h) do { _Pragma("unroll") for (int n = 0; n < 2; ++n) _Pragma("unroll") for (int k = 0; k < 2; ++k) dst[n][k] = *(const LAS bf16x8*)(lds + PG8_SB(b, h) + boff + n * 2048 + k * 1024); } while (0)
#define PG8_MMA(ai, bj, At, Bt) do { __builtin_amdgcn_s_setprio(1); _Pragma("unroll") for (int m = 0; m < 4; ++m) _Pragma("unroll") for (int n = 0; n < 2; ++n) _Pragma("unroll") for (int k = 0; k < 2; ++k) \
        acc[ai][bj][m][n] = __builtin_amdgcn_mfma_f32_16x16x32_bf16(Bt[n][k], At[m][k], acc[ai][bj][m][n], 0, 0, 0); __builtin_amdgcn_s_setprio(0); } while (0)
#define PG8_WAIT_V(n) asm volatile("s_waitcnt vmcnt(" #n ")" ::: "memory")
#define PG8_WAIT_L(n) asm volatile("s_waitcnt lgkmcnt(" #n ")" ::: "memory")
#define PG8_BAR __builtin_amdgcn_s_barrier()
#define PG8_SCHED __builtin_amdgcn_sched_barrier(0)
    Unit cur, nxt; int ui = 0;
    if (!S.next(0, cur)) return;
    f32x4 acc[2][2][4][2];
#pragma unroll
    for (int a = 0; a < 2; ++a)
#pragma unroll
        for (int b = 0; b < 2; ++b)
#pragma unroll
            for (int m = 0; m < 4; ++m)
#pragma unroll
                for (int n = 0; n < 2; ++n) acc[a][b][m][n] = zero4();
    bf16x8 At[4][2], B0[2][2], B1[2][2];
    const char* cA = (const char*)g.A + (size_t)cur.pm * tstepA + (size_t)cur.ka * 2; const char* cB = (const char*)g.Bt + (size_t)cur.pn * tstepB + (size_t)cur.kb * 2;
    if constexpr (SP2) {
        PG8_STAGE(PG8_SB(0, 0), cB, voffB); PG8_STAGE(PG8_SB(0, 1), cB + hstepB, voffB); PG8_STAGE(PG8_SA(0, 0), cA, voffA); PG8_STAGE(PG8_SA(0, 1), cA + hstepA, voffA);
        if (wr == 1) PG8_BAR;
        PG8_WAIT_V(2); PG8_BAR;
        PG8_STAGE(PG8_SB(1, 0), cB + kstep, voffB); PG8_STAGE(PG8_SA(1, 0), cA + kstep, voffA); PG8_STAGE(PG8_SB(1, 1), cB + hstepB + kstep, voffB);
        PG8_WAIT_V(6); PG8_BAR;
    } else {
        PG8_STAGE(PG8_SB(0, 0), cB, voffB); PG8_STAGE(PG8_SA(0, 0), cA, voffA); PG8_STAGE(PG8_SB(0, 1), cB + hstepB, voffB); PG8_STAGE(PG8_SA(0, 1), cA + hstepA, voffA);
        if (wr == 1) PG8_BAR;
        PG8_WAIT_V(4); PG8_BAR;
        PG8_STAGE(PG8_SB(1, 0), cB + kstep, voffB); PG8_STAGE(PG8_SA(1, 0), cA + kstep, voffA); PG8_STAGE(PG8_SB(1, 1), cB + hstepB + kstep, voffB);
        PG8_WAIT_V(6); PG8_BAR;
    }
    for (;;) {
        const bool has_next = S.next(ui + 1, nxt);
        const char* nA = has_next ? (const char*)g.A + (size_t)nxt.pm * tstepA + (size_t)nxt.ka * 2 : cA; const char* nB = has_next ? (const char*)g.Bt + (size_t)nxt.pn * tstepB + (size_t)nxt.kb * 2 : cB;
        const int nt = cur.nt;
        for (int t = 0; t < nt; t += 2) {
            const bool last = (t == nt - 2);
            const char* a1 = cA + (size_t)(t + 1) * kstep;
            const char* a2 = last ? nA : cA + (size_t)(t + 2) * kstep; const char* b2 = last ? nB : cB + (size_t)(t + 2) * kstep;
            const char* a3 = a2 + kstep; const char* b3 = b2 + kstep;
            if constexpr (SP2) {
            PG8_LDB(B0, 0, 0); PG8_LDB(B1, 0, 1); PG8_SCHED; PG8_LDA(At, 0, 0); PG8_STAGE(PG8_SA(1, 1), a1 + hstepA, voffA);
            PG8_WAIT_V(8); PG8_WAIT_L(0); PG8_BAR; PG8_MMA(0, 0, At, B0); PG8_MMA(0, 1, At, B1); PG8_BAR; PG8_SCHED;
            PG8_LDA(At, 0, 1); PG8_STAGE(PG8_SB(0, 0), b2, voffB); PG8_STAGE(PG8_SB(0, 1), b2 + hstepB, voffB); PG8_STAGE(PG8_SA(0, 0), a2, voffA);
            PG8_WAIT_V(8); PG8_WAIT_L(0); PG8_BAR; PG8_MMA(1, 0, At, B0); PG8_MMA(1, 1, At, B1); PG8_BAR; PG8_SCHED;
            PG8_LDB(B0, 1, 0); PG8_LDB(B1, 1, 1); PG8_SCHED; PG8_LDA(At, 1, 0); PG8_STAGE(PG8_SA(0, 1), a2 + hstepA, voffA);
            PG8_WAIT_V(8); PG8_WAIT_L(0); PG8_BAR; PG8_MMA(0, 0, At, B0); PG8_MMA(0, 1, At, B1); PG8_BAR; PG8_SCHED;
            PG8_LDA(At, 1, 1); PG8_STAGE(PG8_SB(1, 0), b3, voffB); PG8_STAGE(PG8_SB(1, 1), b3 + hstepB, voffB); PG8_STAGE(PG8_SA(1, 0), a3, voffA);
            PG8_WAIT_V(8); PG8_WAIT_L(0); PG8_BAR; PG8_MMA(1, 0, At, B0); PG8_MMA(1, 1, At, B1); PG8_BAR; PG8_SCHED;
            } else {
            PG8_LDB(B0, 0, 0); PG8_SCHED; PG8_LDA(At, 0, 0); PG8_STAGE(PG8_SA(1, 1), a1 + hstepA, voffA);
            PG8_WAIT_L(8); PG8_BAR; PG8_WAIT_L(0); PG8_MMA(0, 0, At, B0); PG8_BAR; PG8_SCHED;
            PG8_LDB(B1, 0, 1); PG8_STAGE(PG8_SB(0, 0), b2, voffB);
            PG8_BAR; PG8_WAIT_L(0); PG8_MMA(0, 1, At, B1); PG8_BAR;
            PG8_LDA(At, 0, 1); PG8_STAGE(PG8_SA(0, 0), a2, voffA);
            PG8_BAR; PG8_WAIT_L(0); PG8_MMA(1, 0, At, B0); PG8_BAR; PG8_SCHED;
            PG8_STAGE(PG8_SB(0, 1), b2 + hstepB, voffB);
            PG8_WAIT_V(6); PG8_BAR; PG8_MMA(1, 1, At, B1); PG8_BAR;
            PG8_LDB(B0, 1, 0); PG8_SCHED; PG8_LDA(At, 1, 0); PG8_STAGE(PG8_SA(0, 1), a2 + hstepA, voffA);
            PG8_WAIT_L(8); PG8_BAR; PG8_WAIT_L(0); PG8_MMA(0, 0, At, B0); PG8_BAR; PG8_SCHED;
            PG8_LDB(B1, 1, 1); PG8_STAGE(PG8_SB(1, 0), b3, voffB);
            PG8_BAR; PG8_WAIT_L(0); PG8_MMA(0, 1, At, B1); PG8_BAR;
            PG8_LDA(At, 1, 1); PG8_STAGE(PG8_SA(1, 0), a3, voffA);
            PG8_BAR; PG8_WAIT_L(0); PG8_MMA(1, 0, At, B0); PG8_BAR; PG8_SCHED;
            PG8_STAGE(PG8_SB(1, 1), b3 + hstepB, voffB);
            PG8_WAIT_V(6); PG8_BAR; PG8_MMA(1, 1, At, B1); PG8_BAR;
            }
        }
        if constexpr (ALIGN_EPI) { if (wr == 0) PG8_BAR; }
        E(acc, cur, wr, wc, fr, fq);
        if (!has_next) break;
#pragma unroll
        for (int a = 0; a < 2; ++a)
#pragma unroll
            for (int b = 0; b < 2; ++b)
#pragma unroll
                for (int m = 0; m < 4; ++m)
#pragma unroll
                    for (int n = 0; n < 2; ++n) acc[a][b][m][n] = zero4();
        cur = nxt; cA = nA; cB = nB; ++ui;
        if constexpr (ALIGN_EPI) { if (wr == 1) PG8_BAR; }
    }
    PG8_WAIT_V(0);
    if constexpr (!ALIGN_EPI) { if (wr == 0) PG8_BAR; }
    PG8_BAR;
#undef PG8_SA
#undef PG8_SB
#undef PG8_STAGE
#undef PG8_LDA
#undef PG8_LDB
#undef PG8_MMA
#undef PG8_WAIT_V
#undef PG8_WAIT_L
#undef PG8_BAR
#undef PG8_SCHED
}
}

typedef f32x4 Acc[2][2][4][2];
__device__ __forceinline__ u32x4 pack8(f32x4 v0, f32x4 v1) { u32x4 w; w.x = cvt_pk_bf16(v0[0], v0[1]); w.y = cvt_pk_bf16(v0[2], v0[3]); w.z = cvt_pk_bf16(v1[0], v1[1]); w.w = cvt_pk_bf16(v1[2], v1[3]); return w; }

struct EpiBf16 {
    static constexpr bool PERM = true;
    bf16_t* O; int ldc; const float* rs;
    __device__ __forceinline__ void operator()(const Acc& acc, const pg8::Unit& u, int wr, int wc, int fr, int fq) const {
        const int row0 = u.pm * 256 + wr * 64 + fr, col0 = u.pn * 256 + wc * 32 + 8 * fq;
        float sv[2][4];
#pragma unroll
        for (int ai = 0; ai < 2; ++ai)
#pragma unroll
            for (int m = 0; m < 4; ++m) sv[ai][m] = rs ? rs[row0 + ai * 128 + m * 16] : 1.f;
#pragma unroll
        for (int ai = 0; ai < 2; ++ai)
#pragma unroll
            for (int m = 0; m < 4; ++m) { const int row = row0 + ai * 128 + m * 16; const float s = sv[ai][m]; bf16_t* rowp = O + (size_t)row * ldc + col0;
#pragma unroll
                for (int bj = 0; bj < 2; ++bj) *(u32x4*)(rowp + bj * 128) = pack8(acc[ai][bj][m][0] * s, acc[ai][bj][m][1] * s); }
    }
};
typedef _Float16 h2_t __attribute__((ext_vector_type(2)));
__device__ __forceinline__ unsigned xpk(float lo, float hi) { const f32x2 v = {lo, hi}; const h2_t h = __builtin_convertvector(v, h2_t); return __builtin_bit_cast(unsigned, h); }
__device__ __forceinline__ f32x2 xun(unsigned w) { return __builtin_convertvector(__builtin_bit_cast(h2_t, w), f32x2); }
__device__ __forceinline__ u32x4 xpack8(f32x4 a, f32x4 b) { u32x4 w; w.x = xpk(a[0], a[1]); w.y = xpk(a[2], a[3]); w.z = xpk(b[0], b[1]); w.w = xpk(b[2], b[3]); return w; }
__device__ __forceinline__ void xunpack8(const u32x4 w, f32x4& a, f32x4& b) { const f32x2 p = xun(w.x), q = xun(w.y), r = xun(w.z), s = xun(w.w); a = (f32x4){p[0], p[1], q[0], q[1]}; b = (f32x4){r[0], r[1], s[0], s[1]}; }
__device__ __forceinline__ void unpack8(const u32x4 w, f32x4& a, f32x4& b) { a = (f32x4){bf_lo(w.x), bf_hi(w.x), bf_lo(w.y), bf_hi(w.y)}; b = (f32x4){bf_lo(w.z), bf_hi(w.z), bf_lo(w.w), bf_hi(w.w)}; }
struct EpiResid {
    static constexpr bool PERM = true;
    const float* base32; const bf16_t* base16; bf16_t* out; const float* gate;
    __device__ __forceinline__ void operator()(const Acc& acc, const pg8::Unit& u, int wr, int wc, int fr, int fq) const {
        const int row0 = u.pm * 256 + wr * 64 + fr, col0 = u.pn * 256 + wc * 32 + 8 * fq;
        f32x4 gv[2][2];
#pragma unroll
        for (int bj = 0; bj < 2; ++bj)
#pragma unroll
            for (int n = 0; n < 2; ++n) gv[bj][n] = *(const f32x4*)(gate + col0 + bj * 128 + n * 4);
#pragma unroll
        for (int ai = 0; ai < 2; ++ai) {
            if (base32) {
#pragma unroll
                for (int mh = 0; mh < 4; mh += 2) { f32x4 xf[2][2][2];
#pragma unroll
                    for (int m = 0; m < 2; ++m)
#pragma unroll
                        for (int bj = 0; bj < 2; ++bj) { const float* p = base32 + (size_t)(row0 + ai * 128 + (mh + m) * 16) * DM + col0 + bj * 128; xf[m][bj][0] = __builtin_nontemporal_load((const f32x4*)p); xf[m][bj][1] = __builtin_nontemporal_load((const f32x4*)(p + 4)); }
#pragma unroll
                    for (int m = 0; m < 2; ++m) { const size_t off = (size_t)(row0 + ai * 128 + (mh + m) * 16) * DM + col0;
#pragma unroll
                        for (int bj = 0; bj < 2; ++bj) *(u32x4*)(out + off + bj * 128) = xpack8(xf[m][bj][0] + gv[bj][0] * acc[ai][bj][mh + m][0], xf[m][bj][1] + gv[bj][1] * acc[ai][bj][mh + m][1]); }
                    asm volatile("" ::: "memory"); }
            } else {
                u32x4 xb[4][2];
#pragma unroll
                for (int m = 0; m < 4; ++m)
#pragma unroll
                    for (int bj = 0; bj < 2; ++bj) xb[m][bj] = *(const u32x4*)(base16 + (size_t)(row0 + ai * 128 + m * 16) * DM + col0 + bj * 128);
#pragma unroll
                for (int m = 0; m < 4; ++m) { const size_t off = (size_t)(row0 + ai * 128 + m * 16) * DM + col0;
#pragma unroll
                    for (int bj = 0; bj < 2; ++bj) { f32x4 b0, b1; xunpack8(xb[m][bj], b0, b1);
                        *(u32x4*)(out + off + bj * 128) = xpack8(b0 + gv[bj][0] * acc[ai][bj][m][0], b1 + gv[bj][1] * acc[ai][bj][m][1]); } }
                asm volatile("" ::: "memory");
            }
        }
    }
};
__device__ __forceinline__ float silu_f(float x) { return x * __builtin_amdgcn_rcpf(1.f + __builtin_amdgcn_exp2f(-1.4426950408889634f * x)); }
struct EpiSwiGLU {
    static constexpr bool PERM = true;
    bf16_t* O;
    __device__ __forceinline__ void operator()(const Acc& acc, const pg8::Unit& u, int wr, int wc, int fr, int fq) const {
        const int row0 = u.pm * 256 + wr * 64 + fr, col0 = u.pn * 128 + wc * 32 + 8 * fq;
#pragma unroll
        for (int ai = 0; ai < 2; ++ai)
#pragma unroll
            for (int m = 0; m < 4; ++m) { f32x4 o0, o1;
#pragma unroll
                for (int e = 0; e < 4; ++e) { o0[e] = silu_f(acc[ai][0][m][0][e]) * acc[ai][1][m][0][e]; o1[e] = silu_f(acc[ai][0][m][1][e]) * acc[ai][1][m][1][e]; }
                *(u32x4*)(O + (size_t)(row0 + ai * 128 + m * 16) * FF + col0) = pack8(o0, o1); }
    }
};
__device__ __forceinline__ void rope8(f32x4& v0, f32x4& v1, const f32x4 cs0, const f32x4 cs1) {
    const float a0 = v0[0] * cs0[0] - v0[1] * cs0[1], b0 = v0[1] * cs0[0] + v0[0] * cs0[1];
    const float a1 = v0[2] * cs0[2] - v0[3] * cs0[3], b1 = v0[3] * cs0[2] + v0[2] * cs0[3];
    const float a2 = v1[0] * cs1[0] - v1[1] * cs1[1], b2 = v1[1] * cs1[0] + v1[0] * cs1[1];
    const float a3 = v1[2] * cs1[2] - v1[3] * cs1[3], b3 = v1[3] * cs1[2] + v1[2] * cs1[3];
    v0 = (f32x4){a0, b0, a1, b1}; v1 = (f32x4){a2, b2, a3, b3};
}
struct EpiDQKV {
    static constexpr bool PERM = true;
    bf16_t* QA; bf16_t* CKV; bf16_t* KR; float* SSQ; float* SSKV; const float* TAB;
    __device__ __forceinline__ void operator()(const Acc& acc, const pg8::Unit& u, int wr, int wc, int fr, int fq) const {
        const int row0 = u.pm * 256 + wr * 64 + fr;
        if (u.pn < 4) {
            bf16_t* O = (u.pn < 2) ? QA : CKV; float* SS = (u.pn < 2) ? SSQ : SSKV; const int ct = u.pn & 1, col0 = ct * 256 + wc * 32 + 8 * fq;
#pragma unroll
            for (int ai = 0; ai < 2; ++ai)
#pragma unroll
                for (int m = 0; m < 4; ++m) { const int row = row0 + ai * 128 + m * 16; float s = 0.f;
#pragma unroll
                    for (int bj = 0; bj < 2; ++bj) { const f32x4 v0 = acc[ai][bj][m][0], v1 = acc[ai][bj][m][1];
                        s += (v0[0] * v0[0] + v0[1] * v0[1]) + (v0[2] * v0[2] + v0[3] * v0[3]) + (v1[0] * v1[0] + v1[1] * v1[1]) + (v1[2] * v1[2] + v1[3] * v1[3]);
                        *(u32x4*)(O + (size_t)row * 512 + col0 + bj * 128) = pack8(v0, v1); }
                    s = xor_add<16>(s); s = xor_add<32>(s);
                    if (fq == 0) SS[(size_t)row * 8 + ct * 4 + wc] = s; }
        } else if (wc < 2) {
            const int col0 = wc * 32 + 8 * fq;
#pragma unroll
            for (int ai = 0; ai < 2; ++ai) { f32x4 t0[4], t1[4];
#pragma unroll
                for (int m = 0; m < 4; ++m) { const int row = row0 + ai * 128 + m * 16, rr = row < SEQ ? row : 0, pos = wc ? (rr & 63) : (rr >> 6); const f32x4* t = (const f32x4*)(TAB + (size_t)(pos * 16 + 4 * fq) * 2); t0[m] = t[0]; t1[m] = t[1]; }
#pragma unroll
                for (int m = 0; m < 4; ++m) { const int row = row0 + ai * 128 + m * 16; f32x4 v0 = acc[ai][0][m][0], v1 = acc[ai][0][m][1];
                    if (row < SEQ) rope8(v0, v1, t0[m], t1[m]);
                    *(u32x4*)(KR + (size_t)row * 64 + col0) = pack8(v0, v1); }
                asm volatile("" ::: "memory"); }
        }
    }
};
__device__ __forceinline__ float row_rstd8(const float* ss, int row, float inv_n) {
    const f32x4 a = *(const f32x4*)(ss + (size_t)row * 8), b = *(const f32x4*)(ss + (size_t)row * 8 + 4);
    return __builtin_amdgcn_rsqf(((a[0] + a[1]) + (a[2] + a[3]) + (b[0] + b[1]) + (b[2] + b[3])) * inv_n + EPS);
}
struct EpiUQ {
    static constexpr bool PERM = true;
    bf16_t* Q; const float* SSQ; const float* TAB;
    __device__ __forceinline__ void operator()(const Acc& acc, const pg8::Unit& u, int wr, int wc, int fr, int fq) const {
        const int row0 = u.pm * 256 + wr * 64 + fr;
        int c0[2], ropei[2];
#pragma unroll
        for (int bj = 0; bj < 2; ++bj) { c0[bj] = u.pn * 256 + bj * 128 + wc * 32 + 8 * fq; const int d0 = c0[bj] % QHD; ropei[bj] = (d0 >= QKN) ? ((d0 - QKN) >> 1) : -1; }
#pragma unroll
        for (int ai = 0; ai < 2; ++ai) {
            f32x4 sa[4], sb[4], t0[4], t1[4];
            const int ri = ropei[0] >= 0 ? ropei[0] : ropei[1];
#pragma unroll
            for (int m = 0; m < 4; ++m) { const int row = row0 + ai * 128 + m * 16; sa[m] = *(const f32x4*)(SSQ + (size_t)row * 8); sb[m] = *(const f32x4*)(SSQ + (size_t)row * 8 + 4); }
            if (ri >= 0) {
#pragma unroll
                for (int m = 0; m < 4; ++m) { const int row = row0 + ai * 128 + m * 16, rr = row < SEQ ? row : 0, pos = (ri >> 4) ? (rr & 63) : (rr >> 6); const f32x4* t = (const f32x4*)(TAB + (size_t)(pos * 16 + (ri & 15)) * 2); t0[m] = t[0]; t1[m] = t[1]; } }
#pragma unroll
            for (int m = 0; m < 4; ++m) { const int row = row0 + ai * 128 + m * 16;
                const float rs = __builtin_amdgcn_rsqf(((sa[m][0] + sa[m][1]) + (sa[m][2] + sa[m][3]) + (sb[m][0] + sb[m][1]) + (sb[m][2] + sb[m][3])) * (1.f / QLORA) + EPS);
#pragma unroll
                for (int bj = 0; bj < 2; ++bj) { f32x4 v0 = acc[ai][bj][m][0] * rs, v1 = acc[ai][bj][m][1] * rs;
                    if (ropei[bj] >= 0 && row < SEQ) rope8(v0, v1, t0[m], t1[m]);
                    *(u32x4*)(Q + (size_t)row * NQ + c0[bj]) = pack8(v0 * QSCALE, v1 * QSCALE); } }
            asm volatile("" ::: "memory");
        }
    }
};
struct EpiUKV {
    static constexpr bool PERM = true;
    bf16_t* KN; bf16_t* V; const float* SSKV;
    __device__ __forceinline__ void operator()(const Acc& acc, const pg8::Unit& u, int wr, int wc, int fr, int fq) const {
        const int row0 = u.pm * 256 + wr * 64 + fr, col0 = u.pn * 128 + wc * 32 + 8 * fq;
#pragma unroll
        for (int ai = 0; ai < 2; ++ai) {
            f32x4 sa[4], sb[4];
#pragma unroll
            for (int m = 0; m < 4; ++m) { const int row = row0 + ai * 128 + m * 16; sa[m] = *(const f32x4*)(SSKV + (size_t)row * 8); sb[m] = *(const f32x4*)(SSKV + (size_t)row * 8 + 4); }
#pragma unroll
            for (int m = 0; m < 4; ++m) { const int row = row0 + ai * 128 + m * 16;
                const float rs = __builtin_amdgcn_rsqf(((sa[m][0] + sa[m][1]) + (sa[m][2] + sa[m][3]) + (sb[m][0] + sb[m][1]) + (sb[m][2] + sb[m][3])) * (1.f / KVLORA) + EPS);
                *(u32x4*)(KN + (size_t)row * DM + col0) = pack8(acc[ai][0][m][0] * rs, acc[ai][0][m][1] * rs);
                *(u32x4*)(V + (size_t)row * DM + col0) = pack8(acc[ai][1][m][0] * rs, acc[ai][1][m][1] * rs); }
            asm volatile("" ::: "memory");
        }
    }
};

template <class Main> struct EpiWithSlab {
    static constexpr bool PERM = Main::PERM;
    static_assert(Main::PERM, "slab layout assumes 8 consecutive columns per lane");
    Main main; bf16_t* slab; int ldc;
    __device__ __forceinline__ void operator()(const Acc& acc, const pg8::Unit& u, int wr, int wc, int fr, int fq) const {
        if (u.pm != 32) { main(acc, u, wr, wc, fr, fq); return; }
        bf16_t* sp = slab + (size_t)u.aux * 256 * ldc + (size_t)(wr * 64 + fr) * ldc + u.pn * 256 + wc * 32 + 8 * fq;
#pragma unroll
        for (int ai = 0; ai < 2; ++ai)
#pragma unroll
            for (int m = 0; m < 4; ++m) { bf16_t* rp = sp + (size_t)(ai * 128 + m * 16) * ldc;
#pragma unroll
                for (int bj = 0; bj < 2; ++bj) *(u32x4*)(rp + bj * 128) = xpack8(acc[ai][bj][m][0], acc[ai][bj][m][1]); }
    }
};

namespace att {
__device__ __forceinline__ int crow(int r, int hi) { return (r & 3) + 8 * (r >> 2) + 4 * hi; }
constexpr float THR = 8.f;
__device__ __forceinline__ void partialSM(f32x16& p0, f32x16& p1, float& m_reg, float& alpha) {
    float pmax = p0[0];
#pragma unroll
    for (int r = 1; r < 16; ++r) pmax = fmaxf(pmax, p0[r]);
#pragma unroll
    for (int r = 0; r < 16; ++r) pmax = fmaxf(pmax, p1[r]);
    { auto rr = __builtin_amdgcn_permlane32_swap(__float_as_uint(pmax), __float_as_uint(pmax), false, false); pmax = fmaxf(__uint_as_float(rr[0]), __uint_as_float(rr[1])); }
    float mn;
    if (__builtin_expect(__all(pmax - m_reg <= THR), 1)) { mn = m_reg; alpha = 1.f; }
    else { mn = fmaxf(m_reg, pmax); alpha = __builtin_amdgcn_exp2f(m_reg - mn); m_reg = mn; }
#pragma unroll
    for (int r = 0; r < 16; ++r) { p0[r] = __builtin_amdgcn_exp2f(p0[r] - mn); p1[r] = p1[r] - mn; }
}
__device__ __forceinline__ void finishSM(const f32x16& p0, f32x16& p1, float alpha, float& l_reg, bf16x8& pa0, bf16x8& pa1, bf16x8& pa2, bf16x8& pa3) {
#pragma unroll
    for (int r = 0; r < 16; ++r) p1[r] = __builtin_amdgcn_exp2f(p1[r]);
    float ps = 0;
#pragma unroll
    for (int r = 0; r < 16; ++r) ps += p0[r];
#pragma unroll
    for (int r = 0; r < 16; ++r) ps += p1[r];
    { auto rr = __builtin_amdgcn_permlane32_swap(__float_as_uint(ps), __float_as_uint(ps), false, false); ps = __uint_as_float(rr[0]) + __uint_as_float(rr[1]); }
    l_reg = l_reg * alpha + ps;
#define PK4(P, BASE, OUT) do { unsigned a0 = cvt_pk_bf16(P[BASE + 0], P[BASE + 1]), a1 = cvt_pk_bf16(P[BASE + 2], P[BASE + 3]);   \
    unsigned b0 = cvt_pk_bf16(P[BASE + 4], P[BASE + 5]), b1 = cvt_pk_bf16(P[BASE + 6], P[BASE + 7]);                              \
    auto r0 = __builtin_amdgcn_permlane32_swap(a0, b0, false, false); auto r1 = __builtin_amdgcn_permlane32_swap(a1, b1, false, false); \
    u32x4 w = {r0[0], r1[0], r0[1], r1[1]}; OUT = *reinterpret_cast<bf16x8*>(&w); } while (0)
    PK4(p0, 0, pa0); PK4(p0, 8, pa1); PK4(p1, 0, pa2); PK4(p1, 8, pa3);
#undef PK4
}
__device__ __forceinline__ void unit_simple(const bf16_t* __restrict__ Q, const bf16_t* __restrict__ KN, const bf16_t* __restrict__ KR, const bf16_t* __restrict__ V, bf16_t* __restrict__ O,
                                            int h, int q0, int k0, int nkeys, LAS float* wsf) {
    const int tid = otid(), wid = tid >> 6, lane = tid & 63, r32 = lane & 31, hi = lane >> 5;
    const bf16_t* Qw = Q + (size_t)(q0 + wid * 32 + r32) * NQ + h * QHD + hi * 8;
    bf16x8 qn[8], qp[4];
#pragma unroll
    for (int d0 = 0; d0 < 8; ++d0) qn[d0] = *(const bf16x8*)(Qw + d0 * 16);
#pragma unroll
    for (int d0 = 0; d0 < 4; ++d0) qp[d0] = *(const bf16x8*)(Qw + QKN + d0 * 16);
    float m_reg = -1e30f, l_reg = 0.f; f32x16 o[4];
#pragma unroll
    for (int d = 0; d < 4; ++d) o[d] = f32x16{};
    for (int kt = 0; kt < nkeys; kt += 64) {
        f32x16 p0 = f32x16{}, p1 = f32x16{};
        const bf16_t* kn0 = KN + (size_t)(k0 + kt + r32) * DM + h * QKN + hi * 8; const bf16_t* kn1 = kn0 + (size_t)32 * DM;
#pragma unroll
        for (int d0 = 0; d0 < 8; ++d0) { const bf16x8 b0 = *(const bf16x8*)(kn0 + d0 * 16), b1 = *(const bf16x8*)(kn1 + d0 * 16);
            p0 = __builtin_amdgcn_mfma_f32_32x32x16_bf16(b0, qn[d0], p0, 0, 0, 0); p1 = __builtin_amdgcn_mfma_f32_32x32x16_bf16(b1, qn[d0], p1, 0, 0, 0); }
        const bf16_t* kr0 = KR + (size_t)(k0 + kt + r32) * QKR + hi * 8; const bf16_t* kr1 = kr0 + 32 * QKR;
#pragma unroll
        for (int d0 = 0; d0 < 4; ++d0) { const bf16x8 b0 = *(const bf16x8*)(kr0 + d0 * 16), b1 = *(const bf16x8*)(kr1 + d0 * 16);
            p0 = __builtin_amdgcn_mfma_f32_32x32x16_bf16(b0, qp[d0], p0, 0, 0, 0); p1 = __builtin_amdgcn_mfma_f32_32x32x16_bf16(b1, qp[d0], p1, 0, 0, 0); }
        float alpha; partialSM(p0, p1, m_reg, alpha);
        if (__any(alpha < 1.f)) { if (hi == 0) wsf[r32] = alpha; asm volatile("s_waitcnt lgkmcnt(0)" ::: "memory");
#pragma unroll
            for (int d = 0; d < 4; ++d)
#pragma unroll
                for (int r = 0; r < 16; ++r) o[d][r] *= wsf[crow(r, hi)];
            asm volatile("s_waitcnt lgkmcnt(0)" ::: "memory"); }
        bf16x8 pa[4]; finishSM(p0, p1, alpha, l_reg, pa[0], pa[1], pa[2], pa[3]);
#pragma unroll
        for (int ks = 0; ks < 4; ++ks) { const bf16_t* vb = V + (size_t)(k0 + kt + 16 * ks + 8 * hi) * DM + h * VD + r32;
#pragma unroll
            for (int d0 = 0; d0 < 4; ++d0) { bf16x8 bv;
#pragma unroll
                for (int j = 0; j < 8; ++j) bv[j] = (short)vb[(size_t)j * DM + d0 * 32];
                o[d0] = __builtin_amdgcn_mfma_f32_32x32x16_bf16(pa[ks], bv, o[d0], 0, 0, 0); } }
    }
    if (hi == 0) wsf[32 + r32] = l_reg; asm volatile("s_waitcnt lgkmcnt(0)" ::: "memory");
    bf16_t* Ow = O + (size_t)(q0 + wid * 32) * DM + h * VD + r32;
#pragma unroll
    for (int r = 0; r < 16; ++r) { const int orow = crow(r, hi); const float rl = __builtin_amdgcn_rcpf(wsf[32 + orow]);
#pragma unroll
        for (int d0 = 0; d0 < 4; ++d0) Ow[(size_t)orow * DM + d0 * 32] = (bf16_t)(cvt_pk_bf16(o[d0][r] * rl, 0.f) & 0xffffu); }
    asm volatile("s_waitcnt lgkmcnt(0)" ::: "memory");
}

constexpr int KN_SLOT = 16384, KR_SLOT = 8192, V_SLOT = 16384;
constexpr int L_KN = 0, L_KR = 3 * KN_SLOT, L_V = L_KR + 3 * KR_SLOT, L_WS = L_V + 3 * V_SLOT, ATT_LDS = L_WS + 8 * 256;
__device__ __forceinline__ void glds16(const void* gsrc, unsigned lds_dst) { unsigned keep;
    asm volatile("s_mov_b32 %0, m0\n\ts_mov_b32 m0, %2\n\ts_nop 0\n\tglobal_load_lds_dwordx4 %1, off\n\ts_mov_b32 m0, %0" : "=&s"(keep) : "v"(gsrc), "s"(lds_dst) : "memory"); }
__device__ __forceinline__ void glds16s(const char* sbase, unsigned voff, unsigned lds_dst) {
    asm volatile("s_mov_b32 m0, %2\n\ts_nop 0\n\tglobal_load_lds_dwordx4 %1, %0" :: "s"(sbase), "v"(voff), "s"(lds_dst) : "memory", "m0"); }
typedef short s16x4 __attribute__((ext_vector_type(4)));
__device__ __forceinline__ int v_rd_base(int lane) { return ((lane & 3) << 3) | (((lane >> 2) & 3) << 6) | (((lane >> 4) & 1) << 5) | (((lane >> 5) & 1) << 8); }
constexpr int v_rd_off(int d0, int ks, int half) { return d0 * 512 + ks * 4096 + half * 2048; }
template <int OFF> __device__ __forceinline__ s16x4 tr_read(int vb) { s16x4 r; asm volatile("ds_read_b64_tr_b16 %0, %1 offset:%2" : "=&v"(r) : "v"(vb), "i"(OFF) : "memory"); return r; }
template <int D0> __device__ __forceinline__ void pv_one(f32x16& od, int vb, bf16x8 pa0, bf16x8 pa1, bf16x8 pa2, bf16x8 pa3) {
    const s16x4 l0 = tr_read<v_rd_off(D0, 0, 0)>(vb), h0 = tr_read<v_rd_off(D0, 0, 1)>(vb), l1 = tr_read<v_rd_off(D0, 1, 0)>(vb), h1 = tr_read<v_rd_off(D0, 1, 1)>(vb);
    const s16x4 l2 = tr_read<v_rd_off(D0, 2, 0)>(vb), h2 = tr_read<v_rd_off(D0, 2, 1)>(vb), l3 = tr_read<v_rd_off(D0, 3, 0)>(vb), h3 = tr_read<v_rd_off(D0, 3, 1)>(vb);
    asm volatile("s_waitcnt lgkmcnt(0)" ::: "memory"); __builtin_amdgcn_sched_barrier(0);
#define PK(L, H) (bf16x8){L[0], L[1], L[2], L[3], H[0], H[1], H[2], H[3]}
    od = __builtin_amdgcn_mfma_f32_32x32x16_bf16(pa0, PK(l0, h0), od, 0, 0, 0);
    od = __builtin_amdgcn_mfma_f32_32x32x16_bf16(pa1, PK(l1, h1), od, 0, 0, 0);
    od = __builtin_amdgcn_mfma_f32_32x32x16_bf16(pa2, PK(l2, h2), od, 0, 0, 0);
    od = __builtin_amdgcn_mfma_f32_32x32x16_bf16(pa3, PK(l3, h3), od, 0, 0, 0);
#undef PK
}
__device__ __forceinline__ void pv_d0(f32x16* o, int vb, bf16x8 pa0, bf16x8 pa1, bf16x8 pa2, bf16x8 pa3) {
    pv_one<0>(o[0], vb, pa0, pa1, pa2, pa3); pv_one<1>(o[1], vb, pa0, pa1, pa2, pa3); pv_one<2>(o[2], vb, pa0, pa1, pa2, pa3); pv_one<3>(o[3], vb, pa0, pa1, pa2, pa3);
}
__device__ __forceinline__ void qkt(f32x16& p0, f32x16& p1, LAS unsigned char* kn, LAS unsigned char* kr, const bf16x8* qn, const bf16x8* qp, int r32, int hi) {
    p0 = f32x16{}; p1 = f32x16{};
#pragma unroll
    for (int d0 = 0; d0 < 8; ++d0) { const int cb = ((2 * d0 + hi) ^ (r32 & 15)) * 16;
        const bf16x8 b0 = *(const LAS bf16x8*)(kn + r32 * 256 + cb), b1 = *(const LAS bf16x8*)(kn + 8192 + r32 * 256 + cb);
        p0 = __builtin_amdgcn_mfma_f32_32x32x16_bf16(b0, qn[d0], p0, 0, 0, 0); p1 = __builtin_amdgcn_mfma_f32_32x32x16_bf16(b1, qn[d0], p1, 0, 0, 0); }
#pragma unroll
    for (int d0 = 0; d0 < 4; ++d0) { const int cb = ((2 * d0 + hi) ^ ((r32 >> 1) & 7)) * 16;
        const bf16x8 b0 = *(const LAS bf16x8*)(kr + r32 * 128 + cb), b1 = *(const LAS bf16x8*)(kr + 4096 + r32 * 128 + cb);
        p0 = __builtin_amdgcn_mfma_f32_32x32x16_bf16(b0, qp[d0], p0, 0, 0, 0); p1 = __builtin_amdgcn_mfma_f32_32x32x16_bf16(b1, qp[d0], p1, 0, 0, 0); }
}

typedef short v4i16_t __attribute__((ext_vector_type(4)));
template <int OFF> __device__ __forceinline__ s16x4 tr_rd(int vb) { return __builtin_bit_cast(s16x4, __builtin_amdgcn_ds_read_tr16_b64_v4i16((LAS v4i16_t*)(vb + OFF))); }
template <bool NOLDS> __device__ __forceinline__ void qkt_p(f32x16& p0, f32x16& p1, LAS unsigned char* kn, LAS unsigned char* kr, const bf16x8* qn, const bf16x8* qp, int r32, int hi) {
    const int swn = r32 & 15, swr = (r32 >> 1) & 7;
    LAS unsigned char* knr = kn + r32 * 256; LAS unsigned char* krr = kr + r32 * 128;
    bf16x8 k0[3], k1[3];
    p0 = f32x16{}; p1 = f32x16{};
#define KRD(D, I) do { if (NOLDS) { k0[I] = qn[(D) & 7]; k1[I] = qn[((D) + 1) & 7]; } else if ((D) < 8) { const int cb = ((2 * (D) + hi) ^ swn) * 16; k0[I] = *(const LAS bf16x8*)(knr + cb); k1[I] = *(const LAS bf16x8*)(knr + 8192 + cb); } \
                       else { const int cb = ((2 * ((D) - 8) + hi) ^ swr) * 16; k0[I] = *(const LAS bf16x8*)(krr + cb); k1[I] = *(const LAS bf16x8*)(krr + 4096 + cb); } } while (0)
    KRD(0, 0); KRD(1, 1); __builtin_amdgcn_sched_barrier(0);
#pragma unroll
    for (int D = 0; D < 12; ++D) {
        if (D + 2 < 12) KRD(D + 2, (D + 2) % 3);
        __builtin_amdgcn_sched_barrier(0);
        const bf16x8 q = D < 8 ? qn[D & 7] : qp[(D - 8) & 3];
        p0 = __builtin_amdgcn_mfma_f32_32x32x16_bf16(k0[D % 3], q, p0, 0, 0, 0); p1 = __builtin_amdgcn_mfma_f32_32x32x16_bf16(k1[D % 3], q, p1, 0, 0, 0);
        __builtin_amdgcn_sched_barrier(0);
    }
#undef KRD
}
template <bool NOLDS> __device__ __forceinline__ void pv_p(f32x16* o, int vb, bf16x8 pa0, bf16x8 pa1, bf16x8 pa2, bf16x8 pa3) {
    s16x4 va[8], vq[8];
#define VRD8(D0, X) do { if (NOLDS) { _Pragma("unroll") for (int _e = 0; _e < 8; ++_e) X[_e] = (s16x4){pa0[_e], pa1[_e], pa2[_e], pa3[_e]}; } else { X[0] = tr_rd<v_rd_off(D0, 0, 0)>(vb); X[1] = tr_rd<v_rd_off(D0, 0, 1)>(vb); X[2] = tr_rd<v_rd_off(D0, 1, 0)>(vb); X[3] = tr_rd<v_rd_off(D0, 1, 1)>(vb); \
                         X[4] = tr_rd<v_rd_off(D0, 2, 0)>(vb); X[5] = tr_rd<v_rd_off(D0, 2, 1)>(vb); X[6] = tr_rd<v_rd_off(D0, 3, 0)>(vb); X[7] = tr_rd<v_rd_off(D0, 3, 1)>(vb); } } while (0)
#define PKV(L, H) (bf16x8){L[0], L[1], L[2], L[3], H[0], H[1], H[2], H[3]}
#define PV4(OD, X) do { OD = __builtin_amdgcn_mfma_f32_32x32x16_bf16(pa0, PKV(X[0], X[1]), OD, 0, 0, 0); OD = __builtin_amdgcn_mfma_f32_32x32x16_bf16(pa1, PKV(X[2], X[3]), OD, 0, 0, 0); \
                         OD = __builtin_amdgcn_mfma_f32_32x32x16_bf16(pa2, PKV(X[4], X[5]), OD, 0, 0, 0); OD = __builtin_amdgcn_mfma_f32_32x32x16_bf16(pa3, PKV(X[6], X[7]), OD, 0, 0, 0); } while (0)
    VRD8(0, va); __builtin_amdgcn_sched_barrier(0);
    VRD8(1, vq); __builtin_amdgcn_sched_barrier(0); PV4(o[0], va); __builtin_amdgcn_sched_barrier(0);
    VRD8(2, va); __builtin_amdgcn_sched_barrier(0); PV4(o[1], vq); __builtin_amdgcn_sched_barrier(0);
    VRD8(3, vq); __builtin_amdgcn_sched_barrier(0); PV4(o[2], va); __builtin_amdgcn_sched_barrier(0);
    PV4(o[3], vq); __builtin_amdgcn_sched_barrier(0);
#undef VRD8
#undef PKV
#undef PV4
}
#define ATT_WAIT_BAR(N) asm volatile("s_waitcnt vmcnt(" #N ") lgkmcnt(0)\n\ts_barrier" ::: "memory")
__device__ __forceinline__ void unit_fast(const bf16_t* __restrict__ Q, const bf16_t* __restrict__ KN, const bf16_t* __restrict__ KR, const bf16_t* __restrict__ V, bf16_t* __restrict__ O,
                                          int h, int q0, int k0, int nkeys, LAS unsigned char* lds) {
    const int tid = otid(), wid = __builtin_amdgcn_readfirstlane(tid >> 6), lane = tid & 63, r32 = lane & 31, hi = lane >> 5;
    const unsigned lds0 = (unsigned)(uintptr_t)lds;
    LAS float* wsf = (LAS float*)(lds + L_WS) + wid * 64;
    unsigned kn_off[2], v_off[2], kr_off;
#pragma unroll
    for (int i = 0; i < 2; ++i) { const int row = 8 * wid + 4 * i + (lane >> 4), lc = (lane & 15) ^ (row & 15); kn_off[i] = (unsigned)(row * DM * 2 + h * QKN * 2 + lc * 16);
        const int s = 2 * (2 * wid + i) + (lane >> 5), kk = 8 * (s >> 2) + ((lane & 31) >> 2), k = (kk & ~0xC) | ((kk & 4) << 1) | ((kk & 8) >> 1), c = 32 * (s & 3) + 8 * (lane & 3);
        v_off[i] = (unsigned)(k * DM * 2 + h * VD * 2 + c * 2); }
    { const int row = 8 * wid + (lane >> 3), lc = (lane & 7) ^ ((row >> 1) & 7); kr_off = (unsigned)(row * QKR * 2 + lc * 16); }
    const char* KNg = (const char*)(KN + (size_t)k0 * DM); const char* KRg = (const char*)(KR + (size_t)k0 * QKR); const char* Vg = (const char*)(V + (size_t)k0 * DM);
    const unsigned dK = lds0 + L_KN + 2 * wid * 1024, dR = lds0 + L_KR + wid * 1024, dV = lds0 + L_V + 2 * wid * 1024;
#define DMA_K(t, sl) do { const char* _g = KNg + (size_t)(t) * (64 * DM * 2); const unsigned _d = (unsigned)__builtin_amdgcn_readfirstlane(dK + (sl) * KN_SLOT); \
        glds16(_g + kn_off[0], _d); glds16(_g + kn_off[1], _d + 1024); glds16(KRg + (size_t)(t) * (64 * QKR * 2) + kr_off, (unsigned)__builtin_amdgcn_readfirstlane(dR + (sl) * KR_SLOT)); } while (0)
#define DMA_V(t, sl) do { const char* _g = Vg + (size_t)(t) * (64 * DM * 2); const unsigned _d = (unsigned)__builtin_amdgcn_readfirstlane(dV + (sl) * V_SLOT); \
        glds16(_g + v_off[0], _d); glds16(_g + v_off[1], _d + 1024); } while (0)
    const int NT = nkeys / 64;
    DMA_K(0, 0); DMA_V(0, 0); DMA_K(1, 1);
    const bf16_t* Qw = Q + (size_t)(q0 + wid * 32 + r32) * NQ + h * QHD + hi * 8;
    bf16x8 qn[8], qp[4];
#pragma unroll
    for (int d0 = 0; d0 < 8; ++d0) qn[d0] = *(const bf16x8*)(Qw + d0 * 16);
#pragma unroll
    for (int d0 = 0; d0 < 4; ++d0) qp[d0] = *(const bf16x8*)(Qw + QKN + d0 * 16);
    float m_reg = -1e30f, l_reg = 0.f; f32x16 o[4];
#pragma unroll
    for (int d = 0; d < 4; ++d) o[d] = f32x16{};
    const int vb0 = (int)(lds0 + L_V) + v_rd_base(lane);
    f32x16 pA0, pA1, pB0, pB1; float alA, alB; bf16x8 pa0, pa1, pa2, pa3;
    int sa = 0, sb = 1, sc = 2;
#define ROT() do { const int _t = sa; sa = sb; sb = sc; sc = _t; } while (0)
#define RESC(a) do { if (__any((a) < 1.f)) { if (hi == 0) wsf[r32] = (a); asm volatile("s_waitcnt lgkmcnt(0)" ::: "memory"); \
        _Pragma("unroll") for (int d = 0; d < 4; ++d) _Pragma("unroll") for (int r = 0; r < 16; ++r) o[d][r] *= wsf[crow(r, hi)]; } } while (0)
    ATT_WAIT_BAR(0);
    { DMA_K((2 < NT ? 2 : NT - 1), sc); DMA_V(1, sb);
      qkt(pA0, pA1, lds + L_KN + sa * KN_SLOT, lds + L_KR + sa * KR_SLOT, qn, qp, r32, hi); partialSM(pA0, pA1, m_reg, alA);
      ATT_WAIT_BAR(5); ROT(); }
#define STEP(j, C0, C1, alC, P0, P1, alP) do { const int _kt = ((j) + 2 < NT) ? (j) + 2 : NT - 1, _vt = ((j) + 1 < NT) ? (j) + 1 : NT - 1; \
        DMA_K(_kt, sc); DMA_V(_vt, sb); __builtin_amdgcn_sched_barrier(0); \
        qkt_p<false>(C0, C1, lds + L_KN + sa * KN_SLOT, lds + L_KR + sa * KR_SLOT, qn, qp, r32, hi); \
        finishSM(P0, P1, alP, l_reg, pa0, pa1, pa2, pa3); __builtin_amdgcn_sched_barrier(0); \
        pv_p<false>(o, vb0 + sc * V_SLOT, pa0, pa1, pa2, pa3); \
        partialSM(C0, C1, m_reg, alC); RESC(alC); \
        ATT_WAIT_BAR(5); ROT(); } while (0)
#pragma unroll 1
    for (int j = 1; j + 1 < NT; j += 2) { STEP(j, pB0, pB1, alB, pA0, pA1, alA); STEP(j + 1, pA0, pA1, alA, pB0, pB1, alB); }
    STEP(NT - 1, pB0, pB1, alB, pA0, pA1, alA);
    finishSM(pB0, pB1, alB, l_reg, pa0, pa1, pa2, pa3); __builtin_amdgcn_sched_barrier(0);
    pv_d0(o, vb0 + sc * V_SLOT, pa0, pa1, pa2, pa3);
    if (hi == 0) wsf[32 + r32] = l_reg;
    ATT_WAIT_BAR(0);
    { LAS bf16_t* stg = (LAS bf16_t*)(lds + wid * 8192);
#pragma unroll
      for (int r = 0; r < 16; ++r) { const int orow = crow(r, hi); const float rl = __builtin_amdgcn_rcpf(wsf[32 + orow]);
#pragma unroll
          for (int d0 = 0; d0 < 4; ++d0) stg[orow * 128 + d0 * 32 + r32] = (bf16_t)(cvt_pk_bf16(o[d0][r] * rl, 0.f) & 0xffffu); }
      asm volatile("s_waitcnt lgkmcnt(0)" ::: "memory");
      bf16_t* Ow = O + (size_t)(q0 + wid * 32) * DM + h * VD;
#pragma unroll
      for (int i = 0; i < 8; ++i) { const int row = i * 4 + (lane >> 4), ch = lane & 15; const u32x4 v = *(const LAS u32x4*)(stg + row * 128 + ch * 8); *(u32x4*)(Ow + (size_t)row * DM + ch * 8) = v; } }
    ATT_WAIT_BAR(0);
#undef DMA_K
#undef DMA_V
#undef ROT
#undef RESC
#undef STEP
}


#define SB0() __builtin_amdgcn_sched_barrier(0)
#define PIN(x) asm volatile("" : "+v"(x))
#define PKQ(P, BASE, OUT) do { unsigned a0 = cvt_pk_bf16(P[BASE + 0], P[BASE + 1]), a1 = cvt_pk_bf16(P[BASE + 2], P[BASE + 3]);   \
    unsigned b0 = cvt_pk_bf16(P[BASE + 4], P[BASE + 5]), b1 = cvt_pk_bf16(P[BASE + 6], P[BASE + 7]);                              \
    auto r0 = __builtin_amdgcn_permlane32_swap(a0, b0, false, false); auto r1 = __builtin_amdgcn_permlane32_swap(a1, b1, false, false); \
    u32x4 w = {r0[0], r1[0], r0[1], r1[1]}; OUT = *reinterpret_cast<bf16x8*>(&w); } while (0)
__device__ __forceinline__ void regionA(f32x16& c0, f32x16& c1, LAS unsigned char* kn, LAS unsigned char* kr, const bf16x8* qn, const bf16x8* qp, int r32, int hi,
                                        f32x16& P0, f32x16& P1, float alP, float& l_reg, bf16x8& pa0, bf16x8& pa1, bf16x8& pa2, bf16x8& pa3,
                                        const char* gk, const char* gkr, unsigned ko0, unsigned ko1, unsigned kro, unsigned dk, unsigned dr) {
    const int swn = r32 & 15, swr = (r32 >> 1) & 7;
    LAS unsigned char* knr = kn + r32 * 256; LAS unsigned char* krr = kr + r32 * 128;
    bf16x8 ka0, ka1, kb0, kb1; float ps = 0.f, ps1 = 0.f, ps2 = 0.f, ps3 = 0.f;
    c0 = f32x16{}; c1 = f32x16{};
#define KRD(D, X0, X1) do { if ((D) < 8) { const int cb = ((2 * (D) + hi) ^ swn) * 16; X0 = *(const LAS bf16x8*)(knr + cb); X1 = *(const LAS bf16x8*)(knr + 8192 + cb); } \
                            else if ((D) < 12) { const int cb = ((2 * ((D) - 8) + hi) ^ swr) * 16; X0 = *(const LAS bf16x8*)(krr + cb); X1 = *(const LAS bf16x8*)(krr + 4096 + cb); } } while (0)
#define QOP(D) ((D) < 8 ? qn[(D) & 7] : qp[((D) - 8) & 3])
#define GAPA(D, X0, X1, WORK) do { \
        c0 = __builtin_amdgcn_mfma_f32_32x32x16_bf16(X0, QOP(D), c0, 0, 0, 0); c1 = __builtin_amdgcn_mfma_f32_32x32x16_bf16(X1, QOP(D), c1, 0, 0, 0); KRD((D) + 2, X0, X1); WORK; SB0(); } while (0)
    KRD(0, ka0, ka1); KRD(1, kb0, kb1); SB0();
    GAPA(0, ka0, ka1, { PKQ(P0, 0, pa0); PIN(pa0); });
    GAPA(1, kb0, kb1, { glds16s(gk, ko0, dk); PKQ(P0, 8, pa1); PIN(pa1); });
    GAPA(2, ka0, ka1, { _Pragma("unroll") for (int r = 0; r < 8; ++r) { ps += P0[r]; ps1 += P0[8 + r]; } PIN(ps); PIN(ps1); });
    GAPA(3, kb0, kb1, { _Pragma("unroll") for (int r = 0; r < 4; ++r) P1[r] = __builtin_amdgcn_exp2f(P1[r]); PIN(P1); });
    GAPA(4, ka0, ka1, { glds16s(gk, ko1, dk + 1024); _Pragma("unroll") for (int r = 4; r < 8; ++r) P1[r] = __builtin_amdgcn_exp2f(P1[r]); PIN(P1); });
    GAPA(5, kb0, kb1, { _Pragma("unroll") for (int r = 8; r < 12; ++r) P1[r] = __builtin_amdgcn_exp2f(P1[r]); PIN(P1); });
    GAPA(6, ka0, ka1, { _Pragma("unroll") for (int r = 12; r < 16; ++r) P1[r] = __builtin_amdgcn_exp2f(P1[r]); PIN(P1); });
    GAPA(7, kb0, kb1, { PKQ(P1, 0, pa2); PIN(pa2); });
    GAPA(8, ka0, ka1, { glds16s(gkr, kro, dr); PKQ(P1, 8, pa3); PIN(pa3); });
    GAPA(9, kb0, kb1, { _Pragma("unroll") for (int r = 0; r < 8; ++r) { ps2 += P1[r]; ps3 += P1[8 + r]; } PIN(ps2); PIN(ps3); });
    GAPA(10, ka0, ka1, { ps = (ps + ps1) + (ps2 + ps3); auto rr = __builtin_amdgcn_permlane32_swap(__float_as_uint(ps), __float_as_uint(ps), false, false); ps = __uint_as_float(rr[0]) + __uint_as_float(rr[1]); l_reg = l_reg * alP + ps; PIN(l_reg); });
    GAPA(11, kb0, kb1, { });
#undef KRD
#undef QOP
#undef GAPA
}
__device__ __forceinline__ void regionB(f32x16* o, int vb, bf16x8 pa0, bf16x8 pa1, bf16x8 pa2, bf16x8 pa3, f32x16& C0, f32x16& C1, float& m_reg, float& alC, const char* gv, unsigned vo0, unsigned vo1, unsigned dv) {
    s16x4 va[8]; float mn = 0.f;
#define VRD8(D0, X) do { X[0] = tr_rd<v_rd_off(D0, 0, 0)>(vb); X[1] = tr_rd<v_rd_off(D0, 0, 1)>(vb); X[2] = tr_rd<v_rd_off(D0, 1, 0)>(vb); X[3] = tr_rd<v_rd_off(D0, 1, 1)>(vb); \
                         X[4] = tr_rd<v_rd_off(D0, 2, 0)>(vb); X[5] = tr_rd<v_rd_off(D0, 2, 1)>(vb); X[6] = tr_rd<v_rd_off(D0, 3, 0)>(vb); X[7] = tr_rd<v_rd_off(D0, 3, 1)>(vb); } while (0)
#define PKV(L, H) (bf16x8){L[0], L[1], L[2], L[3], H[0], H[1], H[2], H[3]}
#define PV4(OD, X) do { OD = __builtin_amdgcn_mfma_f32_32x32x16_bf16(pa0, PKV(X[0], X[1]), OD, 0, 0, 0); OD = __builtin_amdgcn_mfma_f32_32x32x16_bf16(pa1, PKV(X[2], X[3]), OD, 0, 0, 0); \
                         OD = __builtin_amdgcn_mfma_f32_32x32x16_bf16(pa2, PKV(X[4], X[5]), OD, 0, 0, 0); OD = __builtin_amdgcn_mfma_f32_32x32x16_bf16(pa3, PKV(X[6], X[7]), OD, 0, 0, 0); } while (0)
    VRD8(0, va); SB0();
    PV4(o[0], va); VRD8(1, va);
    { float a = fmaxf(fmaxf(C0[0], C0[1]), C1[0]), b = fmaxf(fmaxf(C0[2], C0[3]), C1[1]); a = fmaxf(fmaxf(a, C1[2]), C1[3]);
      _Pragma("unroll") for (int r = 4; r < 16; r += 4) { a = fmaxf(fmaxf(a, C0[r]), C0[r + 1]); b = fmaxf(fmaxf(b, C0[r + 2]), C0[r + 3]); a = fmaxf(fmaxf(a, C1[r]), C1[r + 1]); b = fmaxf(fmaxf(b, C1[r + 2]), C1[r + 3]); }
      float pmax = fmaxf(a, b); { auto rr = __builtin_amdgcn_permlane32_swap(__float_as_uint(pmax), __float_as_uint(pmax), false, false); pmax = fmaxf(__uint_as_float(rr[0]), __uint_as_float(rr[1])); }
      const bool keep = __all(pmax - m_reg <= THR); mn = keep ? m_reg : fmaxf(m_reg, pmax); alC = keep ? 1.f : __builtin_amdgcn_exp2f(m_reg - mn); m_reg = mn; PIN(mn); PIN(alC); }
    SB0();
    PV4(o[1], va); VRD8(2, va);
    { glds16s(gv, vo0, dv); _Pragma("unroll") for (int r = 0; r < 16; ++r) { C0[r] -= mn; C1[r] -= mn; } PIN(C0); PIN(C1); }
    SB0();
    PV4(o[2], va); VRD8(3, va);
    { _Pragma("unroll") for (int r = 0; r < 8; ++r) C0[r] = __builtin_amdgcn_exp2f(C0[r]); PIN(C0); }
    SB0();
    PV4(o[3], va);
    { glds16s(gv, vo1, dv + 1024); _Pragma("unroll") for (int r = 8; r < 16; ++r) C0[r] = __builtin_amdgcn_exp2f(C0[r]); PIN(C0); }
    SB0();
#undef VRD8
#undef PKV
#undef PV4
}
__device__ __forceinline__ void unit_il(const bf16_t* __restrict__ Q, const bf16_t* __restrict__ KN, const bf16_t* __restrict__ KR, const bf16_t* __restrict__ V, bf16_t* __restrict__ O,
                                          int h, int q0, int k0, int nkeys, LAS unsigned char* lds) {
    const int tid = otid(), wid = __builtin_amdgcn_readfirstlane(tid >> 6), lane = tid & 63, r32 = lane & 31, hi = lane >> 5;
    const unsigned lds0 = (unsigned)(uintptr_t)lds;
    LAS float* wsf = (LAS float*)(lds + L_WS) + wid * 64;
    unsigned kn_off[2], v_off[2], kr_off;
#pragma unroll
    for (int i = 0; i < 2; ++i) { const int row = 8 * wid + 4 * i + (lane >> 4), lc = (lane & 15) ^ (row & 15); kn_off[i] = (unsigned)(row * DM * 2 + h * QKN * 2 + lc * 16);
        const int s = 2 * (2 * wid + i) + (lane >> 5), kk = 8 * (s >> 2) + ((lane & 31) >> 2), k = (kk & ~0xC) | ((kk & 4) << 1) | ((kk & 8) >> 1), c = 32 * (s & 3) + 8 * (lane & 3);
        v_off[i] = (unsigned)(k * DM * 2 + h * VD * 2 + c * 2); }
    { const int row = 8 * wid + (lane >> 3), lc = (lane & 7) ^ ((row >> 1) & 7); kr_off = (unsigned)(row * QKR * 2 + lc * 16); }
    const char* KNg = (const char*)(KN + (size_t)k0 * DM); const char* KRg = (const char*)(KR + (size_t)k0 * QKR); const char* Vg = (const char*)(V + (size_t)k0 * DM);
    const unsigned dK = lds0 + L_KN + 2 * wid * 1024, dR = lds0 + L_KR + wid * 1024, dV = lds0 + L_V + 2 * wid * 1024;
#define DMA_K(t, sl) do { const char* _g = KNg + (size_t)(t) * (64 * DM * 2); const unsigned _d = (unsigned)__builtin_amdgcn_readfirstlane(dK + (sl) * KN_SLOT); \
        glds16s(_g, kn_off[0], _d); glds16s(_g, kn_off[1], _d + 1024); glds16s(KRg + (size_t)(t) * (64 * QKR * 2), kr_off, (unsigned)__builtin_amdgcn_readfirstlane(dR + (sl) * KR_SLOT)); } while (0)
#define DMA_V(t, sl) do { const char* _g = Vg + (size_t)(t) * (64 * DM * 2); const unsigned _d = (unsigned)__builtin_amdgcn_readfirstlane(dV + (sl) * V_SLOT); \
        glds16s(_g, v_off[0], _d); glds16s(_g, v_off[1], _d + 1024); } while (0)
    const int NT = nkeys / 64;
    DMA_K(0, 0); DMA_V(0, 0); DMA_K(1, 1);
    const bf16_t* Qw = Q + (size_t)(q0 + wid * 32 + r32) * NQ + h * QHD + hi * 8;
    bf16x8 qn[8], qp[4];
#pragma unroll
    for (int d0 = 0; d0 < 8; ++d0) qn[d0] = *(const bf16x8*)(Qw + d0 * 16);
#pragma unroll
    for (int d0 = 0; d0 < 4; ++d0) qp[d0] = *(const bf16x8*)(Qw + QKN + d0 * 16);
    float m_reg = -1e30f, l_reg = 0.f; f32x16 o[4];
#pragma unroll
    for (int d = 0; d < 4; ++d) o[d] = f32x16{};
    const int vb0 = (int)(lds0 + L_V) + v_rd_base(lane);
    f32x16 pA0, pA1, pB0, pB1; float alA, alB; bf16x8 pa0, pa1, pa2, pa3;
    int sa = 0, sb = 1, sc = 2;
#define ROT() do { const int _t = sa; sa = sb; sb = sc; sc = _t; } while (0)
#define RESC(a) do { if (__any((a) < 1.f)) { if (hi == 0) wsf[r32] = (a); asm volatile("s_waitcnt lgkmcnt(0)" ::: "memory"); \
        _Pragma("unroll") for (int d = 0; d < 4; ++d) _Pragma("unroll") for (int r = 0; r < 16; ++r) o[d][r] *= wsf[crow(r, hi)]; } } while (0)
    ATT_WAIT_BAR(0);
    { DMA_K((2 < NT ? 2 : NT - 1), sc); DMA_V(1, sb);
      qkt(pA0, pA1, lds + L_KN + sa * KN_SLOT, lds + L_KR + sa * KR_SLOT, qn, qp, r32, hi); partialSM(pA0, pA1, m_reg, alA);
      ATT_WAIT_BAR(5); ROT(); }
#define STEP(j, C0, C1, alC, P0, P1, alP) do { const int _kt = ((j) + 2 < NT) ? (j) + 2 : NT - 1, _vt = ((j) + 1 < NT) ? (j) + 1 : NT - 1; \
        const char* _gk = KNg + (size_t)_kt * (64 * DM * 2); const char* _gv = Vg + (size_t)_vt * (64 * DM * 2); \
        const unsigned _dk = (unsigned)__builtin_amdgcn_readfirstlane(dK + sc * KN_SLOT), _dr = (unsigned)__builtin_amdgcn_readfirstlane(dR + sc * KR_SLOT), _dv = (unsigned)__builtin_amdgcn_readfirstlane(dV + sb * V_SLOT); SB0(); \
        regionA(C0, C1, lds + L_KN + sa * KN_SLOT, lds + L_KR + sa * KR_SLOT, qn, qp, r32, hi, P0, P1, alP, l_reg, pa0, pa1, pa2, pa3, _gk, KRg + (size_t)_kt * (64 * QKR * 2), kn_off[0], kn_off[1], kr_off, _dk, _dr); \
        regionB(o, vb0 + sc * V_SLOT, pa0, pa1, pa2, pa3, C0, C1, m_reg, alC, _gv, v_off[0], v_off[1], _dv); RESC(alC); \
        ATT_WAIT_BAR(5); ROT(); } while (0)
#pragma unroll 1
    for (int j = 1; j + 1 < NT; j += 2) { STEP(j, pB0, pB1, alB, pA0, pA1, alA); STEP(j + 1, pA0, pA1, alA, pB0, pB1, alB); }
    STEP(NT - 1, pB0, pB1, alB, pA0, pA1, alA);
    finishSM(pB0, pB1, alB, l_reg, pa0, pa1, pa2, pa3); __builtin_amdgcn_sched_barrier(0);
    pv_d0(o, vb0 + sc * V_SLOT, pa0, pa1, pa2, pa3);
    if (hi == 0) wsf[32 + r32] = l_reg;
    ATT_WAIT_BAR(0);
    { LAS bf16_t* stg = (LAS bf16_t*)(lds + wid * 8192);
#pragma unroll
      for (int r = 0; r < 16; ++r) { const int orow = crow(r, hi); const float rl = __builtin_amdgcn_rcpf(wsf[32 + orow]);
#pragma unroll
          for (int d0 = 0; d0 < 4; ++d0) stg[orow * 128 + d0 * 32 + r32] = (bf16_t)(cvt_pk_bf16(o[d0][r] * rl, 0.f) & 0xffffu); }
      asm volatile("s_waitcnt lgkmcnt(0)" ::: "memory");
      bf16_t* Ow = O + (size_t)(q0 + wid * 32) * DM + h * VD;
#pragma unroll
      for (int i = 0; i < 8; ++i) { const int row = i * 4 + (lane >> 4), ch = lane & 15; const u32x4 v = *(const LAS u32x4*)(stg + row * 128 + ch * 8); *(u32x4*)(Ow + (size_t)row * DM + ch * 8) = v; } }
    ATT_WAIT_BAR(0);
#undef DMA_K
#undef DMA_V
#undef ROT
#undef RESC
#undef STEP
}

}

constexpr size_t MiB = 1u << 20;
constexpr size_t al(size_t x) { return (x + 255) / 256 * 256; }
constexpr size_t WS_CTL = 0, CTL_BYTES = 1 * MiB;
constexpr size_t WS_MOD = WS_CTL + CTL_BYTES, MOD_BYTES = (size_t)DEPTH * 2 * 6 * DM * 4;
constexpr size_t ZERO_BYTES = al(WS_MOD + MOD_BYTES);
constexpr size_t WS_TAB = ZERO_BYTES;
constexpr size_t WS_SSQ = al(WS_TAB + 128 * 16 * 2 * 4), WS_SSKV = al(WS_SSQ + (size_t)R * 8 * 4);
constexpr size_t WS_WIN = al(WS_SSKV + (size_t)R * 8 * 4);
constexpr size_t WS_WINB = WS_WIN + (size_t)2 * EVEN_IN * DM * 2;
constexpr size_t WS_POOLT = WS_WINB + (size_t)2 * DM * 1024 * 2;
constexpr size_t WS_WOUT = WS_POOLT + (size_t)2 * 4 * 256 * 256 * 2;
constexpr size_t WS_WDQKV = WS_WOUT + (size_t)2 * DM * DM * 2;
constexpr size_t WS_WUQ = WS_WDQKV + (size_t)2 * NDQKV * DM * 2;
constexpr size_t WS_WUKV = WS_WUQ + (size_t)2 * NQ * QLORA * 2;
constexpr size_t WS_WO = WS_WUKV + (size_t)2 * NKV * KVLORA * 2;
constexpr size_t WS_WGU = WS_WO + (size_t)2 * DM * DM * 2;
constexpr size_t WS_WDN = WS_WGU + (size_t)4 * 2 * FF * DM * 2;
constexpr size_t WS_X = al(WS_WDN + (size_t)4 * DM * FF * 2);
constexpr size_t WS_H = WS_X + (size_t)R * DM * 4;
constexpr size_t WS_Z = WS_H + (size_t)R * DM * 2;
constexpr size_t WS_CAT = WS_Z + (size_t)R * EVEN_IN * 2;
constexpr size_t WS_ACT = WS_CAT + (size_t)R * DM * 2;
constexpr size_t WS_Q = WS_ACT + (size_t)R * FF * 2;
constexpr size_t WS_KN = WS_Q + (size_t)R * NQ * 2;
constexpr size_t WS_V = WS_KN + (size_t)R * DM * 2;
constexpr size_t WS_KR = WS_V + (size_t)R * DM * 2;
constexpr size_t WS_QA = al(WS_KR + (size_t)R * QKR * 2);
constexpr size_t WS_CKV = WS_QA + (size_t)R * QLORA * 2;
constexpr size_t WS_SLAB = al(WS_CKV + (size_t)R * KVLORA * 2);
constexpr size_t WS_END = WS_SLAB + (size_t)11 * 256 * DM * 4;

constexpr int RING_BYTES = 131072, MISC_OFF = RING_BYTES + 320, LDS_BYTES = 147456;
constexpr int NWAVES = 8;

#define XB_TMO      128
#define XB_XCNT(j)  (256  + 64 * (j))
#define XB_XSUB(j)  (1280 + 64 * (j))
#define XB_XGEN(j)  (2304 + 64 * (j))
#define XB_TOP      3328
#define XB_TOPGEN   3392
#define XCD_BAR_WORDS 3456
#define XB_SPIN_CAP (1u << 18)
__device__ __forceinline__ unsigned xb_ld(unsigned* p)              { return __hip_atomic_load(p, __ATOMIC_RELAXED, __HIP_MEMORY_SCOPE_AGENT); }
__device__ __forceinline__ unsigned xb_add(unsigned* p, unsigned v) { return __hip_atomic_fetch_add(p, v, __ATOMIC_RELAXED, __HIP_MEMORY_SCOPE_AGENT); }
__device__ __forceinline__ unsigned xb_xcc_id() { return (unsigned)__builtin_amdgcn_s_getreg((3 << 11) | 20) & 0xFu; }
#define XB_SPIN(cond, bar) do { unsigned _sp = 0; while (cond) { __builtin_amdgcn_s_sleep(1); \
    if ((++_sp & 255u) == 0u) { if (xb_ld(&(bar)[XB_TMO])) break; if (_sp > XB_SPIN_CAP) { atomicAdd(&(bar)[XB_TMO], 1u); break; } } } } while (0)
struct XcdBarrier { unsigned* bar; unsigned x; volatile LAS unsigned* st; };
__device__ __forceinline__ XcdBarrier xcd_barrier_post(unsigned* bar, volatile LAS unsigned* st) {
    XcdBarrier b; b.bar = bar; b.x = xb_xcc_id(); b.st = st;
    if (threadIdx.x == 0) (void)xb_add(&bar[XB_XCNT(b.x)], 1u);
    return b;
}
__device__ __forceinline__ void xcd_barrier_complete(unsigned* bar, unsigned x, unsigned& nloc, unsigned& nx) {
    const unsigned G = gridDim.x * gridDim.y * gridDim.z;
    unsigned sum, cnt, mine, sp = 0u;
    for (;;) {
        sum = 0u; cnt = 0u; mine = 0u;
#pragma unroll
        for (unsigned j = 0; j < 16; ++j) { const unsigned c = xb_ld(&bar[XB_XCNT(j)]); sum += c; cnt += (c > 0u) ? 1u : 0u; mine = (j == x) ? c : mine; }
        if (sum == G) break;
        __builtin_amdgcn_s_sleep(1);
        if ((++sp & 255u) == 0u) { if (xb_ld(&bar[XB_TMO])) break; if (sp > XB_SPIN_CAP) { atomicAdd(&bar[XB_TMO], 1u); break; } }
    }
    nloc = mine > 0u ? mine : 1u; nx = cnt > 0u ? cnt : 1u;
}
__device__ __attribute__((noinline)) void xcd_barrier_ni(unsigned* bar_, unsigned x_, volatile LAS unsigned* st_) {
    XcdBarrier b; b.bar = bar_; b.x = x_; b.st = st_;
    asm volatile("s_waitcnt vmcnt(0)" ::: "memory");
    __syncthreads();
    if (threadIdx.x == 0) {
        unsigned* bar = b.bar;
        __builtin_amdgcn_s_waitcnt(0);
        unsigned nloc = b.st[0], nx = b.st[1];
        if (nloc == 0u) { xcd_barrier_complete(bar, b.x, nloc, nx); b.st[0] = nloc; b.st[1] = nx; }
        const unsigned old = xb_add(&bar[XB_XSUB(b.x)], 1u);
        const unsigned gen = old / nloc;
        if (old + 1u == (gen + 1u) * nloc) {
            __builtin_amdgcn_fence(__ATOMIC_RELEASE, "agent");
            asm volatile("s_waitcnt vmcnt(0)" ::: "memory");
            const unsigned og = xb_add(&bar[XB_TOP], 1u);
            const unsigned tg = og / nx;
            if (og + 1u == (tg + 1u) * nx) xb_add(&bar[XB_TOPGEN], 1u);
            else XB_SPIN(xb_ld(&bar[XB_TOPGEN]) == tg, bar);
            __builtin_amdgcn_fence(__ATOMIC_ACQUIRE, "agent");
            xb_add(&bar[XB_XGEN(b.x)], 1u);
            asm volatile("s_waitcnt vmcnt(0)" ::: "memory");
        } else {
            XB_SPIN(xb_ld(&bar[XB_XGEN(b.x)]) == gen, bar);
            __builtin_amdgcn_fence(__ATOMIC_ACQUIRE, "agent");
            asm volatile("s_waitcnt vmcnt(0)" ::: "memory");
        }
    }
    __syncthreads();
}

struct Args { const float* in[24]; float* out; unsigned char* ws; int ph_lo, ph_hi; };

__device__ __forceinline__ void transpose_item(const float* W, int ldw, int k0, int n0, bf16_t* WT, int ldt, int drow, bool perm, const float* kscale, LAS float* scr, int lane) {
    float tv[32];
    const float* wp = W + (size_t)(k0 + (lane >> 5)) * ldw + n0 + (lane & 31);
#pragma unroll
    for (int i = 0; i < 32; ++i) tv[i] = __builtin_nontemporal_load(wp + (size_t)(2 * i) * ldw);
    if (kscale) {
#pragma unroll
        for (int i = 0; i < 32; ++i) tv[i] *= kscale[k0 + 2 * i + (lane >> 5)]; }
#pragma unroll
    for (int i = 0; i < 32; ++i) scr[(2 * i + (lane >> 5)) * 33 + (lane & 31)] = tv[i];
    asm volatile("s_waitcnt lgkmcnt(0)" ::: "memory");
    const int c = lane & 7;
#pragma unroll
    for (int j = 0; j < 4; ++j) { const int nn = (lane >> 3) + 8 * j; const LAS float* s = scr + (8 * c) * 33 + nn;
        u32x4 o; o.x = cvt_pk_bf16(s[0 * 33], s[1 * 33]); o.y = cvt_pk_bf16(s[2 * 33], s[3 * 33]); o.z = cvt_pk_bf16(s[4 * 33], s[5 * 33]); o.w = cvt_pk_bf16(s[6 * 33], s[7 * 33]);
        const int dn = perm ? (2 * (nn & 15) + (nn >> 4)) : nn;
        *(u32x4*)(WT + (size_t)(drow + dn) * ldt + k0 + 8 * c) = o; }
    asm volatile("s_waitcnt lgkmcnt(0)" ::: "memory");
}
struct TJob { const float* W; int ldw, K, col0, ncols; bf16_t* WT; int ldt, kind, drow0; const float* kscale; };
__device__ __forceinline__ long tjob_items(const TJob& j) { return (long)(j.K / 64) * (j.ncols / 32); }
__device__ __forceinline__ void tjob_run(const TJob& j, long item, LAS float* scr, int lane) {
    const int nblk = j.ncols / 32, kb = (int)(item / nblk), nb = (int)(item % nblk), n0 = j.col0 + 32 * nb, rel = 32 * nb;
    int drow; bool perm = false;
    if (j.kind == 1) drow = 256 * (rel / 128) + (rel % 128);
    else if (j.kind == 2) drow = 256 * (rel / 128) + 128 + (rel % 128);
    else { drow = j.drow0 + rel; if (j.kind == 3) perm = (rel % QHD) >= QKN; if (j.kind == 4) perm = true; }
    transpose_item(j.W, j.ldw, 64 * kb, n0, j.WT, j.ldt, drow, perm, j.kscale, scr, lane);
}
constexpr int NTJOBS = 2 * (2 + 4) + 2 * 6 + 4 * 3;
__device__ __forceinline__ TJob get_tjob(unsigned char* ws, int id) {
    TJob j{}; j.kscale = nullptr; j.kind = 0; j.drow0 = 0; j.col0 = 0;
    if (id < 12) { const int l = id / 6, s = id % 6;
        if (s == 0) { j.W = INP(8) + (size_t)l * DM * EVEN_IN; j.ldw = EVEN_IN; j.K = DM; j.col0 = 1024; j.ncols = 3072; j.WT = (bf16_t*)(ws + WS_WIN) + (size_t)l * EVEN_IN * DM; j.ldt = DM; j.drow0 = 1024; }
        else if (s == 1) { j.W = INP(12) + (size_t)l * DM * DM; j.ldw = DM; j.K = DM; j.ncols = DM; j.WT = (bf16_t*)(ws + WS_WOUT) + (size_t)l * DM * DM; j.ldt = DM; }
        else { const int g = s - 2; j.W = INP(9) + (size_t)(l * 4 + g) * 65536; j.ldw = 256; j.K = 256; j.ncols = 256; j.WT = (bf16_t*)(ws + WS_POOLT) + (size_t)(l * 4 + g) * 65536; j.ldt = 256; }
    } else if (id < 24) { const int l = (id - 12) / 6, s = (id - 12) % 6;
        bf16_t* wd = (bf16_t*)(ws + WS_WDQKV) + (size_t)l * NDQKV * DM;
        if (s == 0) { j.W = INP(13) + (size_t)l * DM * QLORA; j.ldw = QLORA; j.K = DM; j.ncols = QLORA; j.WT = wd; j.ldt = DM; }
        else if (s == 1) { j.W = INP(16) + (size_t)l * DM * 576; j.ldw = 576; j.K = DM; j.ncols = KVLORA; j.WT = wd; j.ldt = DM; j.drow0 = 512; }
        else if (s == 2) { j.W = INP(16) + (size_t)l * DM * 576; j.ldw = 576; j.K = DM; j.col0 = 512; j.ncols = 64; j.WT = wd; j.ldt = DM; j.drow0 = 1024; j.kind = 4; }
        else if (s == 3) { j.W = INP(15) + (size_t)l * QLORA * NQ; j.ldw = NQ; j.K = QLORA; j.ncols = NQ; j.WT = (bf16_t*)(ws + WS_WUQ) + (size_t)l * NQ * QLORA; j.ldt = QLORA; j.kind = 3; j.kscale = INP(14) + l * QLORA; }
        else if (s == 4) { j.W = INP(18) + (size_t)l * KVLORA * NKV; j.ldw = NKV; j.K = KVLORA; j.ncols = NKV; j.WT = (bf16_t*)(ws + WS_WUKV) + (size_t)l * NKV * KVLORA; j.ldt = KVLORA; j.kscale = INP(17) + l * KVLORA; }
        else { j.W = INP(19) + (size_t)l * DM * DM; j.ldw = DM; j.K = DM; j.ncols = DM; j.WT = (bf16_t*)(ws + WS_WO) + (size_t)l * DM * DM; j.ldt = DM; }
    } else { const int l = (id - 24) / 3, s = (id - 24) % 3;
        if (s == 0) { j.W = INP(20) + (size_t)l * DM * FF; j.ldw = FF; j.K = DM; j.ncols = FF; j.WT = (bf16_t*)(ws + WS_WGU) + (size_t)l * 2 * FF * DM; j.ldt = DM; j.kind = 1; }
        else if (s == 1) { j.W = INP(21) + (size_t)l * DM * FF; j.ldw = FF; j.K = DM; j.ncols = FF; j.WT = (bf16_t*)(ws + WS_WGU) + (size_t)l * 2 * FF * DM; j.ldt = DM; j.kind = 2; }
        else { j.W = INP(22) + (size_t)l * FF * DM; j.ldw = DM; j.K = FF; j.ncols = DM; j.WT = (bf16_t*)(ws + WS_WDN) + (size_t)l * DM * FF; j.ldt = FF; }
    }
    return j;
}

__device__ __forceinline__ void prologue(unsigned char* ws, LAS unsigned char* lds, int gw, int NGW, int wave, int lane, int njobs) {
    {
        float* MOD = (float*)(ws + WS_MOD);
        const float* c0 = INP(1); const float* c1 = INP(3);
        LAS float* red = (LAS float*)lds;
        const int bxp = gw / NWAVES, Gp = NGW / NWAVES, tidp = wave * 64 + lane;
        for (int task = bxp; task < 4 * 64; task += Gp) {
            const int l = task / 64, cg = task % 64, col = cg * 192 + 3 * lane;
            const float* Wp = INP(4) + ((size_t)l * DM + wave * 256) * (6 * DM) + col;
            float s0[3] = {0.f, 0.f, 0.f}, s1[3] = {0.f, 0.f, 0.f};
#pragma unroll 1
            for (int kb = 0; kb < 256; kb += 64) {
                const float x0 = c0[wave * 256 + kb + lane], x1 = c1[wave * 256 + kb + lane];
                const float sv0 = x0 / (1.f + __expf(-x0)), sv1 = x1 / (1.f + __expf(-x1));
#pragma unroll 8
                for (int k = 0; k < 64; ++k) { const float* wp = Wp + (size_t)(kb + k) * (6 * DM);
                    const float w0 = __builtin_nontemporal_load(wp), w1 = __builtin_nontemporal_load(wp + 1), w2 = __builtin_nontemporal_load(wp + 2);
                    const float a0 = __builtin_bit_cast(float, __builtin_amdgcn_readlane(__builtin_bit_cast(int, sv0), k)), a1 = __builtin_bit_cast(float, __builtin_amdgcn_readlane(__builtin_bit_cast(int, sv1), k));
                    s0[0] += w0 * a0; s0[1] += w1 * a0; s0[2] += w2 * a0; s1[0] += w0 * a1; s1[1] += w1 * a1; s1[2] += w2 * a1; }
            }
#pragma unroll
            for (int e = 0; e < 3; ++e) { red[(wave * 2 + 0) * 192 + 3 * lane + e] = s0[e]; red[(wave * 2 + 1) * 192 + 3 * lane + e] = s1[e]; }
            __syncthreads();
            if (tidp < 384) { const int s = tidp / 192, cc = tidp % 192; float acc = INP(5)[(size_t)l * 6 * DM + cg * 192 + cc];
#pragma unroll
              for (int w = 0; w < NWAVES; ++w) acc += red[(w * 2 + s) * 192 + cc];
              MOD[((size_t)l * 2 + s) * 6 * DM + cg * 192 + cc] = acc; }
            __syncthreads();
        }
    }
    {
        LAS float* scr = (LAS float*)(lds + wave * 16384);
        long base = 0;
        for (int id = 0; id < njobs; ++id) {
            const TJob j = get_tjob(ws, id); const long n = tjob_items(j);
            long first = ((long)gw - base % NGW + NGW) % NGW;
            for (long it = first; it < n; it += NGW) tjob_run(j, it, scr, lane);
            base += n;
        }
    }
    {
        bf16_t* WB = (bf16_t*)(ws + WS_WINB);
        const long n8 = (long)2 * DM * 1024 / 8;
        for (long i = (long)gw * 64 + lane; i < n8; i += (long)NGW * 64) { const long e = i * 8; const int l = (int)(e / ((long)DM * 1024)); const long rem = e % ((long)DM * 1024); const int k = (int)(rem / 1024), m = (int)(rem % 1024);
            const float* s = INP(8) + ((size_t)l * DM + k) * EVEN_IN + m; const f32x4 v0 = *(const f32x4*)s, v1 = *(const f32x4*)(s + 4);
            *(u32x4*)(WB + e) = pack8(v0, v1); }
    }
    {
        float* TAB = (float*)(ws + WS_TAB);
        for (int i = gw * 64 + lane; i < 128 * 16; i += NGW * 64) { const int pos = i >> 4, f = i & 15; const float inv = powf(10000.f, -(float)f / 16.f); const float ang = (float)pos * inv; TAB[2 * i] = cosf(ang); TAB[2 * i + 1] = sinf(ang); }
        const long nz = (long)2 * (NDQKV - 1088) * DM / 8;
        for (long i = (long)gw * 64 + lane; i < nz; i += (long)NGW * 64) { const long e = i * 8; const int l = (int)(e / ((long)(NDQKV - 1088) * DM)); const long rem = e % ((long)(NDQKV - 1088) * DM);
            *(u32x4*)((bf16_t*)(ws + WS_WDQKV) + (size_t)l * NDQKV * DM + (size_t)1088 * DM + rem) = (u32x4){0u, 0u, 0u, 0u}; }
    }
}

constexpr int DEF_PER_LAYER = 3 * 5632;
__device__ __forceinline__ void deferred_convert(unsigned char* ws, LAS unsigned char* lds, int L, int r_begin, int r_cap, int rank, int quota, int wave, int lane) {
    LAS float* scr = (LAS float*)(lds + wave * 16384);
    for (int k = wave; k < quota; k += NWAVES) {
        const int r = r_begin + rank * quota + k; if (r >= r_cap) break;
        const int s = r / 5632;
        const TJob j = get_tjob(ws, 24 + 3 * L + s); tjob_run(j, r - s * 5632, scr, lane);
    }
}

__device__ __forceinline__ void norm_mod_phase(const float* xl, const float* xc, const float* g, const float* modl, const float* modc, int which, bf16_t* H, int gw, int NGW, int lane, int nrows) {
#pragma unroll 1
    for (int pass = 0; pass < 2; ++pass) {
        const int rlo = pass ? SEQ : 0, rhi = pass ? nrows : (nrows < SEQ ? nrows : SEQ);
        if (rlo >= rhi) continue;
        const float* mod = pass ? modc : modl; const float* xb = pass ? xc : xl;
        const float* sh = mod + (which ? 3 : 0) * DM; const float* sc = sh + DM;
        f32x4 A[8], B[8];
#pragma unroll
        for (int j = 0; j < 8; ++j) { const int c = 256 * j + 4 * lane; A[j] = *(const f32x4*)(g + c); B[j] = *(const f32x4*)(sc + c); }
        __builtin_amdgcn_sched_barrier(0);
#pragma unroll
        for (int j = 0; j < 8; ++j) { const int c = 256 * j + 4 * lane; A[j] = A[j] * (B[j] + 1.f); B[j] = *(const f32x4*)(sh + c); }
        for (int row = rlo + gw; row < rhi; row += NGW) {
            const f32x4* xr = (const f32x4*)(xb + (size_t)row * DM) + lane; f32x4 v[8]; float ss = 0.f;
#pragma unroll
            for (int j = 0; j < 8; ++j) v[j] = __builtin_nontemporal_load(xr + 64 * j);
            asm volatile("" : "+v"(v[0]), "+v"(v[1]), "+v"(v[2]), "+v"(v[3]), "+v"(v[4]), "+v"(v[5]), "+v"(v[6]), "+v"(v[7]));
#pragma unroll
            for (int j = 0; j < 8; ++j) ss += (v[j][0] * v[j][0] + v[j][1] * v[j][1]) + (v[j][2] * v[j][2] + v[j][3] * v[j][3]);
            const float rstd = __builtin_amdgcn_rsqf(wave_sum(ss) * (1.f / DM) + EPS);
            u32x2* o = (u32x2*)(H + (size_t)row * DM) + lane;
#pragma unroll
            for (int j = 0; j < 8; ++j) { const f32x4 y = v[j] * rstd * A[j] + B[j]; u32x2 w; w.x = cvt_pk_bf16(y[0], y[1]); w.y = cvt_pk_bf16(y[2], y[3]); o[64 * j] = w; }
        }
    }
}
__device__ __forceinline__ void norm_mod_phase16(const bf16_t* X, const float* g, const float* mod, int which, bf16_t* H, int gw, int NGW, int lane) {
    const float* sh = mod + (which ? 3 : 0) * DM; const float* sc = sh + DM;
    f32x4 A[4][2], B[4][2];
#pragma unroll
    for (int j = 0; j < 4; ++j)
#pragma unroll
        for (int h = 0; h < 2; ++h) { const int c = 512 * j + 8 * lane + 4 * h; A[j][h] = *(const f32x4*)(g + c); B[j][h] = *(const f32x4*)(sc + c); }
    __builtin_amdgcn_sched_barrier(0);
#pragma unroll
    for (int j = 0; j < 4; ++j)
#pragma unroll
        for (int h = 0; h < 2; ++h) { const int c = 512 * j + 8 * lane + 4 * h; A[j][h] = A[j][h] * (B[j][h] + 1.f); B[j][h] = *(const f32x4*)(sh + c); }
    for (int row = gw; row < SEQ; row += 2 * NGW) {
        const int row2 = row + NGW; const bool has2 = row2 < SEQ; const int r2 = has2 ? row2 : row;
        const u32x4* xr = (const u32x4*)(X + (size_t)row * DM) + lane; const u32x4* xs = (const u32x4*)(X + (size_t)r2 * DM) + lane;
        u32x4 ra[4], rb[4];
#pragma unroll
        for (int j = 0; j < 4; ++j) ra[j] = xr[64 * j];
#pragma unroll
        for (int j = 0; j < 4; ++j) rb[j] = xs[64 * j];
        f32x4 v[4][2], w[4][2]; float ss = 0.f, st = 0.f;
#pragma unroll
        for (int j = 0; j < 4; ++j) { xunpack8(ra[j], v[j][0], v[j][1]);
#pragma unroll
            for (int h = 0; h < 2; ++h) ss += (v[j][h][0] * v[j][h][0] + v[j][h][1] * v[j][h][1]) + (v[j][h][2] * v[j][h][2] + v[j][h][3] * v[j][h][3]); }
#pragma unroll
        for (int j = 0; j < 4; ++j) { xunpack8(rb[j], w[j][0], w[j][1]);
#pragma unroll
            for (int h = 0; h < 2; ++h) st += (w[j][h][0] * w[j][h][0] + w[j][h][1] * w[j][h][1]) + (w[j][h][2] * w[j][h][2] + w[j][h][3] * w[j][h][3]); }
        const float rstd = __builtin_amdgcn_rsqf(wave_sum(ss) * (1.f / DM) + EPS), rstd2 = __builtin_amdgcn_rsqf(wave_sum(st) * (1.f / DM) + EPS);
        u32x4* o = (u32x4*)(H + (size_t)row * DM) + lane;
#pragma unroll
        for (int j = 0; j < 4; ++j) o[64 * j] = pack8(v[j][0] * rstd * A[j][0] + B[j][0], v[j][1] * rstd * A[j][1] + B[j][1]);
        if (has2) { u32x4* o2 = (u32x4*)(H + (size_t)row2 * DM) + lane;
#pragma unroll
            for (int j = 0; j < 4; ++j) o2[64 * j] = pack8(w[j][0] * rstd2 * A[j][0] + B[j][0], w[j][1] * rstd2 * A[j][1] + B[j][1]); }
    }
}
__device__ __forceinline__ void final_norm_phase(const bf16_t* X, const float* g, float* out, int gw, int NGW, int lane) {
    f32x4 G[4][2];
#pragma unroll
    for (int j = 0; j < 4; ++j)
#pragma unroll
        for (int h = 0; h < 2; ++h) G[j][h] = *(const f32x4*)(g + 512 * j + 8 * lane + 4 * h);
    for (int row = gw; row < SEQ; row += NGW) {
        const u32x4* xr = (const u32x4*)(X + (size_t)row * DM) + lane; f32x4 v[4][2]; float ss = 0.f;
#pragma unroll
        for (int j = 0; j < 4; ++j) { xunpack8(xr[64 * j], v[j][0], v[j][1]);
#pragma unroll
            for (int h = 0; h < 2; ++h) ss += (v[j][h][0] * v[j][h][0] + v[j][h][1] * v[j][h][1]) + (v[j][h][2] * v[j][h][2] + v[j][h][3] * v[j][h][3]); }
        const float rstd = __builtin_amdgcn_rsqf(wave_sum(ss) * (1.f / DM) + EPS);
        float* o = out + (size_t)row * DM + 8 * lane;
#pragma unroll
        for (int j = 0; j < 4; ++j) { *(f32x4*)(o + 512 * j) = v[j][0] * rstd * G[j][0]; *(f32x4*)(o + 512 * j + 4) = v[j][1] * rstd * G[j][1]; }
    }
}
template <int S>
__device__ __forceinline__ void ctx_norm_phase(const float* __restrict__ x32, const bf16_t* x16, bf16_t* Xc, const bf16_t* __restrict__ slab, const float* __restrict__ gate, const float* __restrict__ g, const float* __restrict__ modc, int which, bf16_t* __restrict__ Hc, LAS float* red, int bx, int G, int tid) {
    const int col = 4 * tid, lane = tid & 63, wave = tid >> 6;
    const float* sh = modc + (which ? 3 : 0) * DM; const float* sc = sh + DM;
    for (int r = bx; r < CTXL; r += G) {
        f32x4 v; u32x2 sw[S > 0 ? S : 1];
        if (x32) v = *(const f32x4*)(x32 + (size_t)r * DM + col);
        else { const u32x2 w = *(const u32x2*)(x16 + (size_t)r * DM + col); const f32x2 p = xun(w.x), q = xun(w.y); v = (f32x4){p[0], p[1], q[0], q[1]}; }
#pragma unroll
        for (int s = 0; s < S; ++s) sw[s] = *(const u32x2*)(slab + ((size_t)s * 256 + r) * DM + col);
        const f32x4 gv = *(const f32x4*)(g + col), scv = *(const f32x4*)(sc + col), shv = *(const f32x4*)(sh + col);
        if (S > 0) { const f32x4 gt = *(const f32x4*)(gate + col); f32x4 a = {0.f, 0.f, 0.f, 0.f};
#pragma unroll
            for (int s = 0; s < S; ++s) { const f32x2 p = xun(sw[s].x), q = xun(sw[s].y); a += (f32x4){p[0], p[1], q[0], q[1]}; }
            v += gt * a;
            u32x2 w; w.x = xpk(v[0], v[1]); w.y = xpk(v[2], v[3]); *(u32x2*)(Xc + (size_t)r * DM + col) = w;
            const f32x2 p = xun(w.x), q = xun(w.y); v = (f32x4){p[0], p[1], q[0], q[1]}; }
        float ss = wave_sum((v[0] * v[0] + v[1] * v[1]) + (v[2] * v[2] + v[3] * v[3]));
        if (lane == 0) red[wave] = ss;
        __syncthreads();
        float tot = 0.f;
#pragma unroll
        for (int w = 0; w < NWAVES; ++w) tot += red[w];
        __syncthreads();
        const float rstd = __builtin_amdgcn_rsqf(tot * (1.f / DM) + EPS);
        const f32x4 A = gv * (scv + 1.f), y = v * rstd * A + shv;
        u32x2 w; w.x = cvt_pk_bf16(y[0], y[1]); w.y = cvt_pk_bf16(y[2], y[3]); *(u32x2*)(Hc + (size_t)r * DM + col) = w;
    }
}
__device__ __forceinline__ void ld8f(const bf16_t* p, float (&f)[8]) { const u32x4 w = *(const u32x4*)p; f[0] = bf_lo(w.x); f[1] = bf_hi(w.x); f[2] = bf_lo(w.y); f[3] = bf_hi(w.y); f[4] = bf_lo(w.z); f[5] = bf_hi(w.z); f[6] = bf_lo(w.w); f[7] = bf_hi(w.w); }
__device__ __forceinline__ void ld8s(const bf16_t* ZS, int q, int c, float (&f)[8]) {
    f32x4 a = {0.f, 0.f, 0.f, 0.f}, b = a;
#pragma unroll
    for (int s = 0; s < 4; ++s) { f32x4 x, y; xunpack8(*(const u32x4*)(ZS + ((size_t)s * 256 + q) * EVEN_IN + c), x, y); a += x; b += y; }
    f[0] = a[0]; f[1] = a[1]; f[2] = a[2]; f[3] = a[3]; f[4] = b[0]; f[5] = b[1]; f[6] = b[2]; f[7] = b[3];
}
__device__ __forceinline__ void ld4s_raw(const bf16_t* __restrict__ ZS, int q, int c, u32x4 (&r)[4]) {
#pragma unroll
    for (int s = 0; s < 4; ++s) r[s] = *(const u32x4*)(ZS + ((size_t)s * 256 + q) * EVEN_IN + c);
}
__device__ __forceinline__ void sum4s(const u32x4 (&r)[4], float (&f)[8]) {
    f32x4 a = {0.f, 0.f, 0.f, 0.f}, b = a;
#pragma unroll
    for (int s = 0; s < 4; ++s) { f32x4 x, y; xunpack8(r[s], x, y); a += x; b += y; }
    f[0] = a[0]; f[1] = a[1]; f[2] = a[2]; f[3] = a[3]; f[4] = b[0]; f[5] = b[1]; f[6] = b[2]; f[7] = b[3];
}
__device__ __forceinline__ void acc8m(float (&s)[8], const u32x4 w, float m) {
    s[0] += m * bf_lo(w.x); s[1] += m * bf_hi(w.x); s[2] += m * bf_lo(w.y); s[3] += m * bf_hi(w.y); s[4] += m * bf_lo(w.z); s[5] += m * bf_hi(w.z); s[6] += m * bf_lo(w.w); s[7] += m * bf_hi(w.w);
}
__device__ __forceinline__ void up8(const u32x4 w, float (&f)[8]) { f[0] = bf_lo(w.x); f[1] = bf_hi(w.x); f[2] = bf_lo(w.y); f[3] = bf_hi(w.y); f[4] = bf_lo(w.z); f[5] = bf_hi(w.z); f[6] = bf_lo(w.w); f[7] = bf_hi(w.w); }
__device__ __forceinline__ void mixer_ctx_token(const bf16_t* __restrict__ ZS, const float* __restrict__ convw, bf16_t* __restrict__ CAT, int tl, int ch) {
    constexpr int n = CTXL; const int t = SEQ + tl;
    float o[8], f[8];
    if (ch < 128) {
        const int c = 8 * ch, hw = 1 << (c >> 8); const int lo = (tl - hw) < 0 ? 0 : (tl - hw), hi = (tl + hw) > n ? n : (tl + hw);
        float s[8] = {0.f, 0.f, 0.f, 0.f, 0.f, 0.f, 0.f, 0.f};
#pragma unroll 1
        for (int qb = tl - hw; qb < tl + hw; qb += 4) {
            u32x4 rw[4][4];
#pragma unroll
            for (int j = 0; j < 4; ++j) { const int q = qb + j, qc = q < 0 ? 0 : (q > n - 1 ? n - 1 : q); ld4s_raw(ZS, qc, c, rw[j]); }
#pragma unroll
            for (int j = 0; j < 4; ++j) { const int q = qb + j; const float m = (q >= 0 && q < n && q < tl + hw) ? 1.f : 0.f; float fa[8]; sum4s(rw[j], fa);
#pragma unroll
                for (int e = 0; e < 8; ++e) s[e] += m * fa[e]; }
        }
        { u32x4 rw[4]; ld4s_raw(ZS, tl, c, rw); sum4s(rw, f); }
        const float ic = 1.f / (float)(hi - lo);
#pragma unroll
        for (int e = 0; e < 8; ++e) o[e] = s[e] * ic - f[e];
        *(u32x4*)(CAT + (size_t)t * DM + c) = pack8((f32x4){o[0], o[1], o[2], o[3]}, (f32x4){o[4], o[5], o[6], o[7]});
    } else {
        const int c = 8 * (ch - 128); float cv[8] = {0.f, 0.f, 0.f, 0.f, 0.f, 0.f, 0.f, 0.f};
        u32x4 rg[3][4], rv[3][4], rf[4];
#pragma unroll
        for (int k = 0; k < 3; ++k) { const int q = tl + k - 1, qc = q < 0 ? 0 : (q > n - 1 ? n - 1 : q); ld4s_raw(ZS, qc, 2048 + c, rg[k]); ld4s_raw(ZS, qc, 3072 + c, rv[k]); }
        ld4s_raw(ZS, tl, 1024 + c, rf);
#pragma unroll
        for (int k = 0; k < 3; ++k) { const int q = tl + k - 1; const float m = (q >= 0 && q < n) ? 1.f : 0.f; float g[8], v[8]; sum4s(rg[k], g); sum4s(rv[k], v);
            const f32x4 w0 = *(const f32x4*)(convw + k * 1024 + c), w1 = *(const f32x4*)(convw + k * 1024 + c + 4);
#pragma unroll
            for (int e = 0; e < 4; ++e) { cv[e] += m * g[e] * v[e] * w0[e]; cv[4 + e] += m * g[4 + e] * v[4 + e] * w1[e]; } }
        sum4s(rf, f);
#pragma unroll
        for (int e = 0; e < 8; ++e) o[e] = f[e] * cv[e];
        *(u32x4*)(CAT + (size_t)t * DM + 1024 + c) = pack8((f32x4){o[0], o[1], o[2], o[3]}, (f32x4){o[4], o[5], o[6], o[7]});
    }
}
__device__ __forceinline__ void mixer_run16(const bf16_t* __restrict__ Z, const float* __restrict__ convw, bf16_t* __restrict__ CAT, int t0, int ch) {
    if (ch < 128) {
        const int c = 8 * ch, hw = 1 << (c >> 8);
        const bf16_t* Zc = Z + c;
        float s[8] = {0.f, 0.f, 0.f, 0.f, 0.f, 0.f, 0.f, 0.f};
#pragma unroll 1
        for (int qb = t0 - hw; qb < t0 + hw; qb += 4) {
            u32x4 w[4];
#pragma unroll
            for (int j = 0; j < 4; ++j) { const int q = qb + j, qc = q < 0 ? 0 : (q > SEQ - 1 ? SEQ - 1 : q); w[j] = *(const u32x4*)(Zc + (size_t)qc * EVEN_IN); }
#pragma unroll
            for (int j = 0; j < 4; ++j) { const int q = qb + j; acc8m(s, w[j], (q >= 0 && q < SEQ && q < t0 + hw) ? 1.f : 0.f); }
        }
#pragma unroll 1
        for (int i0 = 0; i0 < 16; i0 += 4) {
            u32x4 wc[4], wp[4], wm[4];
#pragma unroll
            for (int i = 0; i < 4; ++i) { const int t = t0 + i0 + i, tp = (t + hw) > SEQ - 1 ? SEQ - 1 : (t + hw), tm = (t - hw) < 0 ? 0 : (t - hw);
                wc[i] = *(const u32x4*)(Zc + (size_t)t * EVEN_IN); wp[i] = *(const u32x4*)(Zc + (size_t)tp * EVEN_IN); wm[i] = *(const u32x4*)(Zc + (size_t)tm * EVEN_IN); }
#pragma unroll
            for (int i = 0; i < 4; ++i) { const int t = t0 + i0 + i; const int lo = (t - hw) < 0 ? 0 : (t - hw), hi = (t + hw) > SEQ ? SEQ : (t + hw);
                const float ic = 1.f / (float)(hi - lo); float f[8], o[8]; up8(wc[i], f);
#pragma unroll
                for (int e = 0; e < 8; ++e) o[e] = s[e] * ic - f[e];
                *(u32x4*)(CAT + (size_t)t * DM + c) = pack8((f32x4){o[0], o[1], o[2], o[3]}, (f32x4){o[4], o[5], o[6], o[7]});
                acc8m(s, wp[i], (t + hw < SEQ) ? 1.f : 0.f); acc8m(s, wm[i], (t - hw >= 0) ? -1.f : 0.f); }
        }
    } else {
        const int c = 8 * (ch - 128); const bf16_t* Zb = Z + 1024 + c; const bf16_t* Zg = Z + 2048 + c; const bf16_t* Zv = Z + 3072 + c;
        float up[8], uc[8], w0[8], w1[8], w2[8];
#pragma unroll
        for (int e = 0; e < 8; ++e) { w0[e] = convw[c + e]; w1[e] = convw[1024 + c + e]; w2[e] = convw[2048 + c + e]; }
        { const int tq = t0 > 0 ? t0 - 1 : 0; const float m = t0 > 0 ? 1.f : 0.f;
          const u32x4 a = *(const u32x4*)(Zg + (size_t)tq * EVEN_IN), b = *(const u32x4*)(Zv + (size_t)tq * EVEN_IN), a2 = *(const u32x4*)(Zg + (size_t)t0 * EVEN_IN), b2 = *(const u32x4*)(Zv + (size_t)t0 * EVEN_IN);
          float x[8], y[8]; up8(a, x); up8(b, y);
#pragma unroll
          for (int e = 0; e < 8; ++e) up[e] = m * x[e] * y[e];
          up8(a2, x); up8(b2, y);
#pragma unroll
          for (int e = 0; e < 8; ++e) uc[e] = x[e] * y[e]; }
#pragma unroll 1
        for (int i0 = 0; i0 < 16; i0 += 4) {
            u32x4 g[4], v[4], fb[4];
#pragma unroll
            for (int i = 0; i < 4; ++i) { const int t = t0 + i0 + i, tn = (t + 1) > SEQ - 1 ? SEQ - 1 : (t + 1);
                g[i] = *(const u32x4*)(Zg + (size_t)tn * EVEN_IN); v[i] = *(const u32x4*)(Zv + (size_t)tn * EVEN_IN); fb[i] = *(const u32x4*)(Zb + (size_t)t * EVEN_IN); }
#pragma unroll
            for (int i = 0; i < 4; ++i) { const int t = t0 + i0 + i; const float m = (t + 1 < SEQ) ? 1.f : 0.f; float x[8], y[8], f[8], o[8]; up8(g[i], x); up8(v[i], y); up8(fb[i], f);
#pragma unroll
                for (int e = 0; e < 8; ++e) { const float un = m * x[e] * y[e]; o[e] = f[e] * (up[e] * w0[e] + uc[e] * w1[e] + un * w2[e]); up[e] = uc[e]; uc[e] = un; }
                *(u32x4*)(CAT + (size_t)t * DM + 1024 + c) = pack8((f32x4){o[0], o[1], o[2], o[3]}, (f32x4){o[4], o[5], o[6], o[7]}); }
        }
    }
}
__device__ __forceinline__ void mixer_phase(const bf16_t* Z, const bf16_t* ZS, const float* convw, bf16_t* CAT, int wg, int nwg, int tid) {
    const int ch = tid & 255, tsub = tid >> 8;
    for (int blk = wg; blk < SEQ / 32; blk += nwg) {
        mixer_run16(Z, convw, CAT, blk * 32 + 16 * tsub, ch);
        if (tsub == 0) mixer_ctx_token(ZS, convw, CAT, blk, ch);
    }
}

template <class Epi, class Sched>
__device__ __forceinline__ void run_gemm(LAS unsigned char* lds, const pg8::Gemm g, const Sched& S, const Epi& E) {
#if MK_SIMPLE_GEMM
    pg8::gemm_simple<Epi, Sched>(g, S, E);
#else
    pg8::gemm_phase<Epi, Sched, true, true>(lds, g, S, E);
#endif
}
constexpr int N_PHASES = 1 + 8 * DEPTH + 1;

__global__ void __launch_bounds__(NWAVES * 64, 2) mk_fwd(Args args) {
    extern __shared__ __attribute__((aligned(16))) unsigned char lds_raw[];
    LAS unsigned char* lds = (LAS unsigned char*)lds_raw;
    volatile LAS unsigned* MISC = (volatile LAS unsigned*)(lds + MISC_OFF);
    const int G = gridDim.x, NGW = G * NWAVES;
    for (int u = threadIdx.x; u < (LDS_BYTES - RING_BYTES) / 4; u += NWAVES * 64) ((LAS unsigned*)(lds + RING_BYTES))[u] = 0u;
    __syncthreads();
#if MK_ONE_LAUNCH
    XcdBarrier bar = xcd_barrier_post((unsigned*)(KARG(unsigned char*, 200) + WS_CTL) + 4096, MISC + 8);
#define GRID_BAR() xcd_barrier_ni(bar.bar, bar.x, bar.st)
#else
#define GRID_BAR() do {} while (0)
#endif
#if MK_ONE_LAUNCH
    constexpr int lo = 0, hi = N_PHASES;
#else
    const int lo = KARG(int, 208), hi = KARG(int, 212);
#endif
#define IN(k) (lo <= (k) && (k) < hi)
#ifndef PH_MASK
#define PH_MASK 0xffffffffu
#endif
#define PH_ON(b) ((PH_MASK >> (b)) & 1u)
#define SEAM(k) do { if ((k) + 1 < hi) GRID_BAR(); } while (0)
#define WSP() unsigned char* ws = KARG(unsigned char*, 200); const int tid = otid(), lane = tid & 63, wave = __builtin_amdgcn_readfirstlane(tid >> 6), bx = obid(), gw = bx * NWAVES + wave; (void)lane; (void)gw
#define MODL(l) ((const float*)(ws + WS_MOD) + (size_t)((l) * 2 + 0) * 6 * DM)
#define MODC(l) ((const float*)(ws + WS_MOD) + (size_t)((l) * 2 + 1) * 6 * DM)

    if (PH_ON(0) && IN(0)) { WSP(); prologue(ws, lds, gw, NGW, wave, lane, (G == 256) ? 26 : NTJOBS); SEAM(0); }

#pragma unroll 1
    for (int l = 0; l < DEPTH; ++l) {
        const int pb = 1 + 8 * l, i2 = l >> 1; const bool lastl = (l == DEPTH - 1);
        if (IN(pb + 0)) {
            WSP();
            const int nf = ((l & 1) == 0 && PH_ON(2) && G > 64) ? 32 : 0;
            if (PH_ON(1) && bx >= nf) { bf16_t* X = (bf16_t*)(ws + WS_X); const int gwn = gw - nf * NWAVES, NGWn = NGW - nf * NWAVES, bxn = bx - nf, Gn = G - nf;
              if (l == 0) norm_mod_phase(INP(0), INP(0), INP(6) + l * DM, MODL(l), MODC(l), 0, (bf16_t*)(ws + WS_H), gwn, NGWn, lane, SEQ);
              else norm_mod_phase16(X, INP(6) + l * DM, MODL(l), 0, (bf16_t*)(ws + WS_H), gwn, NGWn, lane);
              if (l == 0) ctx_norm_phase<0>(INP(2), X + (size_t)SEQ * DM, X + (size_t)SEQ * DM, (const bf16_t*)(ws + WS_SLAB), nullptr, INP(6) + l * DM, MODC(l), 0, (bf16_t*)(ws + WS_H) + (size_t)SEQ * DM, (LAS float*)(lds + MISC_OFF + 64), bxn, Gn, tid);
              else ctx_norm_phase<11>(nullptr, X + (size_t)SEQ * DM, X + (size_t)SEQ * DM, (const bf16_t*)(ws + WS_SLAB), MODC(l - 1) + 5 * DM, INP(6) + l * DM, MODC(l), 0, (bf16_t*)(ws + WS_H) + (size_t)SEQ * DM, (LAS float*)(lds + MISC_OFF + 64), bxn, Gn, tid); }
            if (PH_ON(2) && (l & 1) == 0) {
                pg8::Gemm g{(const bf16_t*)(ws + WS_POOLT) + (size_t)i2 * 4 * 65536, (const bf16_t*)(ws + WS_WINB) + (size_t)i2 * DM * 1024, 256, 1024, 4};
                pg8::FoldOrder S{bx}; EpiBf16 E{(bf16_t*)(ws + WS_WIN) + (size_t)i2 * EVEN_IN * DM, DM, INP(10) + i2 * 1024};
                pg8::gemm_simple<EpiBf16, pg8::FoldOrder>(g, S, E);
            }
            SEAM(pb + 0);
        }
        if ((l & 1) == 0) {
            if (PH_ON(3) && IN(pb + 1)) { WSP(); pg8::Gemm g{(const bf16_t*)(ws + WS_H), (const bf16_t*)(ws + WS_WIN) + (size_t)i2 * EVEN_IN * DM, DM, DM, DM / 64};
                pg8::LatCtxOrder S; S.so.init(SEQ / 256, EVEN_IN / 256, G, bx, DM / 64); S.ntn = EVEN_IN / 256; S.nsl = 4 * (EVEN_IN / 256); S.kchunk = DM / 4;
                EpiWithSlab<EpiBf16> E{{(bf16_t*)(ws + WS_Z), EVEN_IN, nullptr}, (bf16_t*)(ws + WS_SLAB), EVEN_IN};
                run_gemm(lds, g, S, E);
                if (G == 256 && bx >= 64) { if (l == 0) deferred_convert(ws, lds, 0, 11264, 14336, bx - 64, 16, wave, lane); else deferred_convert(ws, lds, 2, 10752, 13824, bx - 64, 16, wave, lane); }
                SEAM(pb + 1); }
            if (PH_ON(4) && IN(pb + 2)) { WSP(); mixer_phase((const bf16_t*)(ws + WS_Z), (const bf16_t*)(ws + WS_SLAB), INP(11) + (size_t)i2 * 3 * 1024, (bf16_t*)(ws + WS_CAT), bx, G, tid); SEAM(pb + 2); }
            if (PH_ON(5) && IN(pb + 3)) { WSP(); bf16_t* X = (bf16_t*)(ws + WS_X); const float* xl = (l == 0) ? INP(0) : nullptr;
                pg8::Gemm g{(const bf16_t*)(ws + WS_CAT), (const bf16_t*)(ws + WS_WOUT) + (size_t)i2 * DM * DM, DM, DM, DM / 64};
                pg8::LatCtxOrder S; S.so.init(SEQ / 256, DM / 256, G, bx, DM / 64); S.ntn = DM / 256; S.nsl = 8 * (DM / 256); S.kchunk = DM / 8;
                EpiWithSlab<EpiResid> E{{xl, X, X, MODL(l) + 2 * DM}, (bf16_t*)(ws + WS_SLAB), DM}; run_gemm(lds, g, S, E);
                if (G == 256 && bx >= 64) { if (l == 0) deferred_convert(ws, lds, 0, 14336, 16896, bx - 64, 14, wave, lane); else deferred_convert(ws, lds, 2, 13824, 16896, bx - 64, 16, wave, lane); }
                SEAM(pb + 3); }
        } else {
            if (PH_ON(6) && IN(pb + 1)) { WSP(); pg8::Gemm g{(const bf16_t*)(ws + WS_H), (const bf16_t*)(ws + WS_WDQKV) + (size_t)i2 * NDQKV * DM, DM, DM, DM / 64}; pg8::StaticOrder S; S.init(NPANEL, NDQKV / 256, G, bx, DM / 64);
                EpiDQKV E{(bf16_t*)(ws + WS_QA), (bf16_t*)(ws + WS_CKV), (bf16_t*)(ws + WS_KR), (float*)(ws + WS_SSQ), (float*)(ws + WS_SSKV), (const float*)(ws + WS_TAB)}; run_gemm(lds, g, S, E);
                if (G == 256 && bx >= 165) deferred_convert(ws, lds, l, 10752, 16896, bx - 165, 68, wave, lane);
                SEAM(pb + 1); }
            if (IN(pb + 2)) {
                if (PH_ON(7)) { WSP(); pg8::Gemm g{(const bf16_t*)(ws + WS_QA), (const bf16_t*)(ws + WS_WUQ) + (size_t)i2 * NQ * QLORA, QLORA, QLORA, QLORA / 64}; pg8::StaticOrder S; S.init(lastl ? SEQ / 256 : NPANEL, NQ / 256, G, bx, QLORA / 64);
                  EpiUQ E{(bf16_t*)(ws + WS_Q), (const float*)(ws + WS_SSQ), (const float*)(ws + WS_TAB)}; run_gemm(lds, g, S, E); }
                if (PH_ON(8)) { WSP(); pg8::Gemm g{(const bf16_t*)(ws + WS_CKV), (const bf16_t*)(ws + WS_WUKV) + (size_t)i2 * NKV * KVLORA, KVLORA, KVLORA, KVLORA / 64}; pg8::StaticOrder S; S.init(NPANEL, NKV / 256, G, G - 1 - bx, KVLORA / 64);
                  EpiUKV E{(bf16_t*)(ws + WS_KN), (bf16_t*)(ws + WS_V), (const float*)(ws + WS_SSKV)}; run_gemm(lds, g, S, E); }
                SEAM(pb + 2); }
            if (PH_ON(9) && IN(pb + 3)) {
                WSP(); LAS float* wsf = (LAS float*)(lds) + wave * 64; (void)wsf;
                const bf16_t* Qb = (const bf16_t*)(ws + WS_Q); const bf16_t* KN = (const bf16_t*)(ws + WS_KN); const bf16_t* KR = (const bf16_t*)(ws + WS_KR); const bf16_t* Vb = (const bf16_t*)(ws + WS_V); bf16_t* CAT = (bf16_t*)(ws + WS_CAT);
                const int nunits = 2 * 256 + (lastl ? 0 : NHEAD);
#pragma unroll 1
                for (int uid = bx; uid < nunits; uid += G) {
#if MK_SIMPLE_ATTN
                    if (uid < 512) att::unit_simple(Qb, KN, KR, Vb, CAT, (uid & 7) + 8 * (uid >> 8), ((uid >> 3) & 31) * 256, 0, R, wsf);
                    else att::unit_simple(Qb, KN, KR, Vb, CAT, uid - 512, SEQ, SEQ, CTXL, wsf);
#else
                    if (uid < 512) att::unit_il(Qb, KN, KR, Vb, CAT, (uid & 7) + 8 * (uid >> 8), ((uid >> 3) & 31) * 256, 0, R, lds);
                    else att::unit_il(Qb, KN, KR, Vb, CAT, uid - 512, SEQ, SEQ, CTXL, lds);
#endif
                }
                SEAM(pb + 3); }
            if (PH_ON(10) && IN(pb + 4)) { WSP(); bf16_t* X = (bf16_t*)(ws + WS_X); pg8::Gemm g{(const bf16_t*)(ws + WS_CAT), (const bf16_t*)(ws + WS_WO) + (size_t)i2 * DM * DM, DM, DM, DM / 64};
                pg8::LatCtxOrder S; S.so.init(SEQ / 256, DM / 256, G, bx, DM / 64); S.ntn = DM / 256; S.nsl = lastl ? 0 : 8 * (DM / 256); S.kchunk = DM / 8;
                EpiWithSlab<EpiResid> E{{nullptr, X, X, MODL(l) + 2 * DM}, (bf16_t*)(ws + WS_SLAB), DM}; run_gemm(lds, g, S, E); SEAM(pb + 4); }
        }
        const int fb = pb + ((l & 1) ? 5 : 4);
        if (PH_ON(11) && IN(fb)) { WSP(); bf16_t* X = (bf16_t*)(ws + WS_X); norm_mod_phase16(X, INP(7) + l * DM, MODL(l), 1, (bf16_t*)(ws + WS_H), gw, NGW, lane);
            if (!lastl) ctx_norm_phase<8>((l == 0) ? INP(2) : nullptr, X + (size_t)SEQ * DM, X + (size_t)SEQ * DM, (const bf16_t*)(ws + WS_SLAB), MODC(l) + 2 * DM, INP(7) + l * DM, MODC(l), 1,
                                          (bf16_t*)(ws + WS_H) + (size_t)SEQ * DM, (LAS float*)(lds + MISC_OFF + 64), bx, G, tid);
            SEAM(fb); }
        if (PH_ON(12) && IN(fb + 1)) { WSP(); pg8::Gemm g{(const bf16_t*)(ws + WS_H), (const bf16_t*)(ws + WS_WGU) + (size_t)l * 2 * FF * DM, DM, DM, DM / 64}; pg8::StaticOrder S; S.init(lastl ? SEQ / 256 : NPANEL, 2 * FF / 256, G, bx, DM / 64); EpiSwiGLU E{(bf16_t*)(ws + WS_ACT)};
            run_gemm(lds, g, S, E);
            if (G == 256 && !lastl && bx >= 172) deferred_convert(ws, lds, l + 1, 0, 6720, bx - 172, 80, wave, lane);
            SEAM(fb + 1); }
        if (PH_ON(13) && IN(fb + 2)) { WSP(); bf16_t* X = (bf16_t*)(ws + WS_X); pg8::Gemm g{(const bf16_t*)(ws + WS_ACT), (const bf16_t*)(ws + WS_WDN) + (size_t)l * DM * FF, FF, FF, FF / 64};
            pg8::LatCtxOrder S; S.so.init(SEQ / 256, DM / 256, G, bx, FF / 64); S.ntn = DM / 256; S.nsl = lastl ? 0 : 11 * (DM / 256); S.kchunk = FF / 11;
            EpiWithSlab<EpiResid> E{{nullptr, X, X, MODL(l) + 5 * DM}, (bf16_t*)(ws + WS_SLAB), DM}; run_gemm(lds, g, S, E);
            if (G == 256 && !lastl && bx >= 88) deferred_convert(ws, lds, l + 1, 6720, 10752, bx - 88, 24, wave, lane);
            SEAM(fb + 2); }
    }
    if (PH_ON(14) && IN(N_PHASES - 1)) { WSP(); final_norm_phase((const bf16_t*)(ws + WS_X), INP(23), KARG(float*, 192), gw, NGW, lane); }
#undef IN
#undef SEAM
}

extern "C" void kernel_launch(void* const* d_in, const int* in_sizes, int n_in, void* d_out, int out_size, void* d_ws, size_t ws_size, hipStream_t stream) {
    static int grid = 0;
    if (grid == 0) {
        if (n_in != 24 || in_sizes[0] != SEQ * DM || out_size != SEQ * DM || ws_size < WS_END) { fprintf(stderr, "kernel_launch: unexpected shapes (n_in %d, in0 %d, out %d, ws %zu < %zu)\n", n_in, n_in > 0 ? in_sizes[0] : -1, out_size, ws_size, (size_t)WS_END); grid = -1; return; }
        int dev = 0, cus = 0, per_cu = 0;
        if (hipGetDevice(&dev) != hipSuccess || hipDeviceGetAttribute(&cus, hipDeviceAttributeMultiprocessorCount, dev) != hipSuccess) { grid = -1; return; }
        if (hipFuncSetAttribute((const void*)mk_fwd, hipFuncAttributeMaxDynamicSharedMemorySize, LDS_BYTES) != hipSuccess) { fprintf(stderr, "kernel_launch: hipFuncSetAttribute failed\n"); grid = -1; return; }
        if (hipOccupancyMaxActiveBlocksPerMultiprocessor(&per_cu, (const void*)mk_fwd, NWAVES * 64, LDS_BYTES) != hipSuccess || per_cu < 1) fprintf(stderr, "kernel_launch: occupancy query says %d\n", per_cu);
        (void)hipGetLastError();
        grid = cus;
    }
    if (grid < 0) return;
    (void)hipMemsetAsync((char*)d_ws, 0, 32768, stream);
    Args a{};
    for (int i = 0; i < 24; ++i) a.in[i] = (const float*)d_in[i];
    a.out = (float*)d_out; a.ws = (unsigned char*)d_ws;
#if MK_ONE_LAUNCH
    a.ph_lo = 0; a.ph_hi = N_PHASES;
    hipLaunchKernelGGL(mk_fwd, dim3(grid), dim3(NWAVES * 64), LDS_BYTES, stream, a);
#else
    for (int k = 0; k < N_PHASES; ++k) {
        if (k >= 1 && k < N_PHASES - 1) { const int l = (k - 1) / 8, s = (k - 1) % 8; if ((l & 1) == 0 && s == 7) continue; }
        a.ph_lo = k; a.ph_hi = k + 1;
        hipLaunchKernelGGL(mk_fwd, dim3(grid), dim3(NWAVES * 64), LDS_BYTES, stream, a);
    }
#endif
    const hipError_t le = hipPeekAtLastError();
    if (le != hipSuccess) fprintf(stderr, "kernel_launch: launch failed: %s\n", hipGetErrorName(le));
}
```

```cpp
#include <hip/hip_runtime.h>
#include <cstdio>
#include <cstdint>

#ifndef MK_ONE_LAUNCH
#define MK_ONE_LAUNCH 1
#endif
#ifndef MK_SIMPLE_ATTN
#define MK_SIMPLE_ATTN 0
#endif
#ifndef MK_SIMPLE_GEMM
#define MK_SIMPLE_GEMM 0
#endif

#define LAS __attribute__((address_space(3)))
#define GAS __attribute__((address_space(1)))
typedef unsigned short bf16_t;
typedef short bf16x8 __attribute__((ext_vector_type(8)));
typedef float f32x4 __attribute__((ext_vector_type(4)));
typedef float f32x2 __attribute__((ext_vector_type(2)));
typedef float f32x16 __attribute__((ext_vector_type(16)));
typedef unsigned u32x4 __attribute__((ext_vector_type(4)));
typedef unsigned u32x2 __attribute__((ext_vector_type(2)));

constexpr int DM = 2048, SEQ = 8192, CTXL = 256, R = SEQ + CTXL, NPANEL = R / 256, DEPTH = 4;
constexpr int EVEN_IN = 4096, FF = 5632, QLORA = 512, KVLORA = 512, NHEAD = 16, QKN = 128, QKR = 64, VD = 128, QHD = QKN + QKR;
constexpr int NQ = NHEAD * QHD  , NKV = NHEAD * (QKN + VD)  , NDQKV = 1280  ;
constexpr float EPS = 1e-6f;
constexpr float QSCALE = 0.07216878364870322f * 1.4426950408889634f;

__device__ __forceinline__ unsigned cvt_pk_bf16(float lo, float hi) { unsigned r; asm volatile("v_cvt_pk_bf16_f32 %0, %1, %2" : "=v"(r) : "v"(lo), "v"(hi)); return r; }
__device__ __forceinline__ float bf_lo(unsigned w) { return __uint_as_float(w << 16); }
__device__ __forceinline__ float bf_hi(unsigned w) { return __uint_as_float(w & 0xffff0000u); }
template <int K> __device__ __forceinline__ float xor_add(float v) {
    if constexpr (K < 32) return v + __builtin_bit_cast(float, __builtin_amdgcn_ds_swizzle(__builtin_bit_cast(int, v), (K << 10) | 0x1F));
    else { auto rr = __builtin_amdgcn_permlane32_swap(__float_as_uint(v), __float_as_uint(v), false, false); return __uint_as_float(rr[0]) + __uint_as_float(rr[1]); }
}
__device__ __forceinline__ float wave_sum(float v) { v = xor_add<1>(v); v = xor_add<2>(v); v = xor_add<4>(v); v = xor_add<8>(v); v = xor_add<16>(v); return xor_add<32>(v); }

__device__ __forceinline__ int otid() { int t = threadIdx.x; asm volatile("" : "+v"(t)); return t; }
__device__ __forceinline__ int obid() { int b = blockIdx.x; asm volatile("" : "+s"(b)); return b; }
template <class T> __device__ __forceinline__ T karg_ld(int off) { const __attribute__((address_space(4))) char* k = (const __attribute__((address_space(4))) char*)__builtin_amdgcn_kernarg_segment_ptr(); asm volatile("" : "+s"(k)); return *(const __attribute__((address_space(4))) T*)(k + off); }
#define KARG(type, off) karg_ld<type>(off)
#define INP(k) KARG(const float*, 8 * (k))
namespace pg8 {
constexpr int BM = 256, BK = 64, HALF = 128, HTB = HALF * BK * 2, STAGE_BYTES = 8 * HTB, NXCD = 8, WGM = 8;
__host__ __device__ __forceinline__ int lds_byte(int r, int c) { const int st = (r >> 4) * 2 + (c >> 5), rr = r & 15, cc = c & 31, ob = rr * 64 + cc * 2; return st * 1024 + (ob ^ (((ob >> 9) & 1) << 5)); }
__host__ __device__ __forceinline__ void stage_rc(int b, int& Rr, int& C) { const int st = b / 1024, sb = b % 1024, swz = sb ^ (((sb >> 9) & 1) << 5); Rr = (st >> 1) * 16 + swz / 64; C = (st & 1) * 32 + (swz % 64) / 2; }
__host__ __device__ __forceinline__ int perm32(int rho) { const int n = rho >> 4, i = rho & 15; return 8 * (i >> 2) + 4 * n + (i & 3); }

struct Unit { int pm, pn, ka, kb, nt, aux; };
struct Gemm { const bf16_t* A; const bf16_t* Bt; int lda, ldb, nt; };

struct StaticOrder {
    int nM, nN, nwg, G, c, nt;
    __device__ void init(int nM_, int nN_, int G_, int c_, int nt_) { nM = nM_; nN = nN_; nwg = nM * nN; G = G_; c = c_; nt = nt_; }
    __device__ __forceinline__ bool next(int i, Unit& u) const {
        const long L = (long)i * G + c; if (L >= nwg) return false;
        int wgid = (int)L; { const int q = nwg / NXCD, r = nwg % NXCD, xcd = wgid % NXCD, off = wgid / NXCD; wgid = (xcd < r ? xcd * (q + 1) : r * (q + 1) + (xcd - r) * q) + off; }
        const int nig = WGM * nN, gid = wgid / nig, fm = gid * WGM, gsz = (nM - fm) < WGM ? (nM - fm) : WGM;
        u.pm = fm + ((wgid % nig) % gsz); u.pn = (wgid % nig) / gsz; u.ka = 0; u.kb = 0; u.nt = nt; u.aux = 0; return true;
    }
};
struct FoldOrder {
    int c;
    __device__ bool next(int i, Unit& u) const { if (i > 0 || c >= 32) return false; u.pm = c & 3; u.pn = c >> 2; u.ka = 0; u.kb = 256 * (c & 3); u.nt = 4; u.aux = 0; return true; }
};

struct LatCtxOrder {
    StaticOrder so; int ntn, nsl, kchunk;
    __device__ __forceinline__ bool next(int i, Unit& u) const {
        Unit a; a.pm = 0; a.pn = 0; a.ka = 0; a.kb = 0; a.nt = so.nt; a.aux = 0;
        const bool ok1 = so.next(i, a);
        const int nL = so.c < so.nwg ? (so.nwg - so.c + so.G - 1) / so.G : 0, s = so.c + (i - nL) * so.G;
        const bool ok2 = !ok1 && s >= 0 && s < nsl;
        const int sl = s / ntn, ko = sl * kchunk;
        u.pm = ok1 ? a.pm : 32; u.pn = ok1 ? a.pn : s - sl * ntn; u.aux = ok1 ? 0 : sl; u.ka = ok1 ? 0 : ko; u.kb = ok1 ? 0 : ko; u.nt = ok1 ? so.nt : kchunk / 64;
        return ok1 || ok2;
    }
};
typedef unsigned long long pg8_u64x2 __attribute__((ext_vector_type(2)));
__device__ __forceinline__ f32x4 zero4() { unsigned long long a, b; asm volatile("v_mov_b64 %0, 0" : "=v"(a)); asm volatile("v_mov_b64 %0, 0" : "=v"(b)); const pg8_u64x2 z = {a, b}; return __builtin_bit_cast(f32x4, z); }
__device__ __forceinline__ void pg8_glds(const char* sbase, unsigned voff, unsigned lds_dst) {
    asm volatile("s_mov_b32 m0, %2\n\ts_nop 0\n\tglobal_load_lds_dwordx4 %1, %0" :: "s"(sbase), "v"(voff), "s"(lds_dst) : "memory", "m0"); }
template <class Epi, class Sched>
__device__ __forceinline__ void gemm_simple(const Gemm g, const Sched& S, const Epi& E) {
    const int tid = otid(), wid = __builtin_amdgcn_readfirstlane(tid >> 6), lane = tid & 63, wr = wid >> 2, wc = wid & 3, fr = lane & 15, fq = lane >> 4;
    Unit u;
    for (int i = 0; S.next(i, u); ++i) {
        f32x4 acc[2][2][4][2];
#pragma unroll
        for (int a = 0; a < 2; ++a)
#pragma unroll
            for (int b = 0; b < 2; ++b)
#pragma unroll
                for (int m = 0; m < 4; ++m)
#pragma unroll
                    for (int n = 0; n < 2; ++n) acc[a][b][m][n] = (f32x4){0.f, 0.f, 0.f, 0.f};
        const bf16_t* A = g.A + (size_t)u.pm * 256 * g.lda + u.ka + (size_t)(64 * wr + fr) * g.lda + fq * 8;
        int rb[2];
#pragma unroll
        for (int n = 0; n < 2; ++n) { const int rho = 16 * n + fr; rb[n] = Epi::PERM ? perm32(rho) : rho; }
        const bf16_t* B = g.Bt + (size_t)u.pn * 256 * g.ldb + u.kb + (size_t)(32 * wc) * g.ldb + fq * 8;
        bf16x8 a[2][4], b[2][2], an[2][4], bn[2][2];
        const int kend = u.nt * 64;
#define GS_LOAD(DA, DB, KK) do { _Pragma("unroll") for (int ai = 0; ai < 2; ++ai) _Pragma("unroll") for (int m = 0; m < 4; ++m) DA[ai][m] = *(const bf16x8*)(A + (size_t)(128 * ai + 16 * m) * g.lda + (KK)); \
            _Pragma("unroll") for (int bj = 0; bj < 2; ++bj) _Pragma("unroll") for (int n = 0; n < 2; ++n) DB[bj][n] = *(const bf16x8*)(B + (size_t)(128 * bj + rb[n]) * g.ldb + (KK)); } while (0)
        GS_LOAD(a, b, 0);
#pragma unroll 1
        for (int kk = 0; kk < kend; kk += 32) {
            const int kn = (kk + 32 < kend) ? kk + 32 : kk;
            GS_LOAD(an, bn, kn);
#pragma unroll
            for (int ai = 0; ai < 2; ++ai)
#pragma unroll
                for (int bj = 0; bj < 2; ++bj)
#pragma unroll
                    for (int m = 0; m < 4; ++m)
#pragma unroll
                        for (int n = 0; n < 2; ++n) acc[ai][bj][m][n] = __builtin_amdgcn_mfma_f32_16x16x32_bf16(b[bj][n], a[ai][m], acc[ai][bj][m][n], 0, 0, 0);
#pragma unroll
            for (int ai = 0; ai < 2; ++ai)
#pragma unroll
                for (int m = 0; m < 4; ++m) a[ai][m] = an[ai][m];
#pragma unroll
            for (int bj = 0; bj < 2; ++bj)
#pragma unroll
                for (int n = 0; n < 2; ++n) b[bj][n] = bn[bj][n];
        }
#undef GS_LOAD
        E(acc, u, wr, wc, fr, fq);
    }
}

template <class Epi, class Sched, bool ALIGN_EPI = true, bool SP2 = true>
__device__ __forceinline__ void gemm_phase(LAS unsigned char* lds, const Gemm g, const Sched& S, const Epi& E) {
    const int tid = otid(), wid = __builtin_amdgcn_readfirstlane(tid >> 6), lane = tid & 63, wr = wid >> 2, wc = wid & 3, fr = lane & 15, fq = lane >> 4;
    unsigned voffA[2], voffB[2];
#pragma unroll
    for (int i = 0; i < 2; ++i) { int Rr, C; stage_rc(tid * 16 + i * 8192, Rr, C); const int Rb = Epi::PERM ? ((Rr & ~31) + perm32(Rr & 31)) : Rr;
        voffA[i] = (unsigned)(Rr * g.lda + C) * 2u; voffB[i] = (unsigned)(Rb * g.ldb + C) * 2u; }
    const size_t kstep = (size_t)(BK * 2);
    const size_t hstepA = (size_t)HALF * g.lda * 2, hstepB = (size_t)HALF * g.ldb * 2;
    const size_t tstepA = 2 * hstepA, tstepB = 2 * hstepB;
    const unsigned ldsw = (unsigned)wid * 1024u, lds0 = (unsigned)(uintptr_t)lds;
    const int aoff = lds_byte(wr * 64 + fr, fq * 8), boff = lds_byte(wc * 32 + fr, fq * 8);
    LAS unsigned char* ldsA = lds + aoff; LAS unsigned char* ldsB = lds + 4 * HTB + boff;
    asm volatile("" : "+v"(ldsA), "+v"(ldsB));
#define PG8_SA(b, h) (((b) * 2 + (h)) * HTB)
#define PG8_SB(b, h) ((4 + (b) * 2 + (h)) * HTB)
#define PG8_STAGE(bufoff, gbase, voff) do { _Pragma("unroll") for (int _i = 0; _i < 2; ++_i) \
        pg8_glds((const char*)(gbase), (voff)[_i], (unsigned)__builtin_amdgcn_readfirstlane((int)(lds0 + (unsigned)(bufoff) + ldsw + (unsigned)(_i * 8192)))); } while (0)
#define PG8_LDA(dst, b, h) do { _Pragma("unroll") for (int m = 0; m < 4; ++m) _Pragma("unroll") for (int k = 0; k < 2; ++k) dst[m][k] = *(const LAS bf16x8*)(ldsA + PG8_SA(b, h) + m * 2048 + k * 1024); } while (0)
#define PG8_LDB(dst, b, h) do { _Pragma("unroll") for (int n = 0; n < 2; ++n) _Pragma("unroll") for (int k = 0; k < 2; ++k) dst[n][k] = *(const LAS bf16x8*)(ldsB + ((b) * 2 + (h)) * HTB + n * 2048 + k * 1024); } while (0)
#define PG8_MMA(ai, bj, At, Bt) do { __builtin_amdgcn_s_setprio(1); _Pragma("unroll") for (int m = 0; m < 4; ++m) _Pragma("unroll") for (int n = 0; n < 2; ++n) _Pragma("unroll") for (int k = 0; k < 2; ++k) \
        acc[ai][bj][m][n] = __builtin_amdgcn_mfma_f32_16x16x32_bf16(Bt[n][k], At[m][k], acc[ai][bj][m][n], 0, 0, 0); __builtin_amdgcn_s_setprio(0); } while (0)
#define PG8_WAIT_V(n) asm volatile("s_waitcnt vmcnt(" #n ")" ::: "memory")
#define PG8_WAIT_L(n) asm volatile("s_waitcnt lgkmcnt(" #n ")" ::: "memory")
#define PG8_WAIT_L0() __builtin_amdgcn_s_waitcnt(0xC07F)
#define PG8_BAR __builtin_amdgcn_s_barrier()
#define PG8_SCHED __builtin_amdgcn_sched_barrier(0)
    Unit cur, nxt; int ui = 0;
    if (!S.next(0, cur)) return;
    f32x4 acc[2][2][4][2];
#pragma unroll
    for (int a = 0; a < 2; ++a)
#pragma unroll
        for (int b = 0; b < 2; ++b)
#pragma unroll
            for (int m = 0; m < 4; ++m)
#pragma unroll
                for (int n = 0; n < 2; ++n) acc[a][b][m][n] = zero4();
    bf16x8 At[4][2], B0[2][2], B1[2][2];
    const char* cA = (const char*)g.A + (size_t)cur.pm * tstepA + (size_t)cur.ka * 2; const char* cB = (const char*)g.Bt + (size_t)cur.pn * tstepB + (size_t)cur.kb * 2;
    if constexpr (SP2) {
        PG8_STAGE(PG8_SB(0, 0), cB, voffB); PG8_STAGE(PG8_SB(0, 1), cB + hstepB, voffB); PG8_STAGE(PG8_SA(0, 0), cA, voffA); PG8_STAGE(PG8_SA(0, 1), cA + hstepA, voffA);
        if (wr == 1) PG8_BAR;
        PG8_WAIT_V(2); PG8_BAR;
        PG8_STAGE(PG8_SB(1, 0), cB + kstep, voffB); PG8_STAGE(PG8_SA(1, 0), cA + kstep, voffA); PG8_STAGE(PG8_SB(1, 1), cB + hstepB + kstep, voffB);
        PG8_WAIT_V(6); PG8_BAR;
    } else {
        PG8_STAGE(PG8_SB(0, 0), cB, voffB); PG8_STAGE(PG8_SA(0, 0), cA, voffA); PG8_STAGE(PG8_SB(0, 1), cB + hstepB, voffB); PG8_STAGE(PG8_SA(0, 1), cA + hstepA, voffA);
        if (wr == 1) PG8_BAR;
        PG8_WAIT_V(4); PG8_BAR;
        PG8_STAGE(PG8_SB(1, 0), cB + kstep, voffB); PG8_STAGE(PG8_SA(1, 0), cA + kstep, voffA); PG8_STAGE(PG8_SB(1, 1), cB + hstepB + kstep, voffB);
        PG8_WAIT_V(6); PG8_BAR;
    }
    for (;;) {
        const bool has_next = S.next(ui + 1, nxt);
        const char* nA = has_next ? (const char*)g.A + (size_t)nxt.pm * tstepA + (size_t)nxt.ka * 2 : cA; const char* nB = has_next ? (const char*)g.Bt + (size_t)nxt.pn * tstepB + (size_t)nxt.kb * 2 : cB;
        const int nt = cur.nt;
        for (int t = 0; t < nt; t += 2) {
            const bool last = (t == nt - 2);
            const char* a1 = cA + (size_t)(t + 1) * kstep;
            const char* a2 = last ? nA : cA + (size_t)(t + 2) * kstep; const char* b2 = last ? nB : cB + (size_t)(t + 2) * kstep;
            const char* a3 = a2 + kstep; const char* b3 = b2 + kstep;
            if constexpr (SP2) {
            PG8_LDB(B0, 0, 0); PG8_LDB(B1, 0, 1); PG8_SCHED; PG8_LDA(At, 0, 0); PG8_STAGE(PG8_SA(1, 1), a1 + hstepA, voffA);
            PG8_WAIT_V(8); PG8_WAIT_L0(); PG8_BAR; PG8_MMA(0, 0, At, B0); PG8_MMA(0, 1, At, B1); PG8_BAR; PG8_SCHED;
            PG8_LDA(At, 0, 1); PG8_STAGE(PG8_SB(0, 0), b2, voffB); PG8_STAGE(PG8_SB(0, 1), b2 + hstepB, voffB); PG8_STAGE(PG8_SA(0, 0), a2, voffA);
            PG8_WAIT_V(8); PG8_WAIT_L0(); PG8_BAR; PG8_MMA(1, 0, At, B0); PG8_MMA(1, 1, At, B1); PG8_BAR; PG8_SCHED;
            PG8_LDB(B0, 1, 0); PG8_LDB(B1, 1, 1); PG8_SCHED; PG8_LDA(At, 1, 0); PG8_STAGE(PG8_SA(0, 1), a2 + hstepA, voffA);
            PG8_WAIT_V(8); PG8_WAIT_L0(); PG8_BAR; PG8_MMA(0, 0, At, B0); PG8_MMA(0, 1, At, B1); PG8_BAR; PG8_SCHED;
            PG8_LDA(At, 1, 1); PG8_STAGE(PG8_SB(1, 0), b3, voffB); PG8_STAGE(PG8_SB(1, 1), b3 + hstepB, voffB); PG8_STAGE(PG8_SA(1, 0), a3, voffA);
            PG8_WAIT_V(8); PG8_WAIT_L0(); PG8_BAR; PG8_MMA(1, 0, At, B0); PG8_MMA(1, 1, At, B1); PG8_BAR; PG8_SCHED;
            } else {
            PG8_LDB(B0, 0, 0); PG8_SCHED; PG8_LDA(At, 0, 0); PG8_STAGE(PG8_SA(1, 1), a1 + hstepA, voffA);
            PG8_WAIT_L(8); PG8_BAR; PG8_WAIT_L(0); PG8_MMA(0, 0, At, B0); PG8_BAR; PG8_SCHED;
            PG8_LDB(B1, 0, 1); PG8_STAGE(PG8_SB(0, 0), b2, voffB);
            PG8_BAR; PG8_WAIT_L(0); PG8_MMA(0, 1, At, B1); PG8_BAR;
            PG8_LDA(At, 0, 1); PG8_STAGE(PG8_SA(0, 0), a2, voffA);
            PG8_BAR; PG8_WAIT_L(0); PG8_MMA(1, 0, At, B0); PG8_BAR; PG8_SCHED;
            PG8_STAGE(PG8_SB(0, 1), b2 + hstepB, voffB);
            PG8_WAIT_V(6); PG8_BAR; PG8_MMA(1, 1, At, B1); PG8_BAR;
            PG8_LDB(B0, 1, 0); PG8_SCHED; PG8_LDA(At, 1, 0); PG8_STAGE(PG8_SA(0, 1), a2 + hstepA, voffA);
            PG8_WAIT_L(8); PG8_BAR; PG8_WAIT_L(0); PG8_MMA(0, 0, At, B0); PG8_BAR; PG8_SCHED;
            PG8_LDB(B1, 1, 1); PG8_STAGE(PG8_SB(1, 0), b3, voffB);
            PG8_BAR; PG8_WAIT_L(0); PG8_MMA(0, 1, At, B1); PG8_BAR;
            PG8_LDA(At, 1, 1); PG8_STAGE(PG8_SA(1, 0), a3, voffA);
            PG8_BAR; PG8_WAIT_L(0); PG8_MMA(1, 0, At, B0); PG8_BAR; PG8_SCHED;
            PG8_STAGE(PG8_SB(1, 1), b3 + hstepB, voffB);
            PG8_WAIT_V(6); PG8_BAR; PG8_MMA(1, 1, At, B1); PG8_BAR;
            }
        }
        if constexpr (ALIGN_EPI) { if (wr == 0) PG8_BAR; }
        E(acc, cur, wr, wc, fr, fq);
        if (!has_next) break;
#pragma unroll
        for (int a = 0; a < 2; ++a)
#pragma unroll
            for (int b = 0; b < 2; ++b)
#pragma unroll
                for (int m = 0; m < 4; ++m)
#pragma unroll
                    for (int n = 0; n < 2; ++n) acc[a][b][m][n] = zero4();
        cur = nxt; cA = nA; cB = nB; ++ui;
        if constexpr (ALIGN_EPI) { if (wr == 1) PG8_BAR; }
    }
    PG8_WAIT_V(0);
    if constexpr (!ALIGN_EPI) { if (wr == 0) PG8_BAR; }
    PG8_BAR;
#undef PG8_SA
#undef PG8_SB
#undef PG8_STAGE
#undef PG8_LDA
#undef PG8_LDB
#undef PG8_MMA
#undef PG8_WAIT_V
#undef PG8_WAIT_L
#undef PG8_WAIT_L0
#undef PG8_BAR
#undef PG8_SCHED
}
}

typedef f32x4 Acc[2][2][4][2];
__device__ __forceinline__ u32x4 pack8(f32x4 v0, f32x4 v1) { u32x4 w; w.x = cvt_pk_bf16(v0[0], v0[1]); w.y = cvt_pk_bf16(v0[2], v0[3]); w.z = cvt_pk_bf16(v1[0], v1[1]); w.w = cvt_pk_bf16(v1[2], v1[3]); return w; }

struct EpiBf16 {
    static constexpr bool PERM = true;
    bf16_t* O; int ldc; const float* rs;
    __device__ __forceinline__ void operator()(const Acc& acc, const pg8::Unit& u, int wr, int wc, int fr, int fq) const {
        const int row0 = u.pm * 256 + wr * 64 + fr, col0 = u.pn * 256 + wc * 32 + 8 * fq;
        float sv[2][4];
#pragma unroll
        for (int ai = 0; ai < 2; ++ai)
#pragma unroll
            for (int m = 0; m < 4; ++m) sv[ai][m] = rs ? rs[row0 + ai * 128 + m * 16] : 1.f;
#pragma unroll
        for (int ai = 0; ai < 2; ++ai)
#pragma unroll
            for (int m = 0; m < 4; ++m) { const int row = row0 + ai * 128 + m * 16; const float s = sv[ai][m]; bf16_t* rowp = O + (size_t)row * ldc + col0;
#pragma unroll
                for (int bj = 0; bj < 2; ++bj) *(u32x4*)(rowp + bj * 128) = pack8(acc[ai][bj][m][0] * s, acc[ai][bj][m][1] * s); }
    }
};
typedef _Float16 h2_t __attribute__((ext_vector_type(2)));
__device__ __forceinline__ unsigned xpk(float lo, float hi) { const f32x2 v = {lo, hi}; const h2_t h = __builtin_convertvector(v, h2_t); return __builtin_bit_cast(unsigned, h); }
__device__ __forceinline__ f32x2 xun(unsigned w) { return __builtin_convertvector(__builtin_bit_cast(h2_t, w), f32x2); }
__device__ __forceinline__ u32x4 xpack8(f32x4 a, f32x4 b) { u32x4 w; w.x = xpk(a[0], a[1]); w.y = xpk(a[2], a[3]); w.z = xpk(b[0], b[1]); w.w = xpk(b[2], b[3]); return w; }
__device__ __forceinline__ void xunpack8(const u32x4 w, f32x4& a, f32x4& b) { const f32x2 p = xun(w.x), q = xun(w.y), r = xun(w.z), s = xun(w.w); a = (f32x4){p[0], p[1], q[0], q[1]}; b = (f32x4){r[0], r[1], s[0], s[1]}; }
__device__ __forceinline__ void unpack8(const u32x4 w, f32x4& a, f32x4& b) { a = (f32x4){bf_lo(w.x), bf_hi(w.x), bf_lo(w.y), bf_hi(w.y)}; b = (f32x4){bf_lo(w.z), bf_hi(w.z), bf_lo(w.w), bf_hi(w.w)}; }
struct EpiResid {
    static constexpr bool PERM = true;
    const float* base32; const bf16_t* base16; bf16_t* out; const float* gate;
    __device__ __forceinline__ void operator()(const Acc& acc, const pg8::Unit& u, int wr, int wc, int fr, int fq) const {
        const int row0 = u.pm * 256 + wr * 64 + fr, col0 = u.pn * 256 + wc * 32 + 8 * fq;
        f32x4 gv[2][2];
#pragma unroll
        for (int bj = 0; bj < 2; ++bj)
#pragma unroll
            for (int n = 0; n < 2; ++n) gv[bj][n] = *(const f32x4*)(gate + col0 + bj * 128 + n * 4);
#pragma unroll
        for (int ai = 0; ai < 2; ++ai) {
            if (base32) {
#pragma unroll
                for (int mh = 0; mh < 4; mh += 2) { f32x4 xf[2][2][2];
#pragma unroll
                    for (int m = 0; m < 2; ++m)
#pragma unroll
                        for (int bj = 0; bj < 2; ++bj) { const float* p = base32 + (size_t)(row0 + ai * 128 + (mh + m) * 16) * DM + col0 + bj * 128; xf[m][bj][0] = __builtin_nontemporal_load((const f32x4*)p); xf[m][bj][1] = __builtin_nontemporal_load((const f32x4*)(p + 4)); }
#pragma unroll
                    for (int m = 0; m < 2; ++m) { const size_t off = (size_t)(row0 + ai * 128 + (mh + m) * 16) * DM + col0;
#pragma unroll
                        for (int bj = 0; bj < 2; ++bj) *(u32x4*)(out + off + bj * 128) = xpack8(xf[m][bj][0] + gv[bj][0] * acc[ai][bj][mh + m][0], xf[m][bj][1] + gv[bj][1] * acc[ai][bj][mh + m][1]); }
                    asm volatile("" ::: "memory"); }
            } else {
                u32x4 xb[4][2];
#pragma unroll
                for (int m = 0; m < 4; ++m)
#pragma unroll
                    for (int bj = 0; bj < 2; ++bj) xb[m][bj] = *(const u32x4*)(base16 + (size_t)(row0 + ai * 128 + m * 16) * DM + col0 + bj * 128);
#pragma unroll
                for (int m = 0; m < 4; ++m) { const size_t off = (size_t)(row0 + ai * 128 + m * 16) * DM + col0;
#pragma unroll
                    for (int bj = 0; bj < 2; ++bj) { f32x4 b0, b1; xunpack8(xb[m][bj], b0, b1);
                        *(u32x4*)(out + off + bj * 128) = xpack8(b0 + gv[bj][0] * acc[ai][bj][m][0], b1 + gv[bj][1] * acc[ai][bj][m][1]); } }
                asm volatile("" ::: "memory");
            }
        }
    }
};
__device__ __forceinline__ float silu_f(float x) { return x * __builtin_amdgcn_rcpf(1.f + __builtin_amdgcn_exp2f(-1.4426950408889634f * x)); }
struct EpiSwiGLU {
    static constexpr bool PERM = true;
    bf16_t* O;
    __device__ __forceinline__ void operator()(const Acc& acc, const pg8::Unit& u, int wr, int wc, int fr, int fq) const {
        const int row0 = u.pm * 256 + wr * 64 + fr, col0 = u.pn * 128 + wc * 32 + 8 * fq;
#pragma unroll
        for (int ai = 0; ai < 2; ++ai)
#pragma unroll
            for (int m = 0; m < 4; ++m) { f32x4 o0, o1;
#pragma unroll
                for (int e = 0; e < 4; ++e) { o0[e] = silu_f(acc[ai][0][m][0][e]) * acc[ai][1][m][0][e]; o1[e] = silu_f(acc[ai][0][m][1][e]) * acc[ai][1][m][1][e]; }
                *(u32x4*)(O + (size_t)(row0 + ai * 128 + m * 16) * FF + col0) = pack8(o0, o1); }
    }
};
__device__ __forceinline__ void rope8(f32x4& v0, f32x4& v1, const f32x4 cs0, const f32x4 cs1) {
    const float a0 = v0[0] * cs0[0] - v0[1] * cs0[1], b0 = v0[1] * cs0[0] + v0[0] * cs0[1];
    const float a1 = v0[2] * cs0[2] - v0[3] * cs0[3], b1 = v0[3] * cs0[2] + v0[2] * cs0[3];
    const float a2 = v1[0] * cs1[0] - v1[1] * cs1[1], b2 = v1[1] * cs1[0] + v1[0] * cs1[1];
    const float a3 = v1[2] * cs1[2] - v1[3] * cs1[3], b3 = v1[3] * cs1[2] + v1[2] * cs1[3];
    v0 = (f32x4){a0, b0, a1, b1}; v1 = (f32x4){a2, b2, a3, b3};
}
struct EpiDQKV {
    static constexpr bool PERM = true;
    bf16_t* QA; bf16_t* CKV; bf16_t* KR; float* SSQ; float* SSKV; const float* TAB;
    __device__ __forceinline__ void operator()(const Acc& acc, const pg8::Unit& u, int wr, int wc, int fr, int fq) const {
        const int row0 = u.pm * 256 + wr * 64 + fr;
        if (u.pn < 4) {
            bf16_t* O = (u.pn < 2) ? QA : CKV; float* SS = (u.pn < 2) ? SSQ : SSKV; const int ct = u.pn & 1, col0 = ct * 256 + wc * 32 + 8 * fq;
#pragma unroll
            for (int ai = 0; ai < 2; ++ai)
#pragma unroll
                for (int m = 0; m < 4; ++m) { const int row = row0 + ai * 128 + m * 16; float s = 0.f;
#pragma unroll
                    for (int bj = 0; bj < 2; ++bj) { const f32x4 v0 = acc[ai][bj][m][0], v1 = acc[ai][bj][m][1];
                        s += (v0[0] * v0[0] + v0[1] * v0[1]) + (v0[2] * v0[2] + v0[3] * v0[3]) + (v1[0] * v1[0] + v1[1] * v1[1]) + (v1[2] * v1[2] + v1[3] * v1[3]);
                        *(u32x4*)(O + (size_t)row * 512 + col0 + bj * 128) = pack8(v0, v1); }
                    s = xor_add<16>(s); s = xor_add<32>(s);
                    if (fq == 0) SS[(size_t)row * 8 + ct * 4 + wc] = s; }
        } else if (wc < 2) {
            const int col0 = wc * 32 + 8 * fq;
#pragma unroll
            for (int ai = 0; ai < 2; ++ai) { f32x4 t0[4], t1[4];
#pragma unroll
                for (int m = 0; m < 4; ++m) { const int row = row0 + ai * 128 + m * 16, rr = row < SEQ ? row : 0, pos = wc ? (rr & 63) : (rr >> 6); const f32x4* t = (const f32x4*)(TAB + (size_t)(pos * 16 + 4 * fq) * 2); t0[m] = t[0]; t1[m] = t[1]; }
#pragma unroll
                for (int m = 0; m < 4; ++m) { const int row = row0 + ai * 128 + m * 16; f32x4 v0 = acc[ai][0][m][0], v1 = acc[ai][0][m][1];
                    if (row < SEQ) rope8(v0, v1, t0[m], t1[m]);
                    *(u32x4*)(KR + (size_t)row * 64 + col0) = pack8(v0, v1); }
                asm volatile("" ::: "memory"); }
        }
    }
};
__device__ __forceinline__ float row_rstd8(const float* ss, int row, float inv_n) {
    const f32x4 a = *(const f32x4*)(ss + (size_t)row * 8), b = *(const f32x4*)(ss + (size_t)row * 8 + 4);
    return __builtin_amdgcn_rsqf(((a[0] + a[1]) + (a[2] + a[3]) + (b[0] + b[1]) + (b[2] + b[3])) * inv_n + EPS);
}
struct EpiUQ {
    static constexpr bool PERM = true;
    bf16_t* Q; const float* SSQ; const float* TAB;
    __device__ __forceinline__ void operator()(const Acc& acc, const pg8::Unit& u, int wr, int wc, int fr, int fq) const {
        const int row0 = u.pm * 256 + wr * 64 + fr;
        int c0[2], ropei[2];
#pragma unroll
        for (int bj = 0; bj < 2; ++bj) { c0[bj] = u.pn * 256 + bj * 128 + wc * 32 + 8 * fq; const int d0 = c0[bj] % QHD; ropei[bj] = (d0 >= QKN) ? ((d0 - QKN) >> 1) : -1; }
#pragma unroll
        for (int ai = 0; ai < 2; ++ai) {
            f32x4 sa[4], sb[4], t0[4], t1[4];
            const int ri = ropei[0] >= 0 ? ropei[0] : ropei[1];
#pragma unroll
            for (int m = 0; m < 4; ++m) { const int row = row0 + ai * 128 + m * 16; sa[m] = *(const f32x4*)(SSQ + (size_t)row * 8); sb[m] = *(const f32x4*)(SSQ + (size_t)row * 8 + 4); }
            if (ri >= 0) {
#pragma unroll
                for (int m = 0; m < 4; ++m) { const int row = row0 + ai * 128 + m * 16, rr = row < SEQ ? row : 0, pos = (ri >> 4) ? (rr & 63) : (rr >> 6); const f32x4* t = (const f32x4*)(TAB + (size_t)(pos * 16 + (ri & 15)) * 2); t0[m] = t[0]; t1[m] = t[1]; } }
#pragma unroll
            for (int m = 0; m < 4; ++m) { const int row = row0 + ai * 128 + m * 16;
                const float rs = __builtin_amdgcn_rsqf(((sa[m][0] + sa[m][1]) + (sa[m][2] + sa[m][3]) + (sb[m][0] + sb[m][1]) + (sb[m][2] + sb[m][3])) * (1.f / QLORA) + EPS);
#pragma unroll
                for (int bj = 0; bj < 2; ++bj) { f32x4 v0 = acc[ai][bj][m][0] * rs, v1 = acc[ai][bj][m][1] * rs;
                    if (ropei[bj] >= 0 && row < SEQ) rope8(v0, v1, t0[m], t1[m]);
                    *(u32x4*)(Q + (size_t)row * NQ + c0[bj]) = pack8(v0 * QSCALE, v1 * QSCALE); } }
            asm volatile("" ::: "memory");
        }
    }
};
struct EpiUKV {
    static constexpr bool PERM = true;
    bf16_t* KN; bf16_t* V; const float* SSKV;
    __device__ __forceinline__ void operator()(const Acc& acc, const pg8::Unit& u, int wr, int wc, int fr, int fq) const {
        const int row0 = u.pm * 256 + wr * 64 + fr, col0 = u.pn * 128 + wc * 32 + 8 * fq;
#pragma unroll
        for (int ai = 0; ai < 2; ++ai) {
            f32x4 sa[4], sb[4];
#pragma unroll
            for (int m = 0; m < 4; ++m) { const int row = row0 + ai * 128 + m * 16; sa[m] = *(const f32x4*)(SSKV + (size_t)row * 8); sb[m] = *(const f32x4*)(SSKV + (size_t)row * 8 + 4); }
#pragma unroll
            for (int m = 0; m < 4; ++m) { const int row = row0 + ai * 128 + m * 16;
                const float rs = __builtin_amdgcn_rsqf(((sa[m][0] + sa[m][1]) + (sa[m][2] + sa[m][3]) + (sb[m][0] + sb[m][1]) + (sb[m][2] + sb[m][3])) * (1.f / KVLORA) + EPS);
                *(u32x4*)(KN + (size_t)row * DM + col0) = pack8(acc[ai][0][m][0] * rs, acc[ai][0][m][1] * rs);
                *(u32x4*)(V + (size_t)row * DM + col0) = pack8(acc[ai][1][m][0] * rs, acc[ai][1][m][1] * rs); }
            asm volatile("" ::: "memory");
        }
    }
};

template <class Main> struct EpiWithSlab {
    static constexpr bool PERM = Main::PERM;
    static_assert(Main::PERM, "slab layout assumes 8 consecutive columns per lane");
    Main main; bf16_t* slab; int ldc;
    __device__ __forceinline__ void operator()(const Acc& acc, const pg8::Unit& u, int wr, int wc, int fr, int fq) const {
        if (u.pm != 32) { main(acc, u, wr, wc, fr, fq); return; }
        bf16_t* sp = slab + (size_t)u.aux * 256 * ldc + (size_t)(wr * 64 + fr) * ldc + u.pn * 256 + wc * 32 + 8 * fq;
#pragma unroll
        for (int ai = 0; ai < 2; ++ai)
#pragma unroll
            for (int m = 0; m < 4; ++m) { bf16_t* rp = sp + (size_t)(ai * 128 + m * 16) * ldc;
#pragma unroll
                for (int bj = 0; bj < 2; ++bj) *(u32x4*)(rp + bj * 128) = xpack8(acc[ai][bj][m][0], acc[ai][bj][m][1]); }
    }
};

namespace att {
__device__ __forceinline__ int crow(int r, int hi) { return (r & 3) + 8 * (r >> 2) + 4 * hi; }
constexpr float THR = 8.f;
__device__ __forceinline__ void partialSM(f32x16& p0, f32x16& p1, float& m_reg, float& alpha) {
    float pmax = p0[0];
#pragma unroll
    for (int r = 1; r < 16; ++r) pmax = fmaxf(pmax, p0[r]);
#pragma unroll
    for (int r = 0; r < 16; ++r) pmax = fmaxf(pmax, p1[r]);
    { auto rr = __builtin_amdgcn_permlane32_swap(__float_as_uint(pmax), __float_as_uint(pmax), false, false); pmax = fmaxf(__uint_as_float(rr[0]), __uint_as_float(rr[1])); }
    float mn;
    if (__builtin_expect(__all(pmax - m_reg <= THR), 1)) { mn = m_reg; alpha = 1.f; }
    else { mn = fmaxf(m_reg, pmax); alpha = __builtin_amdgcn_exp2f(m_reg - mn); m_reg = mn; }
#pragma unroll
    for (int r = 0; r < 16; ++r) { p0[r] = __builtin_amdgcn_exp2f(p0[r] - mn); p1[r] = p1[r] - mn; }
}
__device__ __forceinline__ void finishSM(const f32x16& p0, f32x16& p1, float alpha, float& l_reg, bf16x8& pa0, bf16x8& pa1, bf16x8& pa2, bf16x8& pa3) {
#pragma unroll
    for (int r = 0; r < 16; ++r) p1[r] = __builtin_amdgcn_exp2f(p1[r]);
    float ps = 0;
#pragma unroll
    for (int r = 0; r < 16; ++r) ps += p0[r];
#pragma unroll
    for (int r = 0; r < 16; ++r) ps += p1[r];
    { auto rr = __builtin_amdgcn_permlane32_swap(__float_as_uint(ps), __float_as_uint(ps), false, false); ps = __uint_as_float(rr[0]) + __uint_as_float(rr[1]); }
    l_reg = l_reg * alpha + ps;
#define PK4(P, BASE, OUT) do { unsigned a0 = cvt_pk_bf16(P[BASE + 0], P[BASE + 1]), a1 = cvt_pk_bf16(P[BASE + 2], P[BASE + 3]);   \
    unsigned b0 = cvt_pk_bf16(P[BASE + 4], P[BASE + 5]), b1 = cvt_pk_bf16(P[BASE + 6], P[BASE + 7]);                              \
    auto r0 = __builtin_amdgcn_permlane32_swap(a0, b0, false, false); auto r1 = __builtin_amdgcn_permlane32_swap(a1, b1, false, false); \
    u32x4 w = {r0[0], r1[0], r0[1], r1[1]}; OUT = *reinterpret_cast<bf16x8*>(&w); } while (0)
    PK4(p0, 0, pa0); PK4(p0, 8, pa1); PK4(p1, 0, pa2); PK4(p1, 8, pa3);
#undef PK4
}
__device__ __forceinline__ void unit_simple(const bf16_t* __restrict__ Q, const bf16_t* __restrict__ KN, const bf16_t* __restrict__ KR, const bf16_t* __restrict__ V, bf16_t* __restrict__ O,
                                            int h, int q0, int k0, int nkeys, LAS float* wsf) {
    const int tid = otid(), wid = tid >> 6, lane = tid & 63, r32 = lane & 31, hi = lane >> 5;
    const bf16_t* Qw = Q + (size_t)(q0 + wid * 32 + r32) * NQ + h * QHD + hi * 8;
    bf16x8 qn[8], qp[4];
#pragma unroll
    for (int d0 = 0; d0 < 8; ++d0) qn[d0] = *(const bf16x8*)(Qw + d0 * 16);
#pragma unroll
    for (int d0 = 0; d0 < 4; ++d0) qp[d0] = *(const bf16x8*)(Qw + QKN + d0 * 16);
    float m_reg = -1e30f, l_reg = 0.f; f32x16 o[4];
#pragma unroll
    for (int d = 0; d < 4; ++d) o[d] = f32x16{};
    for (int kt = 0; kt < nkeys; kt += 64) {
        f32x16 p0 = f32x16{}, p1 = f32x16{};
        const bf16_t* kn0 = KN + (size_t)(k0 + kt + r32) * DM + h * QKN + hi * 8; const bf16_t* kn1 = kn0 + (size_t)32 * DM;
#pragma unroll
        for (int d0 = 0; d0 < 8; ++d0) { const bf16x8 b0 = *(const bf16x8*)(kn0 + d0 * 16), b1 = *(const bf16x8*)(kn1 + d0 * 16);
            p0 = __builtin_amdgcn_mfma_f32_32x32x16_bf16(b0, qn[d0], p0, 0, 0, 0); p1 = __builtin_amdgcn_mfma_f32_32x32x16_bf16(b1, qn[d0], p1, 0, 0, 0); }
        const bf16_t* kr0 = KR + (size_t)(k0 + kt + r32) * QKR + hi * 8; const bf16_t* kr1 = kr0 + 32 * QKR;
#pragma unroll
        for (int d0 = 0; d0 < 4; ++d0) { const bf16x8 b0 = *(const bf16x8*)(kr0 + d0 * 16), b1 = *(const bf16x8*)(kr1 + d0 * 16);
            p0 = __builtin_amdgcn_mfma_f32_32x32x16_bf16(b0, qp[d0], p0, 0, 0, 0); p1 = __builtin_amdgcn_mfma_f32_32x32x16_bf16(b1, qp[d0], p1, 0, 0, 0); }
        float alpha; partialSM(p0, p1, m_reg, alpha);
        if (__any(alpha < 1.f)) { if (hi == 0) wsf[r32] = alpha; asm volatile("s_waitcnt lgkmcnt(0)" ::: "memory");
#pragma unroll
            for (int d = 0; d < 4; ++d)
#pragma unroll
                for (int r = 0; r < 16; ++r) o[d][r] *= wsf[crow(r, hi)];
            asm volatile("s_waitcnt lgkmcnt(0)" ::: "memory"); }
        bf16x8 pa[4]; finishSM(p0, p1, alpha, l_reg, pa[0], pa[1], pa[2], pa[3]);
#pragma unroll
        for (int ks = 0; ks < 4; ++ks) { const bf16_t* vb = V + (size_t)(k0 + kt + 16 * ks + 8 * hi) * DM + h * VD + r32;
#pragma unroll
            for (int d0 = 0; d0 < 4; ++d0) { bf16x8 bv;
#pragma unroll
                for (int j = 0; j < 8; ++j) bv[j] = (short)vb[(size_t)j * DM + d0 * 32];
                o[d0] = __builtin_amdgcn_mfma_f32_32x32x16_bf16(pa[ks], bv, o[d0], 0, 0, 0); } }
    }
    if (hi == 0) wsf[32 + r32] = l_reg; asm volatile("s_waitcnt lgkmcnt(0)" ::: "memory");
    bf16_t* Ow = O + (size_t)(q0 + wid * 32) * DM + h * VD + r32;
#pragma unroll
    for (int r = 0; r < 16; ++r) { const int orow = crow(r, hi); const float rl = __builtin_amdgcn_rcpf(wsf[32 + orow]);
#pragma unroll
        for (int d0 = 0; d0 < 4; ++d0) Ow[(size_t)orow * DM + d0 * 32] = (bf16_t)(cvt_pk_bf16(o[d0][r] * rl, 0.f) & 0xffffu); }
    asm volatile("s_waitcnt lgkmcnt(0)" ::: "memory");
}

constexpr int KN_SLOT = 16384, KR_SLOT = 8192, V_SLOT = 16384;
constexpr int L_KN = 0, L_KR = 3 * KN_SLOT, L_V = L_KR + 3 * KR_SLOT, L_WS = L_V + 3 * V_SLOT, ATT_LDS = L_WS + 8 * 256;
__device__ __forceinline__ void glds16(const void* gsrc, unsigned lds_dst) { unsigned keep;
    asm volatile("s_mov_b32 %0, m0\n\ts_mov_b32 m0, %2\n\ts_nop 0\n\tglobal_load_lds_dwordx4 %1, off\n\ts_mov_b32 m0, %0" : "=&s"(keep) : "v"(gsrc), "s"(lds_dst) : "memory"); }
__device__ __forceinline__ void glds16s(const char* sbase, unsigned voff, unsigned lds_dst) {
    asm volatile("s_mov_b32 m0, %2\n\ts_nop 0\n\tglobal_load_lds_dwordx4 %1, %0" :: "s"(sbase), "v"(voff), "s"(lds_dst) : "memory", "m0"); }
typedef short s16x4 __attribute__((ext_vector_type(4)));
__device__ __forceinline__ int v_rd_base(int lane) { return ((lane & 3) << 3) | (((lane >> 2) & 3) << 6) | (((lane >> 4) & 1) << 5) | (((lane >> 5) & 1) << 8); }
constexpr int v_rd_off(int d0, int ks, int half) { return d0 * 512 + ks * 4096 + half * 2048; }
template <int OFF> __device__ __forceinline__ s16x4 tr_read(int vb) { s16x4 r; asm volatile("ds_read_b64_tr_b16 %0, %1 offset:%2" : "=&v"(r) : "v"(vb), "i"(OFF) : "memory"); return r; }
template <int D0> __device__ __forceinline__ void pv_one(f32x16& od, int vb, bf16x8 pa0, bf16x8 pa1, bf16x8 pa2, bf16x8 pa3) {
    const s16x4 l0 = tr_read<v_rd_off(D0, 0, 0)>(vb), h0 = tr_read<v_rd_off(D0, 0, 1)>(vb), l1 = tr_read<v_rd_off(D0, 1, 0)>(vb), h1 = tr_read<v_rd_off(D0, 1, 1)>(vb);
    const s16x4 l2 = tr_read<v_rd_off(D0, 2, 0)>(vb), h2 = tr_read<v_rd_off(D0, 2, 1)>(vb), l3 = tr_read<v_rd_off(D0, 3, 0)>(vb), h3 = tr_read<v_rd_off(D0, 3, 1)>(vb);
    asm volatile("s_waitcnt lgkmcnt(0)" ::: "memory"); __builtin_amdgcn_sched_barrier(0);
#define PK(L, H) (bf16x8){L[0], L[1], L[2], L[3], H[0], H[1], H[2], H[3]}
    od = __builtin_amdgcn_mfma_f32_32x32x16_bf16(pa0, PK(l0, h0), od, 0, 0, 0);
    od = __builtin_amdgcn_mfma_f32_32x32x16_bf16(pa1, PK(l1, h1), od, 0, 0, 0);
    od = __builtin_amdgcn_mfma_f32_32x32x16_bf16(pa2, PK(l2, h2), od, 0, 0, 0);
    od = __builtin_amdgcn_mfma_f32_32x32x16_bf16(pa3, PK(l3, h3), od, 0, 0, 0);
#undef PK
}
__device__ __forceinline__ void pv_d0(f32x16* o, int vb, bf16x8 pa0, bf16x8 pa1, bf16x8 pa2, bf16x8 pa3) {
    pv_one<0>(o[0], vb, pa0, pa1, pa2, pa3); pv_one<1>(o[1], vb, pa0, pa1, pa2, pa3); pv_one<2>(o[2], vb, pa0, pa1, pa2, pa3); pv_one<3>(o[3], vb, pa0, pa1, pa2, pa3);
}
__device__ __forceinline__ void qkt(f32x16& p0, f32x16& p1, LAS unsigned char* kn, LAS unsigned char* kr, const bf16x8* qn, const bf16x8* qp, int r32, int hi) {
    p0 = f32x16{}; p1 = f32x16{};
#pragma unroll
    for (int d0 = 0; d0 < 8; ++d0) { const int cb = ((2 * d0 + hi) ^ (r32 & 15)) * 16;
        const bf16x8 b0 = *(const LAS bf16x8*)(kn + r32 * 256 + cb), b1 = *(const LAS bf16x8*)(kn + 8192 + r32 * 256 + cb);
        p0 = __builtin_amdgcn_mfma_f32_32x32x16_bf16(b0, qn[d0], p0, 0, 0, 0); p1 = __builtin_amdgcn_mfma_f32_32x32x16_bf16(b1, qn[d0], p1, 0, 0, 0); }
#pragma unroll
    for (int d0 = 0; d0 < 4; ++d0) { const int cb = ((2 * d0 + hi) ^ ((r32 >> 1) & 7)) * 16;
        const bf16x8 b0 = *(const LAS bf16x8*)(kr + r32 * 128 + cb), b1 = *(const LAS bf16x8*)(kr + 4096 + r32 * 128 + cb);
        p0 = __builtin_amdgcn_mfma_f32_32x32x16_bf16(b0, qp[d0], p0, 0, 0, 0); p1 = __builtin_amdgcn_mfma_f32_32x32x16_bf16(b1, qp[d0], p1, 0, 0, 0); }
}

typedef short v4i16_t __attribute__((ext_vector_type(4)));
template <int OFF> __device__ __forceinline__ s16x4 tr_rd(int vb) { return __builtin_bit_cast(s16x4, __builtin_amdgcn_ds_read_tr16_b64_v4i16((LAS v4i16_t*)(vb + OFF))); }
template <bool NOLDS> __device__ __forceinline__ void qkt_p(f32x16& p0, f32x16& p1, LAS unsigned char* kn, LAS unsigned char* kr, const bf16x8* qn, const bf16x8* qp, int r32, int hi) {
    const int swn = r32 & 15, swr = (r32 >> 1) & 7;
    LAS unsigned char* knr = kn + r32 * 256; LAS unsigned char* krr = kr + r32 * 128;
    bf16x8 k0[3], k1[3];
    p0 = f32x16{}; p1 = f32x16{};
#define KRD(D, I) do { if (NOLDS) { k0[I] = qn[(D) & 7]; k1[I] = qn[((D) + 1) & 7]; } else if ((D) < 8) { const int cb = ((2 * (D) + hi) ^ swn) * 16; k0[I] = *(const LAS bf16x8*)(knr + cb); k1[I] = *(const LAS bf16x8*)(knr + 8192 + cb); } \
                       else { const int cb = ((2 * ((D) - 8) + hi) ^ swr) * 16; k0[I] = *(const LAS bf16x8*)(krr + cb); k1[I] = *(const LAS bf16x8*)(krr + 4096 + cb); } } while (0)
    KRD(0, 0); KRD(1, 1); __builtin_amdgcn_sched_barrier(0);
#pragma unroll
    for (int D = 0; D < 12; ++D) {
        if (D + 2 < 12) KRD(D + 2, (D + 2) % 3);
        __builtin_amdgcn_sched_barrier(0);
        const bf16x8 q = D < 8 ? qn[D & 7] : qp[(D - 8) & 3];
        p0 = __builtin_amdgcn_mfma_f32_32x32x16_bf16(k0[D % 3], q, p0, 0, 0, 0); p1 = __builtin_amdgcn_mfma_f32_32x32x16_bf16(k1[D % 3], q, p1, 0, 0, 0);
        __builtin_amdgcn_sched_barrier(0);
    }
#undef KRD
}
template <bool NOLDS> __device__ __forceinline__ void pv_p(f32x16* o, int vb, bf16x8 pa0, bf16x8 pa1, bf16x8 pa2, bf16x8 pa3) {
    s16x4 va[8], vq[8];
#define VRD8(D0, X) do { if (NOLDS) { _Pragma("unroll") for (int _e = 0; _e < 8; ++_e) X[_e] = (s16x4){pa0[_e], pa1[_e], pa2[_e], pa3[_e]}; } else { X[0] = tr_rd<v_rd_off(D0, 0, 0)>(vb); X[1] = tr_rd<v_rd_off(D0, 0, 1)>(vb); X[2] = tr_rd<v_rd_off(D0, 1, 0)>(vb); X[3] = tr_rd<v_rd_off(D0, 1, 1)>(vb); \
                         X[4] = tr_rd<v_rd_off(D0, 2, 0)>(vb); X[5] = tr_rd<v_rd_off(D0, 2, 1)>(vb); X[6] = tr_rd<v_rd_off(D0, 3, 0)>(vb); X[7] = tr_rd<v_rd_off(D0, 3, 1)>(vb); } } while (0)
#define PKV(L, H) (bf16x8){L[0], L[1], L[2], L[3], H[0], H[1], H[2], H[3]}
#define PV4(OD, X) do { OD = __builtin_amdgcn_mfma_f32_32x32x16_bf16(pa0, PKV(X[0], X[1]), OD, 0, 0, 0); OD = __builtin_amdgcn_mfma_f32_32x32x16_bf16(pa1, PKV(X[2], X[3]), OD, 0, 0, 0); \
                         OD = __builtin_amdgcn_mfma_f32_32x32x16_bf16(pa2, PKV(X[4], X[5]), OD, 0, 0, 0); OD = __builtin_amdgcn_mfma_f32_32x32x16_bf16(pa3, PKV(X[6], X[7]), OD, 0, 0, 0); } while (0)
    VRD8(0, va); __builtin_amdgcn_sched_barrier(0);
    VRD8(1, vq); __builtin_amdgcn_sched_barrier(0); PV4(o[0], va); __builtin_amdgcn_sched_barrier(0);
    VRD8(2, va); __builtin_amdgcn_sched_barrier(0); PV4(o[1], vq); __builtin_amdgcn_sched_barrier(0);
    VRD8(3, vq); __builtin_amdgcn_sched_barrier(0); PV4(o[2], va); __builtin_amdgcn_sched_barrier(0);
    PV4(o[3], vq); __builtin_amdgcn_sched_barrier(0);
#undef VRD8
#undef PKV
#undef PV4
}
#define ATT_WAIT_BAR(N) asm volatile("s_waitcnt vmcnt(" #N ") lgkmcnt(0)\n\ts_barrier" ::: "memory")
__device__ __forceinline__ void unit_fast(const bf16_t* __restrict__ Q, const bf16_t* __restrict__ KN, const bf16_t* __restrict__ KR, const bf16_t* __restrict__ V, bf16_t* __restrict__ O,
                                          int h, int q0, int k0, int nkeys, LAS unsigned char* lds) {
    const int tid = otid(), wid = __builtin_amdgcn_readfirstlane(tid >> 6), lane = tid & 63, r32 = lane & 31, hi = lane >> 5;
    const unsigned lds0 = (unsigned)(uintptr_t)lds;
    LAS float* wsf = (LAS float*)(lds + L_WS) + wid * 64;
    unsigned kn_off[2], v_off[2], kr_off;
#pragma unroll
    for (int i = 0; i < 2; ++i) { const int row = 8 * wid + 4 * i + (lane >> 4), lc = (lane & 15) ^ (row & 15); kn_off[i] = (unsigned)(row * DM * 2 + h * QKN * 2 + lc * 16);
        const int s = 2 * (2 * wid + i) + (lane >> 5), kk = 8 * (s >> 2) + ((lane & 31) >> 2), k = (kk & ~0xC) | ((kk & 4) << 1) | ((kk & 8) >> 1), c = 32 * (s & 3) + 8 * (lane & 3);
        v_off[i] = (unsigned)(k * DM * 2 + h * VD * 2 + c * 2); }
    { const int row = 8 * wid + (lane >> 3), lc = (lane & 7) ^ ((row >> 1) & 7); kr_off = (unsigned)(row * QKR * 2 + lc * 16); }
    const char* KNg = (const char*)(KN + (size_t)k0 * DM); const char* KRg = (const char*)(KR + (size_t)k0 * QKR); const char* Vg = (const char*)(V + (size_t)k0 * DM);
    const unsigned dK = lds0 + L_KN + 2 * wid * 1024, dR = lds0 + L_KR + wid * 1024, dV = lds0 + L_V + 2 * wid * 1024;
#define DMA_K(t, sl) do { const char* _g = KNg + (size_t)(t) * (64 * DM * 2); const unsigned _d = (unsigned)__builtin_amdgcn_readfirstlane(dK + (sl) * KN_SLOT); \
        glds16(_g + kn_off[0], _d); glds16(_g + kn_off[1], _d + 1024); glds16(KRg + (size_t)(t) * (64 * QKR * 2) + kr_off, (unsigned)__builtin_amdgcn_readfirstlane(dR + (sl) * KR_SLOT)); } while (0)
#define DMA_V(t, sl) do { const char* _g = Vg + (size_t)(t) * (64 * DM * 2); const unsigned _d = (unsigned)__builtin_amdgcn_readfirstlane(dV + (sl) * V_SLOT); \
        glds16(_g + v_off[0], _d); glds16(_g + v_off[1], _d + 1024); } while (0)
    const int NT = nkeys / 64;
    DMA_K(0, 0); DMA_V(0, 0); DMA_K(1, 1);
    const bf16_t* Qw = Q + (size_t)(q0 + wid * 32 + r32) * NQ + h * QHD + hi * 8;
    bf16x8 qn[8], qp[4];
#pragma unroll
    for (int d0 = 0; d0 < 8; ++d0) qn[d0] = *(const bf16x8*)(Qw + d0 * 16);
#pragma unroll
    for (int d0 = 0; d0 < 4; ++d0) qp[d0] = *(const bf16x8*)(Qw + QKN + d0 * 16);
    float m_reg = -1e30f, l_reg = 0.f; f32x16 o[4];
#pragma unroll
    for (int d = 0; d < 4; ++d) o[d] = f32x16{};
    const int vb0 = (int)(lds0 + L_V) + v_rd_base(lane);
    f32x16 pA0, pA1, pB0, pB1; float alA, alB; bf16x8 pa0, pa1, pa2, pa3;
    int sa = 0, sb = 1, sc = 2;
#define ROT() do { const int _t = sa; sa = sb; sb = sc; sc = _t; } while (0)
#define RESC(a) do { if (__any((a) < 1.f)) { if (hi == 0) wsf[r32] = (a); asm volatile("s_waitcnt lgkmcnt(0)" ::: "memory"); \
        _Pragma("unroll") for (int d = 0; d < 4; ++d) _Pragma("unroll") for (int r = 0; r < 16; ++r) o[d][r] *= wsf[crow(r, hi)]; } } while (0)
    ATT_WAIT_BAR(0);
    { DMA_K((2 < NT ? 2 : NT - 1), sc); DMA_V(1, sb);
      qkt(pA0, pA1, lds + L_KN + sa * KN_SLOT, lds + L_KR + sa * KR_SLOT, qn, qp, r32, hi); partialSM(pA0, pA1, m_reg, alA);
      ATT_WAIT_BAR(5); ROT(); }
#define STEP(j, C0, C1, alC, P0, P1, alP) do { const int _kt = ((j) + 2 < NT) ? (j) + 2 : NT - 1, _vt = ((j) + 1 < NT) ? (j) + 1 : NT - 1; \
        DMA_K(_kt, sc); DMA_V(_vt, sb); __builtin_amdgcn_sched_barrier(0); \
        qkt_p<false>(C0, C1, lds + L_KN + sa * KN_SLOT, lds + L_KR + sa * KR_SLOT, qn, qp, r32, hi); \
        finishSM(P0, P1, alP, l_reg, pa0, pa1, pa2, pa3); __builtin_amdgcn_sched_barrier(0); \
        pv_p<false>(o, vb0 + sc * V_SLOT, pa0, pa1, pa2, pa3); \
        partialSM(C0, C1, m_reg, alC); RESC(alC); \
        ATT_WAIT_BAR(5); ROT(); } while (0)
#pragma unroll 1
    for (int j = 1; j + 1 < NT; j += 2) { STEP(j, pB0, pB1, alB, pA0, pA1, alA); STEP(j + 1, pA0, pA1, alA, pB0, pB1, alB); }
    STEP(NT - 1, pB0, pB1, alB, pA0, pA1, alA);
    finishSM(pB0, pB1, alB, l_reg, pa0, pa1, pa2, pa3); __builtin_amdgcn_sched_barrier(0);
    pv_d0(o, vb0 + sc * V_SLOT, pa0, pa1, pa2, pa3);
    if (hi == 0) wsf[32 + r32] = l_reg;
    ATT_WAIT_BAR(0);
    { LAS bf16_t* stg = (LAS bf16_t*)(lds + wid * 8192);
#pragma unroll
      for (int r = 0; r < 16; ++r) { const int orow = crow(r, hi); const float rl = __builtin_amdgcn_rcpf(wsf[32 + orow]);
#pragma unroll
          for (int d0 = 0; d0 < 4; ++d0) stg[orow * 128 + d0 * 32 + r32] = (bf16_t)(cvt_pk_bf16(o[d0][r] * rl, 0.f) & 0xffffu); }
      asm volatile("s_waitcnt lgkmcnt(0)" ::: "memory");
      bf16_t* Ow = O + (size_t)(q0 + wid * 32) * DM + h * VD;
#pragma unroll
      for (int i = 0; i < 8; ++i) { const int row = i * 4 + (lane >> 4), ch = lane & 15; const u32x4 v = *(const LAS u32x4*)(stg + row * 128 + ch * 8); *(u32x4*)(Ow + (size_t)row * DM + ch * 8) = v; } }
    ATT_WAIT_BAR(0);
#undef DMA_K
#undef DMA_V
#undef ROT
#undef RESC
#undef STEP
}


#define SB0() __builtin_amdgcn_sched_barrier(0)
#define PIN(x) asm volatile("" : "+v"(x))
#define PKQ(P, BASE, OUT) do { unsigned a0 = cvt_pk_bf16(P[BASE + 0], P[BASE + 1]), a1 = cvt_pk_bf16(P[BASE + 2], P[BASE + 3]);   \
    unsigned b0 = cvt_pk_bf16(P[BASE + 4], P[BASE + 5]), b1 = cvt_pk_bf16(P[BASE + 6], P[BASE + 7]);                              \
    auto r0 = __builtin_amdgcn_permlane32_swap(a0, b0, false, false); auto r1 = __builtin_amdgcn_permlane32_swap(a1, b1, false, false); \
    u32x4 w = {r0[0], r1[0], r0[1], r1[1]}; OUT = *reinterpret_cast<bf16x8*>(&w); } while (0)
__device__ __forceinline__ void regionA(f32x16& c0, f32x16& c1, LAS unsigned char* kn, LAS unsigned char* kr, const bf16x8* qn, const bf16x8* qp, int r32, int hi,
                                        f32x16& P0, f32x16& P1, float alP, float& l_reg, bf16x8& pa0, bf16x8& pa1, bf16x8& pa2, bf16x8& pa3,
                                        const char* gk, const char* gkr, unsigned ko0, unsigned ko1, unsigned kro, unsigned dk, unsigned dr) {
    const int swn = r32 & 15, swr = (r32 >> 1) & 7;
    LAS unsigned char* knr = kn + r32 * 256; LAS unsigned char* krr = kr + r32 * 128;
    bf16x8 ka0, ka1, kb0, kb1; float ps = 0.f, ps1 = 0.f, ps2 = 0.f, ps3 = 0.f;
    c0 = f32x16{}; c1 = f32x16{};
#define KRD(D, X0, X1) do { if ((D) < 8) { const int cb = ((2 * (D) + hi) ^ swn) * 16; X0 = *(const LAS bf16x8*)(knr + cb); X1 = *(const LAS bf16x8*)(knr + 8192 + cb); } \
                            else if ((D) < 12) { const int cb = ((2 * ((D) - 8) + hi) ^ swr) * 16; X0 = *(const LAS bf16x8*)(krr + cb); X1 = *(const LAS bf16x8*)(krr + 4096 + cb); } } while (0)
#define QOP(D) ((D) < 8 ? qn[(D) & 7] : qp[((D) - 8) & 3])
#define GAPA(D, X0, X1, WORK) do { \
        c0 = __builtin_amdgcn_mfma_f32_32x32x16_bf16(X0, QOP(D), c0, 0, 0, 0); c1 = __builtin_amdgcn_mfma_f32_32x32x16_bf16(X1, QOP(D), c1, 0, 0, 0); KRD((D) + 2, X0, X1); WORK; SB0(); } while (0)
    KRD(0, ka0, ka1); KRD(1, kb0, kb1); SB0();
    GAPA(0, ka0, ka1, { PKQ(P0, 0, pa0); PIN(pa0); });
    GAPA(1, kb0, kb1, { glds16s(gk, ko0, dk); PKQ(P0, 8, pa1); PIN(pa1); });
    GAPA(2, ka0, ka1, { _Pragma("unroll") for (int r = 0; r < 8; ++r) { ps += P0[r]; ps1 += P0[8 + r]; } PIN(ps); PIN(ps1); });
    GAPA(3, kb0, kb1, { _Pragma("unroll") for (int r = 0; r < 4; ++r) P1[r] = __builtin_amdgcn_exp2f(P1[r]); PIN(P1); });
    GAPA(4, ka0, ka1, { glds16s(gk, ko1, dk + 1024); _Pragma("unroll") for (int r = 4; r < 8; ++r) P1[r] = __builtin_amdgcn_exp2f(P1[r]); PIN(P1); });
    GAPA(5, kb0, kb1, { _Pragma("unroll") for (int r = 8; r < 12; ++r) P1[r] = __builtin_amdgcn_exp2f(P1[r]); PIN(P1); });
    GAPA(6, ka0, ka1, { _Pragma("unroll") for (int r = 12; r < 16; ++r) P1[r] = __builtin_amdgcn_exp2f(P1[r]); PIN(P1); });
    GAPA(7, kb0, kb1, { PKQ(P1, 0, pa2); PIN(pa2); });
    GAPA(8, ka0, ka1, { glds16s(gkr, kro, dr); PKQ(P1, 8, pa3); PIN(pa3); });
    GAPA(9, kb0, kb1, { _Pragma("unroll") for (int r = 0; r < 8; ++r) { ps2 += P1[r]; ps3 += P1[8 + r]; } PIN(ps2); PIN(ps3); });
    GAPA(10, ka0, ka1, { ps = (ps + ps1) + (ps2 + ps3); auto rr = __builtin_amdgcn_permlane32_swap(__float_as_uint(ps), __float_as_uint(ps), false, false); ps = __uint_as_float(rr[0]) + __uint_as_float(rr[1]); l_reg = l_reg * alP + ps; PIN(l_reg); });
    GAPA(11, kb0, kb1, { });
#undef KRD
#undef QOP
#undef GAPA
}
__device__ __forceinline__ void regionB(f32x16* o, int vb, bf16x8 pa0, bf16x8 pa1, bf16x8 pa2, bf16x8 pa3, f32x16& C0, f32x16& C1, float& m_reg, float& alC, const char* gv, unsigned vo0, unsigned vo1, unsigned dv) {
    s16x4 va[8]; float mn = 0.f;
#define VRD8(D0, X) do { X[0] = tr_rd<v_rd_off(D0, 0, 0)>(vb); X[1] = tr_rd<v_rd_off(D0, 0, 1)>(vb); X[2] = tr_rd<v_rd_off(D0, 1, 0)>(vb); X[3] = tr_rd<v_rd_off(D0, 1, 1)>(vb); \
                         X[4] = tr_rd<v_rd_off(D0, 2, 0)>(vb); X[5] = tr_rd<v_rd_off(D0, 2, 1)>(vb); X[6] = tr_rd<v_rd_off(D0, 3, 0)>(vb); X[7] = tr_rd<v_rd_off(D0, 3, 1)>(vb); } while (0)
#define PKV(L, H) (bf16x8){L[0], L[1], L[2], L[3], H[0], H[1], H[2], H[3]}
#define PV4(OD, X) do { OD = __builtin_amdgcn_mfma_f32_32x32x16_bf16(pa0, PKV(X[0], X[1]), OD, 0, 0, 0); OD = __builtin_amdgcn_mfma_f32_32x32x16_bf16(pa1, PKV(X[2], X[3]), OD, 0, 0, 0); \
                         OD = __builtin_amdgcn_mfma_f32_32x32x16_bf16(pa2, PKV(X[4], X[5]), OD, 0, 0, 0); OD = __builtin_amdgcn_mfma_f32_32x32x16_bf16(pa3, PKV(X[6], X[7]), OD, 0, 0, 0); } while (0)
    VRD8(0, va); SB0();
    PV4(o[0], va); VRD8(1, va);
    { float a = fmaxf(fmaxf(C0[0], C0[1]), C1[0]), b = fmaxf(fmaxf(C0[2], C0[3]), C1[1]); a = fmaxf(fmaxf(a, C1[2]), C1[3]);
      _Pragma("unroll") for (int r = 4; r < 16; r += 4) { a = fmaxf(fmaxf(a, C0[r]), C0[r + 1]); b = fmaxf(fmaxf(b, C0[r + 2]), C0[r + 3]); a = fmaxf(fmaxf(a, C1[r]), C1[r + 1]); b = fmaxf(fmaxf(b, C1[r + 2]), C1[r + 3]); }
      float pmax = fmaxf(a, b); { auto rr = __builtin_amdgcn_permlane32_swap(__float_as_uint(pmax), __float_as_uint(pmax), false, false); pmax = fmaxf(__uint_as_float(rr[0]), __uint_as_float(rr[1])); }
      const bool keep = __all(pmax - m_reg <= THR); mn = keep ? m_reg : fmaxf(m_reg, pmax); alC = keep ? 1.f : __builtin_amdgcn_exp2f(m_reg - mn); m_reg = mn; PIN(mn); PIN(alC); }
    SB0();
    PV4(o[1], va); VRD8(2, va);
    { glds16s(gv, vo0, dv); _Pragma("unroll") for (int r = 0; r < 16; ++r) { C0[r] -= mn; C1[r] -= mn; } PIN(C0); PIN(C1); }
    SB0();
    PV4(o[2], va); VRD8(3, va);
    { _Pragma("unroll") for (int r = 0; r < 8; ++r) C0[r] = __builtin_amdgcn_exp2f(C0[r]); PIN(C0); }
    SB0();
    PV4(o[3], va);
    { glds16s(gv, vo1, dv + 1024); _Pragma("unroll") for (int r = 8; r < 16; ++r) C0[r] = __builtin_amdgcn_exp2f(C0[r]); PIN(C0); }
    SB0();
#undef VRD8
#undef PKV
#undef PV4
}
__device__ __forceinline__ void unit_il(const bf16_t* __restrict__ Q, const bf16_t* __restrict__ KN, const bf16_t* __restrict__ KR, const bf16_t* __restrict__ V, bf16_t* __restrict__ O,
                                          int h, int q0, int k0, int nkeys, LAS unsigned char* lds) {
    const int tid = otid(), wid = __builtin_amdgcn_readfirstlane(tid >> 6), lane = tid & 63, r32 = lane & 31, hi = lane >> 5;
    const unsigned lds0 = (unsigned)(uintptr_t)lds;
    LAS float* wsf = (LAS float*)(lds + L_WS) + wid * 64;
    unsigned kn_off[2], v_off[2], kr_off;
#pragma unroll
    for (int i = 0; i < 2; ++i) { const int row = 8 * wid + 4 * i + (lane >> 4), lc = (lane & 15) ^ (row & 15); kn_off[i] = (unsigned)(row * DM * 2 + h * QKN * 2 + lc * 16);
        const int s = 2 * (2 * wid + i) + (lane >> 5), kk = 8 * (s >> 2) + ((lane & 31) >> 2), k = (kk & ~0xC) | ((kk & 4) << 1) | ((kk & 8) >> 1), c = 32 * (s & 3) + 8 * (lane & 3);
        v_off[i] = (unsigned)(k * DM * 2 + h * VD * 2 + c * 2); }
    { const int row = 8 * wid + (lane >> 3), lc = (lane & 7) ^ ((row >> 1) & 7); kr_off = (unsigned)(row * QKR * 2 + lc * 16); }
    const char* KNg = (const char*)(KN + (size_t)k0 * DM); const char* KRg = (const char*)(KR + (size_t)k0 * QKR); const char* Vg = (const char*)(V + (size_t)k0 * DM);
    const unsigned dK = lds0 + L_KN + 2 * wid * 1024, dR = lds0 + L_KR + wid * 1024, dV = lds0 + L_V + 2 * wid * 1024;
#define DMA_K(t, sl) do { const char* _g = KNg + (size_t)(t) * (64 * DM * 2); const unsigned _d = (unsigned)__builtin_amdgcn_readfirstlane(dK + (sl) * KN_SLOT); \
        glds16s(_g, kn_off[0], _d); glds16s(_g, kn_off[1], _d + 1024); glds16s(KRg + (size_t)(t) * (64 * QKR * 2), kr_off, (unsigned)__builtin_amdgcn_readfirstlane(dR + (sl) * KR_SLOT)); } while (0)
#define DMA_V(t, sl) do { const char* _g = Vg + (size_t)(t) * (64 * DM * 2); const unsigned _d = (unsigned)__builtin_amdgcn_readfirstlane(dV + (sl) * V_SLOT); \
        glds16s(_g, v_off[0], _d); glds16s(_g, v_off[1], _d + 1024); } while (0)
    const int NT = nkeys / 64;
    DMA_K(0, 0); DMA_V(0, 0); DMA_K(1, 1);
    const bf16_t* Qw = Q + (size_t)(q0 + wid * 32 + r32) * NQ + h * QHD + hi * 8;
    bf16x8 qn[8], qp[4];
#pragma unroll
    for (int d0 = 0; d0 < 8; ++d0) qn[d0] = *(const bf16x8*)(Qw + d0 * 16);
#pragma unroll
    for (int d0 = 0; d0 < 4; ++d0) qp[d0] = *(const bf16x8*)(Qw + QKN + d0 * 16);
    float m_reg = -1e30f, l_reg = 0.f; f32x16 o[4];
#pragma unroll
    for (int d = 0; d < 4; ++d) o[d] = f32x16{};
    const int vb0 = (int)(lds0 + L_V) + v_rd_base(lane);
    f32x16 pA0, pA1, pB0, pB1; float alA, alB; bf16x8 pa0, pa1, pa2, pa3;
    int sa = 0, sb = 1, sc = 2;
#define ROT() do { const int _t = sa; sa = sb; sb = sc; sc = _t; } while (0)
#define RESC(a) do { if (__any((a) < 1.f)) { if (hi == 0) wsf[r32] = (a); asm volatile("s_waitcnt lgkmcnt(0)" ::: "memory"); \
        _Pragma("unroll") for (int d = 0; d < 4; ++d) _Pragma("unroll") for (int r = 0; r < 16; ++r) o[d][r] *= wsf[crow(r, hi)]; } } while (0)
    ATT_WAIT_BAR(0);
    { DMA_K((2 < NT ? 2 : NT - 1), sc); DMA_V(1, sb);
      qkt(pA0, pA1, lds + L_KN + sa * KN_SLOT, lds + L_KR + sa * KR_SLOT, qn, qp, r32, hi); partialSM(pA0, pA1, m_reg, alA);
      ATT_WAIT_BAR(5); ROT(); }
#define STEP(j, C0, C1, alC, P0, P1, alP) do { const int _kt = ((j) + 2 < NT) ? (j) + 2 : NT - 1, _vt = ((j) + 1 < NT) ? (j) + 1 : NT - 1; \
        const char* _gk = KNg + (size_t)_kt * (64 * DM * 2); const char* _gv = Vg + (size_t)_vt * (64 * DM * 2); \
        const unsigned _dk = (unsigned)__builtin_amdgcn_readfirstlane(dK + sc * KN_SLOT), _dr = (unsigned)__builtin_amdgcn_readfirstlane(dR + sc * KR_SLOT), _dv = (unsigned)__builtin_amdgcn_readfirstlane(dV + sb * V_SLOT); SB0(); \
        regionA(C0, C1, lds + L_KN + sa * KN_SLOT, lds + L_KR + sa * KR_SLOT, qn, qp, r32, hi, P0, P1, alP, l_reg, pa0, pa1, pa2, pa3, _gk, KRg + (size_t)_kt * (64 * QKR * 2), kn_off[0], kn_off[1], kr_off, _dk, _dr); \
        regionB(o, vb0 + sc * V_SLOT, pa0, pa1, pa2, pa3, C0, C1, m_reg, alC, _gv, v_off[0], v_off[1], _dv); RESC(alC); \
        ATT_WAIT_BAR(5); ROT(); } while (0)
#pragma unroll 1
    for (int j = 1; j + 1 < NT; j += 2) { STEP(j, pB0, pB1, alB, pA0, pA1, alA); STEP(j + 1, pA0, pA1, alA, pB0, pB1, alB); }
    STEP(NT - 1, pB0, pB1, alB, pA0, pA1, alA);
    finishSM(pB0, pB1, alB, l_reg, pa0, pa1, pa2, pa3); __builtin_amdgcn_sched_barrier(0);
    pv_d0(o, vb0 + sc * V_SLOT, pa0, pa1, pa2, pa3);
    if (hi == 0) wsf[32 + r32] = l_reg;
    ATT_WAIT_BAR(0);
    { LAS bf16_t* stg = (LAS bf16_t*)(lds + wid * 8192);
#pragma unroll
      for (int r = 0; r < 16; ++r) { const int orow = crow(r, hi); const float rl = __builtin_amdgcn_rcpf(wsf[32 + orow]);
#pragma unroll
          for (int d0 = 0; d0 < 4; ++d0) stg[orow * 128 + d0 * 32 + r32] = (bf16_t)(cvt_pk_bf16(o[d0][r] * rl, 0.f) & 0xffffu); }
      asm volatile("s_waitcnt lgkmcnt(0)" ::: "memory");
      bf16_t* Ow = O + (size_t)(q0 + wid * 32) * DM + h * VD;
#pragma unroll
      for (int i = 0; i < 8; ++i) { const int row = i * 4 + (lane >> 4), ch = lane & 15; const u32x4 v = *(const LAS u32x4*)(stg + row * 128 + ch * 8); *(u32x4*)(Ow + (size_t)row * DM + ch * 8) = v; } }
    ATT_WAIT_BAR(0);
#undef DMA_K
#undef DMA_V
#undef ROT
#undef RESC
#undef STEP
}

}

constexpr size_t MiB = 1u << 20;
constexpr size_t al(size_t x) { return (x + 255) / 256 * 256; }
constexpr size_t WS_CTL = 0, CTL_BYTES = 1 * MiB;
constexpr size_t WS_MOD = WS_CTL + CTL_BYTES, MOD_BYTES = (size_t)DEPTH * 2 * 6 * DM * 4;
constexpr size_t ZERO_BYTES = al(WS_MOD + MOD_BYTES);
constexpr size_t WS_TAB = ZERO_BYTES;
constexpr size_t WS_SSQ = al(WS_TAB + 128 * 16 * 2 * 4), WS_SSKV = al(WS_SSQ + (size_t)R * 8 * 4);
constexpr size_t WS_WIN = al(WS_SSKV + (size_t)R * 8 * 4);
constexpr size_t WS_WINB = WS_WIN + (size_t)2 * EVEN_IN * DM * 2;
constexpr size_t WS_POOLT = WS_WINB + (size_t)2 * DM * 1024 * 2;
constexpr size_t WS_WOUT = WS_POOLT + (size_t)2 * 4 * 256 * 256 * 2;
constexpr size_t WS_WDQKV = WS_WOUT + (size_t)2 * DM * DM * 2;
constexpr size_t WS_WUQ = WS_WDQKV + (size_t)2 * NDQKV * DM * 2;
constexpr size_t WS_WUKV = WS_WUQ + (size_t)2 * NQ * QLORA * 2;
constexpr size_t WS_WO = WS_WUKV + (size_t)2 * NKV * KVLORA * 2;
constexpr size_t WS_WGU = WS_WO + (size_t)2 * DM * DM * 2;
constexpr size_t WS_WDN = WS_WGU + (size_t)4 * 2 * FF * DM * 2;
constexpr size_t WS_X = al(WS_WDN + (size_t)4 * DM * FF * 2);
constexpr size_t WS_H = WS_X + (size_t)R * DM * 4;
constexpr size_t WS_Z = WS_H + (size_t)R * DM * 2;
constexpr size_t WS_CAT = WS_Z + (size_t)R * EVEN_IN * 2;
constexpr size_t WS_ACT = WS_CAT + (size_t)R * DM * 2;
constexpr size_t WS_Q = WS_ACT + (size_t)R * FF * 2;
constexpr size_t WS_KN = WS_Q + (size_t)R * NQ * 2;
constexpr size_t WS_V = WS_KN + (size_t)R * DM * 2;
constexpr size_t WS_KR = WS_V + (size_t)R * DM * 2;
constexpr size_t WS_QA = al(WS_KR + (size_t)R * QKR * 2);
constexpr size_t WS_CKV = WS_QA + (size_t)R * QLORA * 2;
constexpr size_t WS_SLAB = al(WS_CKV + (size_t)R * KVLORA * 2);
constexpr size_t WS_END = WS_SLAB + (size_t)11 * 256 * DM * 4;

constexpr int RING_BYTES = 131072, MISC_OFF = RING_BYTES + 320, LDS_BYTES = 147456;
constexpr int NWAVES = 8;

#define XB_TMO      128
#define XB_XCNT(j)  (256  + 64 * (j))
#define XB_XSUB(j)  (1280 + 64 * (j))
#define XB_XGEN(j)  (2304 + 64 * (j))
#define XB_TOP      3328
#define XB_TOPGEN   3392
#define XCD_BAR_WORDS 3456
#define XB_SPIN_CAP (1u << 18)
__device__ __forceinline__ unsigned xb_ld(unsigned* p)              { return __hip_atomic_load(p, __ATOMIC_RELAXED, __HIP_MEMORY_SCOPE_AGENT); }
__device__ __forceinline__ unsigned xb_add(unsigned* p, unsigned v) { return __hip_atomic_fetch_add(p, v, __ATOMIC_RELAXED, __HIP_MEMORY_SCOPE_AGENT); }
__device__ __forceinline__ unsigned xb_xcc_id() { return (unsigned)__builtin_amdgcn_s_getreg((3 << 11) | 20) & 0xFu; }
#define XB_SPIN(cond, bar) do { unsigned _sp = 0; while (cond) { __builtin_amdgcn_s_sleep(1); \
    if ((++_sp & 255u) == 0u) { if (xb_ld(&(bar)[XB_TMO])) break; if (_sp > XB_SPIN_CAP) { atomicAdd(&(bar)[XB_TMO], 1u); break; } } } } while (0)
struct XcdBarrier { unsigned* bar; unsigned x; volatile LAS unsigned* st; };
__device__ __forceinline__ XcdBarrier xcd_barrier_post(unsigned* bar, volatile LAS unsigned* st) {
    XcdBarrier b; b.bar = bar; b.x = xb_xcc_id(); b.st = st;
    if (threadIdx.x == 0) (void)xb_add(&bar[XB_XCNT(b.x)], 1u);
    return b;
}
__device__ __forceinline__ void xcd_barrier_complete(unsigned* bar, unsigned x, unsigned& nloc, unsigned& nx) {
    const unsigned G = gridDim.x * gridDim.y * gridDim.z;
    unsigned sum, cnt, mine, sp = 0u;
    for (;;) {
        sum = 0u; cnt = 0u; mine = 0u;
#pragma unroll
        for (unsigned j = 0; j < 16; ++j) { const unsigned c = xb_ld(&bar[XB_XCNT(j)]); sum += c; cnt += (c > 0u) ? 1u : 0u; mine = (j == x) ? c : mine; }
        if (sum == G) break;
        __builtin_amdgcn_s_sleep(1);
        if ((++sp & 255u) == 0u) { if (xb_ld(&bar[XB_TMO])) break; if (sp > XB_SPIN_CAP) { atomicAdd(&bar[XB_TMO], 1u); break; } }
    }
    nloc = mine > 0u ? mine : 1u; nx = cnt > 0u ? cnt : 1u;
}
__device__ __attribute__((noinline)) void xcd_barrier_ni(unsigned* bar_, unsigned x_, volatile LAS unsigned* st_) {
    XcdBarrier b; b.bar = bar_; b.x = x_; b.st = st_;
    asm volatile("s_waitcnt vmcnt(0)" ::: "memory");
    __syncthreads();
    if (threadIdx.x == 0) {
        unsigned* bar = b.bar;
        __builtin_amdgcn_s_waitcnt(0);
        unsigned nloc = b.st[0], nx = b.st[1];
        if (nloc == 0u) { xcd_barrier_complete(bar, b.x, nloc, nx); b.st[0] = nloc; b.st[1] = nx; }
        const unsigned old = xb_add(&bar[XB_XSUB(b.x)], 1u);
        const unsigned gen = old / nloc;
        if (old + 1u == (gen + 1u) * nloc) {
            __builtin_amdgcn_fence(__ATOMIC_RELEASE, "agent");
            asm volatile("s_waitcnt vmcnt(0)" ::: "memory");
            const unsigned og = xb_add(&bar[XB_TOP], 1u);
            const unsigned tg = og / nx;
            if (og + 1u == (tg + 1u) * nx) xb_add(&bar[XB_TOPGEN], 1u);
            else XB_SPIN(xb_ld(&bar[XB_TOPGEN]) == tg, bar);
            __builtin_amdgcn_fence(__ATOMIC_ACQUIRE, "agent");
            xb_add(&bar[XB_XGEN(b.x)], 1u);
            asm volatile("s_waitcnt vmcnt(0)" ::: "memory");
        } else {
            XB_SPIN(xb_ld(&bar[XB_XGEN(b.x)]) == gen, bar);
            __builtin_amdgcn_fence(__ATOMIC_ACQUIRE, "agent");
            asm volatile("s_waitcnt vmcnt(0)" ::: "memory");
        }
    }
    __syncthreads();
}

struct Args { const float* in[24]; float* out; unsigned char* ws; int ph_lo, ph_hi; };

__device__ __forceinline__ void transpose_item(const float* W, int ldw, int k0, int n0, bf16_t* WT, int ldt, int drow, bool perm, const float* kscale, LAS float* scr, int lane) {
    float tv[32];
    const float* wp = W + (size_t)(k0 + (lane >> 5)) * ldw + n0 + (lane & 31);
#pragma unroll
    for (int i = 0; i < 32; ++i) tv[i] = __builtin_nontemporal_load(wp + (size_t)(2 * i) * ldw);
    if (kscale) {
#pragma unroll
        for (int i = 0; i < 32; ++i) tv[i] *= kscale[k0 + 2 * i + (lane >> 5)]; }
#pragma unroll
    for (int i = 0; i < 32; ++i) scr[(2 * i + (lane >> 5)) * 33 + (lane & 31)] = tv[i];
    asm volatile("s_waitcnt lgkmcnt(0)" ::: "memory");
    const int c = lane & 7;
#pragma unroll
    for (int j = 0; j < 4; ++j) { const int nn = (lane >> 3) + 8 * j; const LAS float* s = scr + (8 * c) * 33 + nn;
        u32x4 o; o.x = cvt_pk_bf16(s[0 * 33], s[1 * 33]); o.y = cvt_pk_bf16(s[2 * 33], s[3 * 33]); o.z = cvt_pk_bf16(s[4 * 33], s[5 * 33]); o.w = cvt_pk_bf16(s[6 * 33], s[7 * 33]);
        const int dn = perm ? (2 * (nn & 15) + (nn >> 4)) : nn;
        *(u32x4*)(WT + (size_t)(drow + dn) * ldt + k0 + 8 * c) = o; }
    asm volatile("s_waitcnt lgkmcnt(0)" ::: "memory");
}
struct TJob { const float* W; int ldw, K, col0, ncols; bf16_t* WT; int ldt, kind, drow0; const float* kscale; };
__device__ __forceinline__ long tjob_items(const TJob& j) { return (long)(j.K / 64) * (j.ncols / 32); }
__device__ __forceinline__ void tjob_run(const TJob& j, long item, LAS float* scr, int lane) {
    const int nblk = j.ncols / 32, kb = (int)(item / nblk), nb = (int)(item % nblk), n0 = j.col0 + 32 * nb, rel = 32 * nb;
    int drow; bool perm = false;
    if (j.kind == 1) drow = 256 * (rel / 128) + (rel % 128);
    else if (j.kind == 2) drow = 256 * (rel / 128) + 128 + (rel % 128);
    else { drow = j.drow0 + rel; if (j.kind == 3) perm = (rel % QHD) >= QKN; if (j.kind == 4) perm = true; }
    transpose_item(j.W, j.ldw, 64 * kb, n0, j.WT, j.ldt, drow, perm, j.kscale, scr, lane);
}
constexpr int NTJOBS = 2 * (2 + 4) + 2 * 6 + 4 * 3;
__device__ __forceinline__ TJob get_tjob(unsigned char* ws, int id) {
    TJob j{}; j.kscale = nullptr; j.kind = 0; j.drow0 = 0; j.col0 = 0;
    if (id < 12) { const int l = id / 6, s = id % 6;
        if (s == 0) { j.W = INP(8) + (size_t)l * DM * EVEN_IN; j.ldw = EVEN_IN; j.K = DM; j.col0 = 1024; j.ncols = 3072; j.WT = (bf16_t*)(ws + WS_WIN) + (size_t)l * EVEN_IN * DM; j.ldt = DM; j.drow0 = 1024; }
        else if (s == 1) { j.W = INP(12) + (size_t)l * DM * DM; j.ldw = DM; j.K = DM; j.ncols = DM; j.WT = (bf16_t*)(ws + WS_WOUT) + (size_t)l * DM * DM; j.ldt = DM; }
        else { const int g = s - 2; j.W = INP(9) + (size_t)(l * 4 + g) * 65536; j.ldw = 256; j.K = 256; j.ncols = 256; j.WT = (bf16_t*)(ws + WS_POOLT) + (size_t)(l * 4 + g) * 65536; j.ldt = 256; }
    } else if (id < 24) { const int l = (id - 12) / 6, s = (id - 12) % 6;
        bf16_t* wd = (bf16_t*)(ws + WS_WDQKV) + (size_t)l * NDQKV * DM;
        if (s == 0) { j.W = INP(13) + (size_t)l * DM * QLORA; j.ldw = QLORA; j.K = DM; j.ncols = QLORA; j.WT = wd; j.ldt = DM; }
        else if (s == 1) { j.W = INP(16) + (size_t)l * DM * 576; j.ldw = 576; j.K = DM; j.ncols = KVLORA; j.WT = wd; j.ldt = DM; j.drow0 = 512; }
        else if (s == 2) { j.W = INP(16) + (size_t)l * DM * 576; j.ldw = 576; j.K = DM; j.col0 = 512; j.ncols = 64; j.WT = wd; j.ldt = DM; j.drow0 = 1024; j.kind = 4; }
        else if (s == 3) { j.W = INP(15) + (size_t)l * QLORA * NQ; j.ldw = NQ; j.K = QLORA; j.ncols = NQ; j.WT = (bf16_t*)(ws + WS_WUQ) + (size_t)l * NQ * QLORA; j.ldt = QLORA; j.kind = 3; j.kscale = INP(14) + l * QLORA; }
        else if (s == 4) { j.W = INP(18) + (size_t)l * KVLORA * NKV; j.ldw = NKV; j.K = KVLORA; j.ncols = NKV; j.WT = (bf16_t*)(ws + WS_WUKV) + (size_t)l * NKV * KVLORA; j.ldt = KVLORA; j.kscale = INP(17) + l * KVLORA; }
        else { j.W = INP(19) + (size_t)l * DM * DM; j.ldw = DM; j.K = DM; j.ncols = DM; j.WT = (bf16_t*)(ws + WS_WO) + (size_t)l * DM * DM; j.ldt = DM; }
    } else { const int l = (id - 24) / 3, s = (id - 24) % 3;
        if (s == 0) { j.W = INP(20) + (size_t)l * DM * FF; j.ldw = FF; j.K = DM; j.ncols = FF; j.WT = (bf16_t*)(ws + WS_WGU) + (size_t)l * 2 * FF * DM; j.ldt = DM; j.kind = 1; }
        else if (s == 1) { j.W = INP(21) + (size_t)l * DM * FF; j.ldw = FF; j.K = DM; j.ncols = FF; j.WT = (bf16_t*)(ws + WS_WGU) + (size_t)l * 2 * FF * DM; j.ldt = DM; j.kind = 2; }
        else { j.W = INP(22) + (size_t)l * FF * DM; j.ldw = DM; j.K = FF; j.ncols = DM; j.WT = (bf16_t*)(ws + WS_WDN) + (size_t)l * DM * FF; j.ldt = FF; }
    }
    return j;
}

__device__ __forceinline__ void prologue(unsigned char* ws, LAS unsigned char* lds, int gw, int NGW, int wave, int lane, int njobs) {
    {
        float* MOD = (float*)(ws + WS_MOD);
        const float* c0 = INP(1); const float* c1 = INP(3);
        LAS float* red = (LAS float*)lds;
        const int bxp = gw / NWAVES, Gp = NGW / NWAVES, tidp = wave * 64 + lane;
        for (int task = bxp; task < 4 * 64; task += Gp) {
            const int l = task / 64, cg = task % 64, col = cg * 192 + 3 * lane;
            const float* Wp = INP(4) + ((size_t)l * DM + wave * 256) * (6 * DM) + col;
            float s0[3] = {0.f, 0.f, 0.f}, s1[3] = {0.f, 0.f, 0.f};
#pragma unroll 1
            for (int kb = 0; kb < 256; kb += 64) {
                const float x0 = c0[wave * 256 + kb + lane], x1 = c1[wave * 256 + kb + lane];
                const float sv0 = x0 / (1.f + __expf(-x0)), sv1 = x1 / (1.f + __expf(-x1));
#pragma unroll 8
                for (int k = 0; k < 64; ++k) { const float* wp = Wp + (size_t)(kb + k) * (6 * DM);
                    const float w0 = __builtin_nontemporal_load(wp), w1 = __builtin_nontemporal_load(wp + 1), w2 = __builtin_nontemporal_load(wp + 2);
                    const float a0 = __builtin_bit_cast(float, __builtin_amdgcn_readlane(__builtin_bit_cast(int, sv0), k)), a1 = __builtin_bit_cast(float, __builtin_amdgcn_readlane(__builtin_bit_cast(int, sv1), k));
                    s0[0] += w0 * a0; s0[1] += w1 * a0; s0[2] += w2 * a0; s1[0] += w0 * a1; s1[1] += w1 * a1; s1[2] += w2 * a1; }
            }
#pragma unroll
            for (int e = 0; e < 3; ++e) { red[(wave * 2 + 0) * 192 + 3 * lane + e] = s0[e]; red[(wave * 2 + 1) * 192 + 3 * lane + e] = s1[e]; }
            __syncthreads();
            if (tidp < 384) { const int s = tidp / 192, cc = tidp % 192; float acc = INP(5)[(size_t)l * 6 * DM + cg * 192 + cc];
#pragma unroll
              for (int w = 0; w < NWAVES; ++w) acc += red[(w * 2 + s) * 192 + cc];
              MOD[((size_t)l * 2 + s) * 6 * DM + cg * 192 + cc] = acc; }
            __syncthreads();
        }
    }
    {
        LAS float* scr = (LAS float*)(lds + wave * 16384);
        long base = 0;
        for (int id = 0; id < njobs; ++id) {
            const TJob j = get_tjob(ws, id); const long n = tjob_items(j);
            long first = ((long)gw - base % NGW + NGW) % NGW;
            for (long it = first; it < n; it += NGW) tjob_run(j, it, scr, lane);
            base += n;
        }
    }
    {
        bf16_t* WB = (bf16_t*)(ws + WS_WINB);
        const long n8 = (long)2 * DM * 1024 / 8;
        for (long i = (long)gw * 64 + lane; i < n8; i += (long)NGW * 64) { const long e = i * 8; const int l = (int)(e / ((long)DM * 1024)); const long rem = e % ((long)DM * 1024); const int k = (int)(rem / 1024), m = (int)(rem % 1024);
            const float* s = INP(8) + ((size_t)l * DM + k) * EVEN_IN + m; const f32x4 v0 = *(const f32x4*)s, v1 = *(const f32x4*)(s + 4);
            *(u32x4*)(WB + e) = pack8(v0, v1); }
    }
    {
        float* TAB = (float*)(ws + WS_TAB);
        for (int i = gw * 64 + lane; i < 128 * 16; i += NGW * 64) { const int pos = i >> 4, f = i & 15; const float inv = powf(10000.f, -(float)f / 16.f); const float ang = (float)pos * inv; TAB[2 * i] = cosf(ang); TAB[2 * i + 1] = sinf(ang); }
        const long nz = (long)2 * (NDQKV - 1088) * DM / 8;
        for (long i = (long)gw * 64 + lane; i < nz; i += (long)NGW * 64) { const long e = i * 8; const int l = (int)(e / ((long)(NDQKV - 1088) * DM)); const long rem = e % ((long)(NDQKV - 1088) * DM);
            *(u32x4*)((bf16_t*)(ws + WS_WDQKV) + (size_t)l * NDQKV * DM + (size_t)1088 * DM + rem) = (u32x4){0u, 0u, 0u, 0u}; }
    }
}

constexpr int DEF_PER_LAYER = 3 * 5632;
__device__ __forceinline__ void deferred_convert(unsigned char* ws, LAS unsigned char* lds, int L, int r_begin, int r_cap, int rank, int quota, int wave, int lane) {
    LAS float* scr = (LAS float*)(lds + wave * 16384);
    for (int k = wave; k < quota; k += NWAVES) {
        const int r = r_begin + rank * quota + k; if (r >= r_cap) break;
        const int s = r / 5632;
        const TJob j = get_tjob(ws, 24 + 3 * L + s); tjob_run(j, r - s * 5632, scr, lane);
    }
}

__device__ __forceinline__ void norm_mod_phase(const float* xl, const float* xc, const float* g, const float* modl, const float* modc, int which, bf16_t* H, int gw, int NGW, int lane, int nrows) {
#pragma unroll 1
    for (int pass = 0; pass < 2; ++pass) {
        const int rlo = pass ? SEQ : 0, rhi = pass ? nrows : (nrows < SEQ ? nrows : SEQ);
        if (rlo >= rhi) continue;
        const float* mod = pass ? modc : modl; const float* xb = pass ? xc : xl;
        const float* sh = mod + (which ? 3 : 0) * DM; const float* sc = sh + DM;
        f32x4 A[8], B[8];
#pragma unroll
        for (int j = 0; j < 8; ++j) { const int c = 256 * j + 4 * lane; A[j] = *(const f32x4*)(g + c); B[j] = *(const f32x4*)(sc + c); }
        __builtin_amdgcn_sched_barrier(0);
#pragma unroll
        for (int j = 0; j < 8; ++j) { const int c = 256 * j + 4 * lane; A[j] = A[j] * (B[j] + 1.f); B[j] = *(const f32x4*)(sh + c); }
        for (int row = rlo + gw; row < rhi; row += NGW) {
            const f32x4* xr = (const f32x4*)(xb + (size_t)row * DM) + lane; f32x4 v[8]; float ss = 0.f;
#pragma unroll
            for (int j = 0; j < 8; ++j) v[j] = __builtin_nontemporal_load(xr + 64 * j);
            asm volatile("" : "+v"(v[0]), "+v"(v[1]), "+v"(v[2]), "+v"(v[3]), "+v"(v[4]), "+v"(v[5]), "+v"(v[6]), "+v"(v[7]));
#pragma unroll
            for (int j = 0; j < 8; ++j) ss += (v[j][0] * v[j][0] + v[j][1] * v[j][1]) + (v[j][2] * v[j][2] + v[j][3] * v[j][3]);
            const float rstd = __builtin_amdgcn_rsqf(wave_sum(ss) * (1.f / DM) + EPS);
            u32x2* o = (u32x2*)(H + (size_t)row * DM) + lane;
#pragma unroll
            for (int j = 0; j < 8; ++j) { const f32x4 y = v[j] * rstd * A[j] + B[j]; u32x2 w; w.x = cvt_pk_bf16(y[0], y[1]); w.y = cvt_pk_bf16(y[2], y[3]); o[64 * j] = w; }
        }
    }
}
__device__ __forceinline__ void norm_mod_phase16(const bf16_t* X, const float* g, const float* mod, int which, bf16_t* H, int gw, int NGW, int lane) {
    const float* sh = mod + (which ? 3 : 0) * DM; const float* sc = sh + DM;
    f32x4 A[4][2], B[4][2];
#pragma unroll
    for (int j = 0; j < 4; ++j)
#pragma unroll
        for (int h = 0; h < 2; ++h) { const int c = 512 * j + 8 * lane + 4 * h; A[j][h] = *(const f32x4*)(g + c); B[j][h] = *(const f32x4*)(sc + c); }
    __builtin_amdgcn_sched_barrier(0);
#pragma unroll
    for (int j = 0; j < 4; ++j)
#pragma unroll
        for (int h = 0; h < 2; ++h) { const int c = 512 * j + 8 * lane + 4 * h; A[j][h] = A[j][h] * (B[j][h] + 1.f); B[j][h] = *(const f32x4*)(sh + c); }
    for (int row = gw; row < SEQ; row += 2 * NGW) {
        const int row2 = row + NGW; const bool has2 = row2 < SEQ; const int r2 = has2 ? row2 : row;
        const u32x4* xr = (const u32x4*)(X + (size_t)row * DM) + lane; const u32x4* xs = (const u32x4*)(X + (size_t)r2 * DM) + lane;
        u32x4 ra[4], rb[4];
#pragma unroll
        for (int j = 0; j < 4; ++j) ra[j] = xr[64 * j];
#pragma unroll
        for (int j = 0; j < 4; ++j) rb[j] = xs[64 * j];
        f32x4 v[4][2], w[4][2]; float ss = 0.f, st = 0.f;
#pragma unroll
        for (int j = 0; j < 4; ++j) { xunpack8(ra[j], v[j][0], v[j][1]);
#pragma unroll
            for (int h = 0; h < 2; ++h) ss += (v[j][h][0] * v[j][h][0] + v[j][h][1] * v[j][h][1]) + (v[j][h][2] * v[j][h][2] + v[j][h][3] * v[j][h][3]); }
#pragma unroll
        for (int j = 0; j < 4; ++j) { xunpack8(rb[j], w[j][0], w[j][1]);
#pragma unroll
            for (int h = 0; h < 2; ++h) st += (w[j][h][0] * w[j][h][0] + w[j][h][1] * w[j][h][1]) + (w[j][h][2] * w[j][h][2] + w[j][h][3] * w[j][h][3]); }
        const float rstd = __builtin_amdgcn_rsqf(wave_sum(ss) * (1.f / DM) + EPS), rstd2 = __builtin_amdgcn_rsqf(wave_sum(st) * (1.f / DM) + EPS);
        u32x4* o = (u32x4*)(H + (size_t)row * DM) + lane;
#pragma unroll
        for (int j = 0; j < 4; ++j) o[64 * j] = pack8(v[j][0] * rstd * A[j][0] + B[j][0], v[j][1] * rstd * A[j][1] + B[j][1]);
        if (has2) { u32x4* o2 = (u32x4*)(H + (size_t)row2 * DM) + lane;
#pragma unroll
            for (int j = 0; j < 4; ++j) o2[64 * j] = pack8(w[j][0] * rstd2 * A[j][0] + B[j][0], w[j][1] * rstd2 * A[j][1] + B[j][1]); }
    }
}
__device__ __forceinline__ void final_norm_phase(const bf16_t* X, const float* g, float* out, int gw, int NGW, int lane) {
    f32x4 G[4][2];
#pragma unroll
    for (int j = 0; j < 4; ++j)
#pragma unroll
        for (int h = 0; h < 2; ++h) G[j][h] = *(const f32x4*)(g + 512 * j + 8 * lane + 4 * h);
    for (int row = gw; row < SEQ; row += NGW) {
        const u32x4* xr = (const u32x4*)(X + (size_t)row * DM) + lane; f32x4 v[4][2]; float ss = 0.f;
#pragma unroll
        for (int j = 0; j < 4; ++j) { xunpack8(xr[64 * j], v[j][0], v[j][1]);
#pragma unroll
            for (int h = 0; h < 2; ++h) ss += (v[j][h][0] * v[j][h][0] + v[j][h][1] * v[j][h][1]) + (v[j][h][2] * v[j][h][2] + v[j][h][3] * v[j][h][3]); }
        const float rstd = __builtin_amdgcn_rsqf(wave_sum(ss) * (1.f / DM) + EPS);
        float* o = out + (size_t)row * DM + 8 * lane;
#pragma unroll
        for (int j = 0; j < 4; ++j) { *(f32x4*)(o + 512 * j) = v[j][0] * rstd * G[j][0]; *(f32x4*)(o + 512 * j + 4) = v[j][1] * rstd * G[j][1]; }
    }
}
template <int S>
__device__ __forceinline__ void ctx_norm_phase(const float* __restrict__ x32, const bf16_t* x16, bf16_t* Xc, const bf16_t* __restrict__ slab, const float* __restrict__ gate, const float* __restrict__ g, const float* __restrict__ modc, int which, bf16_t* __restrict__ Hc, LAS float* red, int bx, int G, int tid) {
    const int col = 4 * tid, lane = tid & 63, wave = tid >> 6;
    const float* sh = modc + (which ? 3 : 0) * DM; const float* sc = sh + DM;
    for (int r = bx; r < CTXL; r += G) {
        f32x4 v; u32x2 sw[S > 0 ? S : 1];
        if (x32) v = *(const f32x4*)(x32 + (size_t)r * DM + col);
        else { const u32x2 w = *(const u32x2*)(x16 + (size_t)r * DM + col); const f32x2 p = xun(w.x), q = xun(w.y); v = (f32x4){p[0], p[1], q[0], q[1]}; }
#pragma unroll
        for (int s = 0; s < S; ++s) sw[s] = *(const u32x2*)(slab + ((size_t)s * 256 + r) * DM + col);
        const f32x4 gv = *(const f32x4*)(g + col), scv = *(const f32x4*)(sc + col), shv = *(const f32x4*)(sh + col);
        if (S > 0) { const f32x4 gt = *(const f32x4*)(gate + col); f32x4 a = {0.f, 0.f, 0.f, 0.f};
#pragma unroll
            for (int s = 0; s < S; ++s) { const f32x2 p = xun(sw[s].x), q = xun(sw[s].y); a += (f32x4){p[0], p[1], q[0], q[1]}; }
            v += gt * a;
            u32x2 w; w.x = xpk(v[0], v[1]); w.y = xpk(v[2], v[3]); *(u32x2*)(Xc + (size_t)r * DM + col) = w;
            const f32x2 p = xun(w.x), q = xun(w.y); v = (f32x4){p[0], p[1], q[0], q[1]}; }
        float ss = wave_sum((v[0] * v[0] + v[1] * v[1]) + (v[2] * v[2] + v[3] * v[3]));
        if (lane == 0) red[wave] = ss;
        __syncthreads();
        float tot = 0.f;
#pragma unroll
        for (int w = 0; w < NWAVES; ++w) tot += red[w];
        __syncthreads();
        const float rstd = __builtin_amdgcn_rsqf(tot * (1.f / DM) + EPS);
        const f32x4 A = gv * (scv + 1.f), y = v * rstd * A + shv;
        u32x2 w; w.x = cvt_pk_bf16(y[0], y[1]); w.y = cvt_pk_bf16(y[2], y[3]); *(u32x2*)(Hc + (size_t)r * DM + col) = w;
    }
}
__device__ __forceinline__ void ld8f(const bf16_t* p, float (&f)[8]) { const u32x4 w = *(const u32x4*)p; f[0] = bf_lo(w.x); f[1] = bf_hi(w.x); f[2] = bf_lo(w.y); f[3] = bf_hi(w.y); f[4] = bf_lo(w.z); f[5] = bf_hi(w.z); f[6] = bf_lo(w.w); f[7] = bf_hi(w.w); }
__device__ __forceinline__ void ld8s(const bf16_t* ZS, int q, int c, float (&f)[8]) {
    f32x4 a = {0.f, 0.f, 0.f, 0.f}, b = a;
#pragma unroll
    for (int s = 0; s < 4; ++s) { f32x4 x, y; xunpack8(*(const u32x4*)(ZS + ((size_t)s * 256 + q) * EVEN_IN + c), x, y); a += x; b += y; }
    f[0] = a[0]; f[1] = a[1]; f[2] = a[2]; f[3] = a[3]; f[4] = b[0]; f[5] = b[1]; f[6] = b[2]; f[7] = b[3];
}
__device__ __forceinline__ void ld4s_raw(const bf16_t* __restrict__ ZS, int q, int c, u32x4 (&r)[4]) {
#pragma unroll
    for (int s = 0; s < 4; ++s) r[s] = *(const u32x4*)(ZS + ((size_t)s * 256 + q) * EVEN_IN + c);
}
__device__ __forceinline__ void sum4s(const u32x4 (&r)[4], float (&f)[8]) {
    f32x4 a = {0.f, 0.f, 0.f, 0.f}, b = a;
#pragma unroll
    for (int s = 0; s < 4; ++s) { f32x4 x, y; xunpack8(r[s], x, y); a += x; b += y; }
    f[0] = a[0]; f[1] = a[1]; f[2] = a[2]; f[3] = a[3]; f[4] = b[0]; f[5] = b[1]; f[6] = b[2]; f[7] = b[3];
}
__device__ __forceinline__ void acc8m(float (&s)[8], const u32x4 w, float m) {
    s[0] += m * bf_lo(w.x); s[1] += m * bf_hi(w.x); s[2] += m * bf_lo(w.y); s[3] += m * bf_hi(w.y); s[4] += m * bf_lo(w.z); s[5] += m * bf_hi(w.z); s[6] += m * bf_lo(w.w); s[7] += m * bf_hi(w.w);
}
__device__ __forceinline__ void up8(const u32x4 w, float (&f)[8]) { f[0] = bf_lo(w.x); f[1] = bf_hi(w.x); f[2] = bf_lo(w.y); f[3] = bf_hi(w.y); f[4] = bf_lo(w.z); f[5] = bf_hi(w.z); f[6] = bf_lo(w.w); f[7] = bf_hi(w.w); }
__device__ __forceinline__ void mixer_ctx_token(const bf16_t* __restrict__ ZS, const float* __restrict__ convw, bf16_t* __restrict__ CAT, int tl, int ch) {
    constexpr int n = CTXL; const int t = SEQ + tl;
    float o[8], f[8];
    if (ch < 128) {
        const int c = 8 * ch, hw = 1 << (c >> 8); const int lo = (tl - hw) < 0 ? 0 : (tl - hw), hi = (tl + hw) > n ? n : (tl + hw);
        float s[8] = {0.f, 0.f, 0.f, 0.f, 0.f, 0.f, 0.f, 0.f};
#pragma unroll 1
        for (int qb = tl - hw; qb < tl + hw; qb += 4) {
            u32x4 rw[4][4];
#pragma unroll
            for (int j = 0; j < 4; ++j) { const int q = qb + j, qc = q < 0 ? 0 : (q > n - 1 ? n - 1 : q); ld4s_raw(ZS, qc, c, rw[j]); }
#pragma unroll
            for (int j = 0; j < 4; ++j) { const int q = qb + j; const float m = (q >= 0 && q < n && q < tl + hw) ? 1.f : 0.f; float fa[8]; sum4s(rw[j], fa);
#pragma unroll
                for (int e = 0; e < 8; ++e) s[e] += m * fa[e]; }
        }
        { u32x4 rw[4]; ld4s_raw(ZS, tl, c, rw); sum4s(rw, f); }
        const float ic = 1.f / (float)(hi - lo);
#pragma unroll
        for (int e = 0; e < 8; ++e) o[e] = s[e] * ic - f[e];
        *(u32x4*)(CAT + (size_t)t * DM + c) = pack8((f32x4){o[0], o[1], o[2], o[3]}, (f32x4){o[4], o[5], o[6], o[7]});
    } else {
        const int c = 8 * (ch - 128); float cv[8] = {0.f, 0.f, 0.f, 0.f, 0.f, 0.f, 0.f, 0.f};
        u32x4 rg[3][4], rv[3][4], rf[4];
#pragma unroll
        for (int k = 0; k < 3; ++k) { const int q = tl + k - 1, qc = q < 0 ? 0 : (q > n - 1 ? n - 1 : q); ld4s_raw(ZS, qc, 2048 + c, rg[k]); ld4s_raw(ZS, qc, 3072 + c, rv[k]); }
        ld4s_raw(ZS, tl, 1024 + c, rf);
#pragma unroll
        for (int k = 0; k < 3; ++k) { const int q = tl + k - 1; const float m = (q >= 0 && q < n) ? 1.f : 0.f; float g[8], v[8]; sum4s(rg[k], g); sum4s(rv[k], v);
            const f32x4 w0 = *(const f32x4*)(convw + k * 1024 + c), w1 = *(const f32x4*)(convw + k * 1024 + c + 4);
#pragma unroll
            for (int e = 0; e < 4; ++e) { cv[e] += m * g[e] * v[e] * w0[e]; cv[4 + e] += m * g[4 + e] * v[4 + e] * w1[e]; } }
        sum4s(rf, f);
#pragma unroll
        for (int e = 0; e < 8; ++e) o[e] = f[e] * cv[e];
        *(u32x4*)(CAT + (size_t)t * DM + 1024 + c) = pack8((f32x4){o[0], o[1], o[2], o[3]}, (f32x4){o[4], o[5], o[6], o[7]});
    }
}
__device__ __forceinline__ void mixer_run16(const bf16_t* __restrict__ Z, const float* __restrict__ convw, bf16_t* __restrict__ CAT, int t0, int ch) {
    if (ch < 128) {
        const int c = 8 * ch, hw = 1 << (c >> 8);
        const bf16_t* Zc = Z + c;
        float s[8] = {0.f, 0.f, 0.f, 0.f, 0.f, 0.f, 0.f, 0.f};
#pragma unroll 1
        for (int qb = t0 - hw; qb < t0 + hw; qb += 4) {
            u32x4 w[4];
#pragma unroll
            for (int j = 0; j < 4; ++j) { const int q = qb + j, qc = q < 0 ? 0 : (q > SEQ - 1 ? SEQ - 1 : q); w[j] = *(const u32x4*)(Zc + (size_t)qc * EVEN_IN); }
#pragma unroll
            for (int j = 0; j < 4; ++j) { const int q = qb + j; acc8m(s, w[j], (q >= 0 && q < SEQ && q < t0 + hw) ? 1.f : 0.f); }
        }
#pragma unroll 1
        for (int i0 = 0; i0 < 16; i0 += 4) {
            u32x4 wc[4], wp[4], wm[4];
#pragma unroll
            for (int i = 0; i < 4; ++i) { const int t = t0 + i0 + i, tp = (t + hw) > SEQ - 1 ? SEQ - 1 : (t + hw), tm = (t - hw) < 0 ? 0 : (t - hw);
                wc[i] = *(const u32x4*)(Zc + (size_t)t * EVEN_IN); wp[i] = *(const u32x4*)(Zc + (size_t)tp * EVEN_IN); wm[i] = *(const u32x4*)(Zc + (size_t)tm * EVEN_IN); }
#pragma unroll
            for (int i = 0; i < 4; ++i) { const int t = t0 + i0 + i; const int lo = (t - hw) < 0 ? 0 : (t - hw), hi = (t + hw) > SEQ ? SEQ : (t + hw);
                const float ic = 1.f / (float)(hi - lo); float f[8], o[8]; up8(wc[i], f);
#pragma unroll
                for (int e = 0; e < 8; ++e) o[e] = s[e] * ic - f[e];
                *(u32x4*)(CAT + (size_t)t * DM + c) = pack8((f32x4){o[0], o[1], o[2], o[3]}, (f32x4){o[4], o[5], o[6], o[7]});
                acc8m(s, wp[i], (t + hw < SEQ) ? 1.f : 0.f); acc8m(s, wm[i], (t - hw >= 0) ? -1.f : 0.f); }
        }
    } else {
        const int c = 8 * (ch - 128); const bf16_t* Zb = Z + 1024 + c; const bf16_t* Zg = Z + 2048 + c; const bf16_t* Zv = Z + 3072 + c;
        float up[8], uc[8], w0[8], w1[8], w2[8];
#pragma unroll
        for (int e = 0; e < 8; ++e) { w0[e] = convw[c + e]; w1[e] = convw[1024 + c + e]; w2[e] = convw[2048 + c + e]; }
        { const int tq = t0 > 0 ? t0 - 1 : 0; const float m = t0 > 0 ? 1.f : 0.f;
          const u32x4 a = *(const u32x4*)(Zg + (size_t)tq * EVEN_IN), b = *(const u32x4*)(Zv + (size_t)tq * EVEN_IN), a2 = *(const u32x4*)(Zg + (size_t)t0 * EVEN_IN), b2 = *(const u32x4*)(Zv + (size_t)t0 * EVEN_IN);
          float x[8], y[8]; up8(a, x); up8(b, y);
#pragma unroll
          for (int e = 0; e < 8; ++e) up[e] = m * x[e] * y[e];
          up8(a2, x); up8(b2, y);
#pragma unroll
          for (int e = 0; e < 8; ++e) uc[e] = x[e] * y[e]; }
#pragma unroll 1
        for (int i0 = 0; i0 < 16; i0 += 4) {
            u32x4 g[4], v[4], fb[4];
#pragma unroll
            for (int i = 0; i < 4; ++i) { const int t = t0 + i0 + i, tn = (t + 1) > SEQ - 1 ? SEQ - 1 : (t + 1);
                g[i] = *(const u32x4*)(Zg + (size_t)tn * EVEN_IN); v[i] = *(const u32x4*)(Zv + (size_t)tn * EVEN_IN); fb[i] = *(const u32x4*)(Zb + (size_t)t * EVEN_IN); }
#pragma unroll
            for (int i = 0; i < 4; ++i) { const int t = t0 + i0 + i; const float m = (t + 1 < SEQ) ? 1.f : 0.f; float x[8], y[8], f[8], o[8]; up8(g[i], x); up8(v[i], y); up8(fb[i], f);
#pragma unroll
                for (int e = 0; e < 8; ++e) { const float un = m * x[e] * y[e]; o[e] = f[e] * (up[e] * w0[e] + uc[e] * w1[e] + un * w2[e]); up[e] = uc[e]; uc[e] = un; }
                *(u32x4*)(CAT + (size_t)t * DM + 1024 + c) = pack8((f32x4){o[0], o[1], o[2], o[3]}, (f32x4){o[4], o[5], o[6], o[7]}); }
        }
    }
}
__device__ __forceinline__ void mixer_phase(const bf16_t* Z, const bf16_t* ZS, const float* convw, bf16_t* CAT, int wg, int nwg, int tid) {
    const int ch = tid & 255, tsub = tid >> 8;
    for (int blk = wg; blk < SEQ / 32; blk += nwg) {
        mixer_run16(Z, convw, CAT, blk * 32 + 16 * tsub, ch);
        if (tsub == 0) mixer_ctx_token(ZS, convw, CAT, blk, ch);
    }
}

template <class Epi, class Sched>
__device__ __forceinline__ void run_gemm(LAS unsigned char* lds, const pg8::Gemm g, const Sched& S, const Epi& E) {
#if MK_SIMPLE_GEMM
    pg8::gemm_simple<Epi, Sched>(g, S, E);
#else
    pg8::gemm_phase<Epi, Sched, true, true>(lds, g, S, E);
#endif
}
constexpr int N_PHASES = 1 + 8 * DEPTH + 1;

__global__ void __launch_bounds__(NWAVES * 64, 2) mk_fwd(Args args) {
    extern __shared__ __attribute__((aligned(16))) unsigned char lds_raw[];
    LAS unsigned char* lds = (LAS unsigned char*)lds_raw;
    volatile LAS unsigned* MISC = (volatile LAS unsigned*)(lds + MISC_OFF);
    const int G = gridDim.x, NGW = G * NWAVES;
    for (int u = threadIdx.x; u < (LDS_BYTES - RING_BYTES) / 4; u += NWAVES * 64) ((LAS unsigned*)(lds + RING_BYTES))[u] = 0u;
    __syncthreads();
#if MK_ONE_LAUNCH
    XcdBarrier bar = xcd_barrier_post((unsigned*)(KARG(unsigned char*, 200) + WS_CTL) + 4096, MISC + 8);
#define GRID_BAR() xcd_barrier_ni(bar.bar, bar.x, bar.st)
#else
#define GRID_BAR() do {} while (0)
#endif
#if MK_ONE_LAUNCH
    constexpr int lo = 0, hi = N_PHASES;
#else
    const int lo = KARG(int, 208), hi = KARG(int, 212);
#endif
#define IN(k) (lo <= (k) && (k) < hi)
#ifndef PH_MASK
#define PH_MASK 0xffffffffu
#endif
#define PH_ON(b) ((PH_MASK >> (b)) & 1u)
#define SEAM(k) do { if ((k) + 1 < hi) GRID_BAR(); } while (0)
#define WSP() unsigned char* ws = KARG(unsigned char*, 200); const int tid = otid(), lane = tid & 63, wave = __builtin_amdgcn_readfirstlane(tid >> 6), bx = obid(), gw = bx * NWAVES + wave; (void)lane; (void)gw
#define MODL(l) ((const float*)(ws + WS_MOD) + (size_t)((l) * 2 + 0) * 6 * DM)
#define MODC(l) ((const float*)(ws + WS_MOD) + (size_t)((l) * 2 + 1) * 6 * DM)

    if (PH_ON(0) && IN(0)) { WSP(); prologue(ws, lds, gw, NGW, wave, lane, (G == 256) ? 26 : NTJOBS); SEAM(0); }

#pragma unroll 1
    for (int l = 0; l < DEPTH; ++l) {
        const int pb = 1 + 8 * l, i2 = l >> 1; const bool lastl = (l == DEPTH - 1);
        if (IN(pb + 0)) {
            WSP();
            const int nf = ((l & 1) == 0 && PH_ON(2) && G > 64) ? 32 : 0;
            if (PH_ON(1) && bx >= nf) { bf16_t* X = (bf16_t*)(ws + WS_X); const int gwn = gw - nf * NWAVES, NGWn = NGW - nf * NWAVES, bxn = bx - nf, Gn = G - nf;
              if (l == 0) norm_mod_phase(INP(0), INP(0), INP(6) + l * DM, MODL(l), MODC(l), 0, (bf16_t*)(ws + WS_H), gwn, NGWn, lane, SEQ);
              else norm_mod_phase16(X, INP(6) + l * DM, MODL(l), 0, (bf16_t*)(ws + WS_H), gwn, NGWn, lane);
              if (l == 0) ctx_norm_phase<0>(INP(2), X + (size_t)SEQ * DM, X + (size_t)SEQ * DM, (const bf16_t*)(ws + WS_SLAB), nullptr, INP(6) + l * DM, MODC(l), 0, (bf16_t*)(ws + WS_H) + (size_t)SEQ * DM, (LAS float*)(lds + MISC_OFF + 64), bxn, Gn, tid);
              else ctx_norm_phase<11>(nullptr, X + (size_t)SEQ * DM, X + (size_t)SEQ * DM, (const bf16_t*)(ws + WS_SLAB), MODC(l - 1) + 5 * DM, INP(6) + l * DM, MODC(l), 0, (bf16_t*)(ws + WS_H) + (size_t)SEQ * DM, (LAS float*)(lds + MISC_OFF + 64), bxn, Gn, tid); }
            if (PH_ON(2) && (l & 1) == 0) {
                pg8::Gemm g{(const bf16_t*)(ws + WS_POOLT) + (size_t)i2 * 4 * 65536, (const bf16_t*)(ws + WS_WINB) + (size_t)i2 * DM * 1024, 256, 1024, 4};
                pg8::FoldOrder S{bx}; EpiBf16 E{(bf16_t*)(ws + WS_WIN) + (size_t)i2 * EVEN_IN * DM, DM, INP(10) + i2 * 1024};
                pg8::gemm_simple<EpiBf16, pg8::FoldOrder>(g, S, E);
            }
            SEAM(pb + 0);
        }
        if ((l & 1) == 0) {
            if (PH_ON(3) && IN(pb + 1)) { WSP(); pg8::Gemm g{(const bf16_t*)(ws + WS_H), (const bf16_t*)(ws + WS_WIN) + (size_t)i2 * EVEN_IN * DM, DM, DM, DM / 64};
                pg8::LatCtxOrder S; S.so.init(SEQ / 256, EVEN_IN / 256, G, bx, DM / 64); S.ntn = EVEN_IN / 256; S.nsl = 4 * (EVEN_IN / 256); S.kchunk = DM / 4;
                EpiWithSlab<EpiBf16> E{{(bf16_t*)(ws + WS_Z), EVEN_IN, nullptr}, (bf16_t*)(ws + WS_SLAB), EVEN_IN};
                run_gemm(lds, g, S, E);
                if (G == 256 && bx >= 64) { if (l == 0) deferred_convert(ws, lds, 0, 11264, 14336, bx - 64, 16, wave, lane); else deferred_convert(ws, lds, 2, 10752, 13824, bx - 64, 16, wave, lane); }
                SEAM(pb + 1); }
            if (PH_ON(4) && IN(pb + 2)) { WSP(); mixer_phase((const bf16_t*)(ws + WS_Z), (const bf16_t*)(ws + WS_SLAB), INP(11) + (size_t)i2 * 3 * 1024, (bf16_t*)(ws + WS_CAT), bx, G, tid); SEAM(pb + 2); }
            if (PH_ON(5) && IN(pb + 3)) { WSP(); bf16_t* X = (bf16_t*)(ws + WS_X); const float* xl = (l == 0) ? INP(0) : nullptr;
                pg8::Gemm g{(const bf16_t*)(ws + WS_CAT), (const bf16_t*)(ws + WS_WOUT) + (size_t)i2 * DM * DM, DM, DM, DM / 64};
                pg8::LatCtxOrder S; S.so.init(SEQ / 256, DM / 256, G, bx, DM / 64); S.ntn = DM / 256; S.nsl = 8 * (DM / 256); S.kchunk = DM / 8;
                EpiWithSlab<EpiResid> E{{xl, X, X, MODL(l) + 2 * DM}, (bf16_t*)(ws + WS_SLAB), DM}; run_gemm(lds, g, S, E);
                if (G == 256 && bx >= 64) { if (l == 0) deferred_convert(ws, lds, 0, 14336, 16896, bx - 64, 14, wave, lane); else deferred_convert(ws, lds, 2, 13824, 16896, bx - 64, 16, wave, lane); }
                SEAM(pb + 3); }
        } else {
            if (PH_ON(6) && IN(pb + 1)) { WSP(); pg8::Gemm g{(const bf16_t*)(ws + WS_H), (const bf16_t*)(ws + WS_WDQKV) + (size_t)i2 * NDQKV * DM, DM, DM, DM / 64}; pg8::StaticOrder S; S.init(NPANEL, NDQKV / 256, G, bx, DM / 64);
                EpiDQKV E{(bf16_t*)(ws + WS_QA), (bf16_t*)(ws + WS_CKV), (bf16_t*)(ws + WS_KR), (float*)(ws + WS_SSQ), (float*)(ws + WS_SSKV), (const float*)(ws + WS_TAB)}; run_gemm(lds, g, S, E);
                if (G == 256 && bx >= 165) deferred_convert(ws, lds, l, 10752, 16896, bx - 165, 68, wave, lane);
                SEAM(pb + 1); }
            if (IN(pb + 2)) {
                if (PH_ON(7)) { WSP(); pg8::Gemm g{(const bf16_t*)(ws + WS_QA), (const bf16_t*)(ws + WS_WUQ) + (size_t)i2 * NQ * QLORA, QLORA, QLORA, QLORA / 64}; pg8::StaticOrder S; S.init(lastl ? SEQ / 256 : NPANEL, NQ / 256, G, bx, QLORA / 64);
                  EpiUQ E{(bf16_t*)(ws + WS_Q), (const float*)(ws + WS_SSQ), (const float*)(ws + WS_TAB)}; run_gemm(lds, g, S, E); }
                if (PH_ON(8)) { WSP(); pg8::Gemm g{(const bf16_t*)(ws + WS_CKV), (const bf16_t*)(ws + WS_WUKV) + (size_t)i2 * NKV * KVLORA, KVLORA, KVLORA, KVLORA / 64}; pg8::StaticOrder S; S.init(NPANEL, NKV / 256, G, G - 1 - bx, KVLORA / 64);
                  EpiUKV E{(bf16_t*)(ws + WS_KN), (bf16_t*)(ws + WS_V), (const float*)(ws + WS_SSKV)}; run_gemm(lds, g, S, E); }
                SEAM(pb + 2); }
            if (PH_ON(9) && IN(pb + 3)) {
                WSP(); LAS float* wsf = (LAS float*)(lds) + wave * 64; (void)wsf;
                const bf16_t* Qb = (const bf16_t*)(ws + WS_Q); const bf16_t* KN = (const bf16_t*)(ws + WS_KN); const bf16_t* KR = (const bf16_t*)(ws + WS_KR); const bf16_t* Vb = (const bf16_t*)(ws + WS_V); bf16_t* CAT = (bf16_t*)(ws + WS_CAT);
                const int nunits = 2 * 256 + (lastl ? 0 : NHEAD);
#pragma unroll 1
                for (int uid = bx; uid < nunits; uid += G) {
#if MK_SIMPLE_ATTN
                    if (uid < 512) att::unit_simple(Qb, KN, KR, Vb, CAT, (uid & 7) + 8 * (uid >> 8), ((uid >> 3) & 31) * 256, 0, R, wsf);
                    else att::unit_simple(Qb, KN, KR, Vb, CAT, uid - 512, SEQ, SEQ, CTXL, wsf);
#else
                    if (uid < 512) att::unit_il(Qb, KN, KR, Vb, CAT, (uid & 7) + 8 * (uid >> 8), ((uid >> 3) & 31) * 256, 0, R, lds);
                    else att::unit_il(Qb, KN, KR, Vb, CAT, uid - 512, SEQ, SEQ, CTXL, lds);
#endif
                }
                SEAM(pb + 3); }
            if (PH_ON(10) && IN(pb + 4)) { WSP(); bf16_t* X = (bf16_t*)(ws + WS_X); pg8::Gemm g{(const bf16_t*)(ws + WS_CAT), (const bf16_t*)(ws + WS_WO) + (size_t)i2 * DM * DM, DM, DM, DM / 64};
                pg8::LatCtxOrder S; S.so.init(SEQ / 256, DM / 256, G, bx, DM / 64); S.ntn = DM / 256; S.nsl = lastl ? 0 : 8 * (DM / 256); S.kchunk = DM / 8;
                EpiWithSlab<EpiResid> E{{nullptr, X, X, MODL(l) + 2 * DM}, (bf16_t*)(ws + WS_SLAB), DM}; run_gemm(lds, g, S, E); SEAM(pb + 4); }
        }
        const int fb = pb + ((l & 1) ? 5 : 4);
        if (PH_ON(11) && IN(fb)) { WSP(); bf16_t* X = (bf16_t*)(ws + WS_X); norm_mod_phase16(X, INP(7) + l * DM, MODL(l), 1, (bf16_t*)(ws + WS_H), gw, NGW, lane);
            if (!lastl) ctx_norm_phase<8>((l == 0) ? INP(2) : nullptr, X + (size_t)SEQ * DM, X + (size_t)SEQ * DM, (const bf16_t*)(ws + WS_SLAB), MODC(l) + 2 * DM, INP(7) + l * DM, MODC(l), 1,
                                          (bf16_t*)(ws + WS_H) + (size_t)SEQ * DM, (LAS float*)(lds + MISC_OFF + 64), bx, G, tid);
            SEAM(fb); }
        if (PH_ON(12) && IN(fb + 1)) { WSP(); pg8::Gemm g{(const bf16_t*)(ws + WS_H), (const bf16_t*)(ws + WS_WGU) + (size_t)l * 2 * FF * DM, DM, DM, DM / 64}; pg8::StaticOrder S; S.init(lastl ? SEQ / 256 : NPANEL, 2 * FF / 256, G, bx, DM / 64); EpiSwiGLU E{(bf16_t*)(ws + WS_ACT)};
            run_gemm(lds, g, S, E);
            if (G == 256 && !lastl && bx >= 172) deferred_convert(ws, lds, l + 1, 0, 6720, bx - 172, 80, wave, lane);
            SEAM(fb + 1); }
        if (PH_ON(13) && IN(fb + 2)) { WSP(); bf16_t* X = (bf16_t*)(ws + WS_X); pg8::Gemm g{(const bf16_t*)(ws + WS_ACT), (const bf16_t*)(ws + WS_WDN) + (size_t)l * DM * FF, FF, FF, FF / 64};
            pg8::LatCtxOrder S; S.so.init(SEQ / 256, DM / 256, G, bx, FF / 64); S.ntn = DM / 256; S.nsl = lastl ? 0 : 11 * (DM / 256); S.kchunk = FF / 11;
            EpiWithSlab<EpiResid> E{{nullptr, X, X, MODL(l) + 5 * DM}, (bf16_t*)(ws + WS_SLAB), DM}; run_gemm(lds, g, S, E);
            if (G == 256 && !lastl && bx >= 88) deferred_convert(ws, lds, l + 1, 6720, 10752, bx - 88, 24, wave, lane);
            SEAM(fb + 2); }
    }
    if (PH_ON(14) && IN(N_PHASES - 1)) { WSP(); final_norm_phase((const bf16_t*)(ws + WS_X), INP(23), KARG(float*, 192), gw, NGW, lane); }
#undef IN
#undef SEAM
}

extern "C" void kernel_launch(void* const* d_in, const int* in_sizes, int n_in, void* d_out, int out_size, void* d_ws, size_t ws_size, hipStream_t stream) {
    static int grid = 0;
    if (grid == 0) {
        if (n_in != 24 || in_sizes[0] != SEQ * DM || out_size != SEQ * DM || ws_size < WS_END) { fprintf(stderr, "kernel_launch: unexpected shapes (n_in %d, in0 %d, out %d, ws %zu < %zu)\n", n_in, n_in > 0 ? in_sizes[0] : -1, out_size, ws_size, (size_t)WS_END); grid = -1; return; }
        int dev = 0, cus = 0, per_cu = 0;
        if (hipGetDevice(&dev) != hipSuccess || hipDeviceGetAttribute(&cus, hipDeviceAttributeMultiprocessorCount, dev) != hipSuccess) { grid = -1; return; }
        if (hipFuncSetAttribute((const void*)mk_fwd, hipFuncAttributeMaxDynamicSharedMemorySize, LDS_BYTES) != hipSuccess) { fprintf(stderr, "kernel_launch: hipFuncSetAttribute failed\n"); grid = -1; return; }
        if (hipOccupancyMaxActiveBlocksPerMultiprocessor(&per_cu, (const void*)mk_fwd, NWAVES * 64, LDS_BYTES) != hipSuccess || per_cu < 1) fprintf(stderr, "kernel_launch: occupancy query says %d\n", per_cu);
        (void)hipGetLastError();
        grid = cus;
    }
    if (grid < 0) return;
    (void)hipMemsetAsync((char*)d_ws, 0, 32768, stream);
    Args a{};
    for (int i = 0; i < 24; ++i) a.in[i] = (const float*)d_in[i];
    a.out = (float*)d_out; a.ws = (unsigned char*)d_ws;
#if MK_ONE_LAUNCH
    a.ph_lo = 0; a.ph_hi = N_PHASES;
    hipLaunchKernelGGL(mk_fwd, dim3(grid), dim3(NWAVES * 64), LDS_BYTES, stream, a);
#else
    for (int k = 0; k < N_PHASES; ++k) {
        if (k >= 1 && k < N_PHASES - 1) { const int l = (k - 1) / 8, s = (k - 1) % 8; if ((l & 1) == 0 && s == 7) continue; }
        a.ph_lo = k; a.ph_hi = k + 1;
        hipLaunchKernelGGL(mk_fwd, dim3(grid), dim3(NWAVES * 64), LDS_BYTES, stream, a);
    }
#endif
    const hipError_t le = hipPeekAtLastError();
    if (le != hipSuccess) fprintf(stderr, "kernel_launch: launch failed: %s\n", hipGetErrorName(le));
}
```
